# Optimizing an MI355X kernel written in HIP

```python
import math
import jax
import jax.numpy as jnp
from jax import lax
import numpy as np

D_MODEL = 2048
BATCH = 2
SEQ = 8192
DEPTH = 2

GRID_W = 64
CTX_LEN = 256
N_MIXERS = 4
D_MIX = D_MODEL
W_GROUP = D_MIX // N_MIXERS
N_PROJ = 9
P_IN = N_PROJ * W_GROUP

RG_BLOCKS = 4
RG_BW = W_GROUP // RG_BLOCKS
RG_CONV = 4
RG_PAD = (2, 1)
RG_C = 8.0

SC_CONV = 3
SC_PAD = (1, 1)

POOL_WINDOWS = (2, 4, 8, 16)
POOL_GW = W_GROUP // len(POOL_WINDOWS)

DA_HEADS = 4
DA_HD = W_GROUP // (2 * DA_HEADS)
DA_VD = 2 * DA_HD
ROPE_THETA = 10000.0
Q_BLOCK = 128

N_GROUPS = 4
EXP_PER_GROUP = 8
N_EXPERTS = N_GROUPS * EXP_PER_GROUP
D_EXPERT = D_MODEL // 4
TOP_K = 2

N_MOD = 6
EPS = 1e-6

kernel_name = 'hymba_style_flow_backbone'


def rmsnorm(x, g):
    xf = x.astype(jnp.float32)
    r = lax.rsqrt(jnp.mean(xf * xf, axis=-1, keepdims=True) + EPS)
    return (xf * r).astype(x.dtype) * g


def dwconv(x, w, pad):
    L = x.shape[1]
    xp = jnp.pad(x, ((0, 0), pad, (0, 0)))
    return sum(w[k] * xp[:, k:k + L] for k in range(w.shape[0]))


def _lin_comb(e1, e2):
    a1, b1 = e1
    a2, b2 = e2
    return a1 * a2, a2 * b1 + b2


def rglru_scan(u, w_gate, b_gate, lam, h0, reverse):
    B_, L, _ = u.shape
    ub = u.reshape(B_, L, RG_BLOCKS, RG_BW).astype(jnp.float32)
    g = jnp.einsum('blnd,gnde->gblne', ub, w_gate.astype(jnp.float32)) + b_gate.astype(jnp.float32)[:, None, None]
    r = jax.nn.sigmoid(g[0])
    i = jax.nn.sigmoid(g[1])
    log_a = -RG_C * r * jax.nn.softplus(-lam.astype(jnp.float32).reshape(RG_BLOCKS, RG_BW))
    a = jnp.exp(log_a)
    bx = jnp.sqrt(-jnp.expm1(2.0 * log_a)) * (i * ub)
    if h0 is not None:
        edge = -1 if reverse else 0
        bx = bx.at[:, edge].add(a[:, edge] * h0)
    _, h = lax.associative_scan(_lin_comb, (a, bx), axis=1, reverse=reverse)
    return h


def pool_mixer(x, w, b, scale):
    B_, L, _ = x.shape
    xf = x.astype(jnp.float32)
    cs = jnp.pad(jnp.cumsum(xf, axis=1), ((0, 0), (1, 0), (0, 0)))
    t = np.arange(L)
    outs = []
    for gi, win in enumerate(POOL_WINDOWS):
        lo = np.clip(t - win // 2, 0, L)
        hi = np.clip(t + win // 2, 0, L)
        cnt = jnp.asarray((hi - lo).astype(np.float32))[None, :, None]
        sl = slice(gi * POOL_GW, (gi + 1) * POOL_GW)
        csg = cs[..., sl]
        outs.append((csg[:, hi] - csg[:, lo]) / cnt - xf[..., sl])
    d = jnp.stack(outs, axis=2)
    y = jnp.einsum('blgd,gde->blge', d, w) + b
    return (y.reshape(B_, L, W_GROUP) * scale).astype(x.dtype)


def rope_axis(x, pos):
    nf = x.shape[-1] // 2
    inv = ROPE_THETA ** (-jnp.arange(nf, dtype=jnp.float32) / nf)
    ang = pos.astype(jnp.float32)[:, None] * inv
    cos = jnp.cos(ang)[None, :, None, None, :]
    sin = jnp.sin(ang)[None, :, None, None, :]
    xf = x.astype(jnp.float32)
    x1, x2 = xf[..., :nf], xf[..., nf:]
    return jnp.concatenate([x1 * cos - x2 * sin, x1 * sin + x2 * cos], axis=-1).astype(x.dtype)


def rope_2d(x, rows, cols):
    half = x.shape[-1] // 2
    return jnp.concatenate([rope_axis(x[..., :half], rows), rope_axis(x[..., half:], cols)], axis=-1)


def diff_lambda(lp, lam_init):
    lp = lp.astype(jnp.float32)
    return jnp.exp(jnp.sum(lp[0] * lp[1])) - jnp.exp(jnp.sum(lp[2] * lp[3])) + lam_init


def diff_attn(q, k, v, lam):
    s = jnp.einsum('bqhcd,bkhcd->bhcqk', q, k).astype(jnp.float32) * (DA_HD ** -0.5)
    p = jax.nn.softmax(s, axis=-1)
    pd = p[:, :, 0] - lam * p[:, :, 1]
    return jnp.einsum('bhqk,bkhe->bqhe', pd.astype(v.dtype), v)


def diff_attn_latent(q, k_all, v_all, lam):
    B_, L = q.shape[:2]
    nb = L // Q_BLOCK
    qb = jnp.swapaxes(q.reshape(B_, nb, Q_BLOCK, DA_HEADS, 2, DA_HD), 0, 1)
    o = lax.map(lambda qi: diff_attn(qi, k_all, v_all, lam), qb)
    return jnp.swapaxes(o, 0, 1).reshape(B_, L, DA_HEADS, DA_VD)


def head_group_concat(a_gate, h_rec, b_b, b_c, b_x, c_x, y_att, sc_w, pool_w, pool_b, pool_scale):
    ya = jax.nn.gelu(a_gate) * h_rec.reshape(a_gate.shape).astype(a_gate.dtype)
    yb = b_b * dwconv(b_c * b_x, sc_w, SC_PAD)
    yc = pool_mixer(c_x, pool_w, pool_b, pool_scale)
    return jnp.concatenate([ya, yb, yc, y_att.reshape(a_gate.shape)], axis=-1)


def hier_moe(t, w_grp, b_grp, w_exp, b_exp, w_up, w_down):
    n_tok = t.shape[0]
    g_logit = (t @ w_grp).astype(jnp.float32) + b_grp
    g_prob = jax.nn.softmax(g_logit, axis=-1)
    g_idx = jnp.argmax(g_logit, axis=-1)
    g_w = jnp.take_along_axis(g_prob, g_idx[:, None], axis=-1)
    e_logit = ((t @ w_exp).astype(jnp.float32) + b_exp).reshape(n_tok, N_GROUPS, EXP_PER_GROUP)
    e_logit = jnp.take_along_axis(e_logit, g_idx[:, None, None], axis=1)[:, 0]
    top_v, top_i = lax.top_k(e_logit, TOP_K)
    top_w = jax.nn.softmax(top_v, axis=-1) * g_w
    e_sel = g_idx[:, None] * EXP_PER_GROUP + top_i
    gate = jnp.einsum('tk,tke->te', top_w, jax.nn.one_hot(e_sel, N_EXPERTS, dtype=jnp.float32)).astype(t.dtype)
    y = jnp.zeros_like(t)
    for e in range(N_EXPERTS):
        hu = t @ w_up[e]
        h = jax.nn.silu(hu[:, :D_EXPERT]) * hu[:, D_EXPERT:]
        y = y + gate[:, e:e + 1] * (h @ w_down[e])
    return y


def setup_inputs(seed: int = 0) -> dict:
    key = jax.random.key(seed)
    ks = jax.random.split(key, 32)
    f32 = jnp.float32

    def nrm(k, shape, scale):
        return jax.random.normal(k, shape, f32) * scale

    D, W = D_MODEL, W_GROUP
    a_target = jax.random.uniform(ks[12], (DEPTH, 2, W), f32, 0.9, 0.999)
    s = a_target ** (1.0 / RG_C)
    rg_lam = jnp.log(s) - jnp.log1p(-s)
    return {
        'x': nrm(ks[0], (BATCH, SEQ, D), 1.0),
        'c': nrm(ks[1], (BATCH, D), 1.0),
        'ctx': nrm(ks[2], (BATCH, CTX_LEN, D), 1.0),
        'c_ctx': nrm(ks[3], (D,), 1.0),
        'mod_w': nrm(ks[4], (DEPTH, D, N_MOD * D), 0.5 * D ** -0.5),
        'mod_b': nrm(ks[5], (DEPTH, N_MOD * D), 0.1),
        'norm_mix': 1.0 + nrm(ks[6], (DEPTH, D), 0.1),
        'norm_ffn': 1.0 + nrm(ks[7], (DEPTH, D), 0.1),
        'w_in': nrm(ks[8], (DEPTH, D, P_IN), D ** -0.5),
        'w_out': nrm(ks[9], (DEPTH, D_MIX, D), D_MIX ** -0.5),
        'rg_conv_w': nrm(ks[10], (DEPTH, RG_CONV, W), RG_CONV ** -0.5),
        'rg_conv_b': nrm(ks[11], (DEPTH, W), 0.02),
        'rg_gate_w': nrm(ks[13], (DEPTH, 2, 2, RG_BLOCKS, RG_BW, RG_BW), RG_BW ** -0.5),
        'rg_gate_b': nrm(ks[14], (DEPTH, 2, 2, RG_BLOCKS, RG_BW), 0.02),
        'rg_lam': rg_lam,
        'sc_conv_w': nrm(ks[15], (DEPTH, SC_CONV, W), SC_CONV ** -0.5),
        'pool_w': nrm(ks[16], (DEPTH, len(POOL_WINDOWS), POOL_GW, POOL_GW), POOL_GW ** -0.5),
        'pool_b': nrm(ks[17], (DEPTH, len(POOL_WINDOWS), POOL_GW), 0.02),
        'pool_scale': 1.0 + nrm(ks[18], (DEPTH, W), 0.1),
        'da_lam': nrm(ks[19], (DEPTH, 4, DA_HD), 0.1),
        'da_norm': 1.0 + nrm(ks[20], (DEPTH, DA_VD), 0.1),
        'moe_grp_w': nrm(ks[21], (DEPTH, D, N_GROUPS), D ** -0.5),
        'moe_grp_b': nrm(ks[22], (DEPTH, N_GROUPS), 0.01),
        'moe_exp_w': nrm(ks[23], (DEPTH, D, N_EXPERTS), D ** -0.5),
        'moe_exp_b': nrm(ks[24], (DEPTH, N_EXPERTS), 0.01),
        'moe_up': nrm(ks[25], (DEPTH, N_EXPERTS, D, 2 * D_EXPERT), D ** -0.5),
        'moe_down': nrm(ks[26], (DEPTH, N_EXPERTS, D_EXPERT, D), D_EXPERT ** -0.5),
        'norm_final': 1.0 + nrm(ks[27], (D,), 0.1),
    }


def reference(x, c, ctx, c_ctx, mod_w, mod_b, norm_mix, norm_ffn, w_in, w_out,
              rg_conv_w, rg_conv_b, rg_gate_w, rg_gate_b, rg_lam, sc_conv_w,
              pool_w, pool_b, pool_scale, da_lam, da_norm,
              moe_grp_w, moe_grp_b, moe_exp_w, moe_exp_b, moe_up, moe_down, norm_final):
    B_, L, D = x.shape
    n_ctx = ctx.shape[1]
    n_rows = L // GRID_W
    rows = jnp.repeat(jnp.arange(n_rows, dtype=jnp.int32), GRID_W)
    cols = jnp.tile(jnp.arange(GRID_W, dtype=jnp.int32), n_rows)
    s_lat = jax.nn.silu(c)
    s_ctx = jax.nn.silu(c_ctx)
    xl, xc = x, ctx
    for l in range(DEPTH):
        last = l == DEPTH - 1
        lam_init = 0.8 - 0.6 * math.exp(-0.3 * l)
        m_l = jnp.split((s_lat @ mod_w[l] + mod_b[l])[:, None, :], N_MOD, axis=-1)
        m_c = jnp.split(s_ctx @ mod_w[l] + mod_b[l], N_MOD, axis=-1)

        hl = rmsnorm(xl, norm_mix[l]) * (1.0 + m_l[1]) + m_l[0]
        hc = rmsnorm(xc, norm_mix[l]) * (1.0 + m_c[1]) + m_c[0]
        al_x, al_g, bl_b, bl_c, bl_x, cl_x, ql, kl, vl = jnp.split(hl @ w_in[l], N_PROJ, axis=-1)
        ac_x, ac_g, bc_b, bc_c, bc_x, cc_x, qc, kc, vc = jnp.split(hc @ w_in[l], N_PROJ, axis=-1)

        ul = dwconv(al_x, rg_conv_w[l], RG_PAD) + rg_conv_b[l]
        uc = dwconv(ac_x, rg_conv_w[l], RG_PAD) + rg_conv_b[l]
        hcf = rglru_scan(uc, rg_gate_w[l, 0], rg_gate_b[l, 0], rg_lam[l, 0], None, False)
        hcb = rglru_scan(uc, rg_gate_w[l, 1], rg_gate_b[l, 1], rg_lam[l, 1], None, True)
        hlf = rglru_scan(ul, rg_gate_w[l, 0], rg_gate_b[l, 0], rg_lam[l, 0], hcf[:, -1], False)
        hlb = rglru_scan(ul, rg_gate_w[l, 1], rg_gate_b[l, 1], rg_lam[l, 1], hcb[:, 0], True)

        lam = diff_lambda(da_lam[l], lam_init)
        kc = kc.reshape(B_, n_ctx, DA_HEADS, 2, DA_HD)
        vc = vc.reshape(B_, n_ctx, DA_HEADS, DA_VD)
        ql = rope_2d(ql.reshape(B_, L, DA_HEADS, 2, DA_HD), rows, cols)
        kl = rope_2d(kl.reshape(B_, L, DA_HEADS, 2, DA_HD), rows, cols)
        k_all = jnp.concatenate([kc, kl], axis=1)
        v_all = jnp.concatenate([vc, vl.reshape(B_, L, DA_HEADS, DA_VD)], axis=1)
        ydl = rmsnorm(diff_attn_latent(ql, k_all, v_all, lam), da_norm[l]) * (1.0 - lam_init)

        yl = head_group_concat(al_g, hlf + hlb, bl_b, bl_c, bl_x, cl_x, ydl,
                               sc_conv_w[l], pool_w[l], pool_b[l], pool_scale[l])
        xl = xl + m_l[2] * (yl @ w_out[l])
        if not last:
            ydc = rmsnorm(diff_attn(qc.reshape(B_, n_ctx, DA_HEADS, 2, DA_HD), kc, vc, lam),
                          da_norm[l]) * (1.0 - lam_init)
            yc = head_group_concat(ac_g, hcf + hcb, bc_b, bc_c, bc_x, cc_x, ydc,
                                   sc_conv_w[l], pool_w[l], pool_b[l], pool_scale[l])
            xc = xc + m_c[2] * (yc @ w_out[l])

        fl = rmsnorm(xl, norm_ffn[l]) * (1.0 + m_l[4]) + m_l[3]
        if last:
            y_l = hier_moe(fl.reshape(-1, D), moe_grp_w[l], moe_grp_b[l], moe_exp_w[l], moe_exp_b[l],
                           moe_up[l], moe_down[l])
            xl = xl + m_l[5] * y_l.reshape(xl.shape)
        else:
            fc = rmsnorm(xc, norm_ffn[l]) * (1.0 + m_c[4]) + m_c[3]
            tok = jnp.concatenate([fc.reshape(-1, D), fl.reshape(-1, D)], axis=0)
            y = hier_moe(tok, moe_grp_w[l], moe_grp_b[l], moe_exp_w[l], moe_exp_b[l],
                         moe_up[l], moe_down[l])
            xc = xc + m_c[5] * y[:B_ * n_ctx].reshape(xc.shape)
            xl = xl + m_l[5] * y[B_ * n_ctx:].reshape(xl.shape)
    return rmsnorm(xl, norm_final)
```

```cpp
#include <hip/hip_runtime.h>
#include <cstdio>
#include <cstdint>
#ifndef MK_SPLIT
#define MK_SPLIT 0
#endif

constexpr int DM = 2048, NBATCH = 2, LSEQ = 8192, NCTX = 256, SEGB = NCTX + LSEQ, T = NBATCH * SEGB;
constexpr int DEPTH = 2, PIN = 4608, NEXP = 32, DEXP = 512, NROUTE = 36, NMODC = 6 * DM;
constexpr int NTM = T / 256;
constexpr int TPB = SEGB / 256;
constexpr int CH64 = SEGB / 64;
constexpr int SLOT_CAP = 42240;
constexpr int KSPLIT = 16;
constexpr float EPS = 1e-6f;
constexpr float QSCALE = 0.125f * 1.4426950408889634f;
constexpr int NWAVES = 8;

constexpr size_t MiB = 1u << 20;
constexpr size_t WS_CTL = 0, CTL_ZERO_BYTES = 1 * MiB;
constexpr size_t WS_MODP = 1 * MiB, WS_MOD = 6 * MiB, WS_WRT = 7 * MiB, WS_AUXB = 8 * MiB;
constexpr size_t WS_WIN = 10 * MiB, WS_WOUT = 46 * MiB, WS_UP = 62 * MiB, WS_DOWN = 318 * MiB;
constexpr size_t WS_X = 446 * MiB, WS_H = 578 * MiB, WS_P = 644 * MiB, WS_QP = 793 * MiB, WS_KP = 810 * MiB, WS_VT = 827 * MiB;
constexpr size_t WS_AUXA = 844 * MiB, WS_G = 877 * MiB, WS_YB = 943 * MiB, WS_SUM = 1009 * MiB, WS_ROUTE = 1012 * MiB;
constexpr size_t WS_HS = 1013 * MiB, WS_HM = 1178 * MiB, WS_YS = 1220 * MiB, WS_END = 1385 * MiB;
static_assert(WS_MODP + (size_t)DEPTH * KSPLIT * 3 * NMODC * 4 <= WS_MOD, "modp");
static_assert(WS_WIN + (size_t)DEPTH * PIN * DM * 2 <= WS_WOUT && WS_WOUT + (size_t)DEPTH * DM * DM * 2 <= WS_UP, "w");
static_assert(WS_UP + (size_t)DEPTH * NEXP * 1024 * DM * 2 <= WS_DOWN && WS_DOWN + (size_t)DEPTH * NEXP * DM * DEXP * 2 <= WS_X, "w2");
static_assert(WS_X + (size_t)T * DM * 4 <= WS_H && WS_H + (size_t)T * DM * 2 <= WS_P && WS_P + (size_t)T * PIN * 2 <= WS_QP, "act");
static_assert(WS_QP + (size_t)T * 512 * 2 <= WS_KP && WS_VT + (size_t)T * 512 * 2 <= WS_AUXA && WS_AUXA + (size_t)8 * T * 128 * 2 <= WS_G, "act2");
static_assert(WS_G + (size_t)T * DM * 2 <= WS_YB && WS_YB + (size_t)T * DM * 2 <= WS_SUM, "act3");
static_assert(WS_HS + (size_t)SLOT_CAP * DM * 2 <= WS_HM && WS_HM + (size_t)SLOT_CAP * DEXP * 2 <= WS_YS && WS_YS + (size_t)SLOT_CAP * DM * 2 <= WS_END, "moe");
constexpr int RT_TOKE = 0, RT_POS = T, RT_W = 3 * T, RT_SLOT = 5 * T, RT_WSLOT = 7 * T;
constexpr int RT_S2T = RT_WSLOT + SLOT_CAP;
static_assert((size_t)(RT_S2T + SLOT_CAP) * 4 <= 1 * MiB, "route");
constexpr int CW_TMO = 0, CW_CTXD = 64  , CW_FOV = 512  , CW_BAR = 4096, CW_CNT = 16384;
constexpr int CW_MOE = 32768, CW_MOE_L = 4096, MOE_NT = 0, MOE_TILE_E = 64, MOE_TMAP = 256, TMAP_STRIDE = 68;
static_assert(MOE_TMAP + 32 * TMAP_STRIDE <= CW_MOE_L && (CW_MOE + DEPTH * CW_MOE_L) * 4 <= (int)CTL_ZERO_BYTES, "moe ctl");

constexpr int RING_BYTES = 131072;
constexpr int MISC_OFF = 139264 + 320;
constexpr int TP_OFF = MISC_OFF + 128;
constexpr int GT_OFF = RING_BYTES;
constexpr int LDS_BYTES = 147456;
static_assert(TP_OFF + 33 * 4 + 64 <= LDS_BYTES && 8 * 16896 <= 139264 && GT_OFF + 4 * 256 * 4 <= 139264, "lds");

#define GAS __attribute__((address_space(1)))
#define LAS __attribute__((address_space(3)))
typedef unsigned short bf16;
typedef unsigned v4u __attribute__((ext_vector_type(4)));
typedef unsigned v2u __attribute__((ext_vector_type(2)));
typedef float f32x4 __attribute__((ext_vector_type(4)));
typedef float f32x16 __attribute__((ext_vector_type(16)));
typedef short bf16x8 __attribute__((ext_vector_type(8)));
typedef GAS unsigned gu32;
#define RLX_AGENT __ATOMIC_RELAXED, __HIP_MEMORY_SCOPE_AGENT
#define LDS_WAIT() asm volatile("s_waitcnt lgkmcnt(0)" ::: "memory")
#define VM_WAIT() asm volatile("s_waitcnt vmcnt(0)" ::: "memory")
__device__ __forceinline__ unsigned f2bf(float f) { unsigned u = __builtin_bit_cast(unsigned, f); return (u + 0x7fffu + ((u >> 16) & 1u)) >> 16; }
__device__ __forceinline__ unsigned pk2(float lo, float hi) { return f2bf(lo) | (f2bf(hi) << 16); }
__device__ __forceinline__ unsigned pk2_hw(float lo, float hi) { unsigned r; asm("v_cvt_pk_bf16_f32 %0, %1, %2" : "=v"(r) : "v"(lo), "v"(hi)); return r; }
__device__ __forceinline__ float bf2f(unsigned u16) { return __builtin_bit_cast(float, u16 << 16); }
__device__ __forceinline__ float bflo(unsigned w) { return __builtin_bit_cast(float, w << 16); }
__device__ __forceinline__ float bfhi(unsigned w) { return __builtin_bit_cast(float, w & 0xffff0000u); }
__device__ __forceinline__ int fresh_lane() { int ln; asm volatile("v_mbcnt_lo_u32_b32 %0, -1, 0\n\tv_mbcnt_hi_u32_b32 %0, -1, %0" : "=v"(ln)); return ln; }
template <int PAT> __device__ __forceinline__ float swz_xor(float v) { return __builtin_bit_cast(float, __builtin_amdgcn_ds_swizzle(__builtin_bit_cast(int, v), PAT)); }
__device__ __forceinline__ float half_swap_sum(float v) { auto rr = __builtin_amdgcn_permlane32_swap(__builtin_bit_cast(unsigned, v), __builtin_bit_cast(unsigned, v), false, false); return __builtin_bit_cast(float, rr[0]) + __builtin_bit_cast(float, rr[1]); }
__device__ __forceinline__ float wave_sum(float v) {
    const int ln = fresh_lane();
#pragma unroll
    for (int o = 1; o < 64; o <<= 1) v += __builtin_bit_cast(float, __builtin_amdgcn_ds_bpermute((ln ^ o) << 2, __builtin_bit_cast(int, v)));
    return v;
}
__device__ __forceinline__ float sigmoidf_(float x) { return 1.0f / (1.0f + __expf(-x)); }
__device__ __forceinline__ float siluf_(float x) { return x / (1.0f + __expf(-x)); }
__device__ __forceinline__ float gelu_tanh(float x) { const float z = 0.7978845608028654f * (x + 0.044715f * x * x * x); const float e = __expf(2.0f * z); return 0.5f * x * (2.0f - 2.0f / (e + 1.0f)); }
__device__ __forceinline__ int mod_row(int r) { const int b = r / SEGB; return (r - b * SEGB) < NCTX ? 2 : b; }

namespace pg8 {
#define PG8_LAS __attribute__((address_space(3)))
typedef unsigned short bf16_t;
typedef short bf16x8 __attribute__((ext_vector_type(8)));
typedef float f32x4 __attribute__((ext_vector_type(4)));
typedef unsigned u32x4 __attribute__((ext_vector_type(4)));
constexpr int BM = 256, BK = 64, HALF = 128, HTB = HALF * BK * 2  , STAGE_BYTES = 8 * HTB, NXCD = 8, WGM = 8;

__host__ __device__ __forceinline__ int lds_byte(int r, int c) { const int st = (r >> 4) * 2 + (c >> 5), rr = r & 15, cc = c & 31, ob = rr * 64 + cc * 2; return st * 1024 + (ob ^ (((ob >> 9) & 1) << 5)); }
__host__ __device__ __forceinline__ void stage_rc(int b, int& R, int& C) { const int st = b / 1024, sb = b % 1024, swz = sb ^ (((sb >> 9) & 1) << 5); R = (st >> 1) * 16 + swz / 64; C = (st & 1) * 32 + (swz % 64) / 2; }
__host__ __device__ __forceinline__ int perm32(int rho) { const int n = rho >> 4, i = rho & 15; return 8 * (i >> 2) + 4 * n + (i & 3); }

struct Unit { int pm, pn, aux; };
struct Gemm { const bf16_t* A; const bf16_t* Bt; int M, N, K; };

struct StaticOrder {
    int nM, nN, nwg, G, c;
    __host__ __device__ void init(int M, int N, int G_, int c_) { nM = M / BM; nN = N / BM; nwg = nM * nN; G = G_; c = c_; }
    __host__ __device__ bool next(int i, Unit& u) const {
        const long L = (long)i * G + c; if (L >= nwg) return false;
        int wgid = (int)L; { const int q = nwg / NXCD, r = nwg % NXCD, xcd = wgid % NXCD, off = wgid / NXCD; wgid = (xcd < r ? xcd * (q + 1) : r * (q + 1) + (xcd - r) * q) + off; }
        const int nig = WGM * nN, gid = wgid / nig, fm = gid * WGM, gsz = (nM - fm) < WGM ? (nM - fm) : WGM;
        u.pm = fm + ((wgid % nig) % gsz); u.pn = (wgid % nig) / gsz; return true;
    }
    __device__ __forceinline__ void a_ready(const Unit&) const {}
    __device__ __forceinline__ void done(const Unit&) const {}
};
__device__ __forceinline__ unsigned cvt_pk_bf16(float lo, float hi) { unsigned r; asm volatile("v_cvt_pk_bf16_f32 %0, %1, %2" : "=v"(r) : "v"(lo), "v"(hi)); return r; }
typedef float f32x2 __attribute__((ext_vector_type(2)));
template <class Epi, class Sched, bool ALIGN_EPI = false, bool SP2 = false, bool GATHER = false>
__device__ __forceinline__ void gemm_phase(PG8_LAS unsigned char* lds, const Gemm g, const Sched& S, const Epi& E, const int tid_in) {
    int tid_ = tid_in;
    const int tid = tid_, wid = __builtin_amdgcn_readfirstlane(tid >> 6), lane = tid & 63, wr = wid >> 2, wc = wid & 3, fr = lane & 15, fq = lane >> 4;
    const int K = g.K, nt = K / BK;
    unsigned voffA[2], voffB[2];
#pragma unroll
    for (int i = 0; i < 2; ++i) { int R, C; stage_rc(tid * 16 + i * 8192, R, C); const int Rb = Epi::PERM ? ((R & ~31) + perm32(R & 31)) : R;
        voffA[i] = (unsigned)(R * K + C) * 2u; voffB[i] = (unsigned)(Rb * K + C) * 2u; }
    static_assert(!GATHER || SP2, "GATHER is written for the SP2 loop");
    unsigned vC[2][2] = {}, vN[2][2] = {};
    int gR0 = 0, gC0 = 0; if constexpr (GATHER) stage_rc(tid * 16, gR0, gC0);
#define PG8_GOFF(v, ui_) do { _Pragma("unroll") for (int h_ = 0; h_ < 2; ++h_) _Pragma("unroll") for (int i_ = 0; i_ < 2; ++i_) v[h_][i_] = (unsigned)(S.row((ui_), h_ * 128 + gR0 + 64 * i_) * K + gC0) * 2u; } while (0)
    const size_t kstep = (size_t)(BK * 2);
    const size_t hstep = (size_t)HALF * K * 2;
    const size_t tstep = 2 * hstep;
    const unsigned ldsw = (unsigned)wid * 1024u;
    const int aoff = lds_byte(wr * 64 + fr, fq * 8), boff = lds_byte(wc * 32 + fr, fq * 8);
#define PG8_SA(b, h) (((b) * 2 + (h)) * HTB)
#define PG8_SB(b, h) ((4 + (b) * 2 + (h)) * HTB)
#define PG8_STAGE(bufoff, gbase, voff) do { _Pragma("unroll") for (int _i = 0; _i < 2; ++_i) \
        __builtin_amdgcn_global_load_lds((const unsigned*)((const char*)(gbase) + (voff)[_i]), (PG8_LAS unsigned*)(lds + (bufoff) + ldsw + _i * 8192), 16, 0, 0); } while (0)
#define PG8_LDA(dst, b, h) do { _Pragma("unroll") for (int m = 0; m < 4; ++m) _Pragma("unroll") for (int k = 0; k < 2; ++k) dst[m][k] = *(const PG8_LAS bf16x8*)(lds + PG8_SA(b, h) + aoff + m * 2048 + k * 1024); } while (0)
#define PG8_LDB(dst, b, h) do { _Pragma("unroll") for (int n = 0; n < 2; ++n) _Pragma("unroll") for (int k = 0; k < 2; ++k) dst[n][k] = *(const PG8_LAS bf16x8*)(lds + PG8_SB(b, h) + boff + n * 2048 + k * 1024); } while (0)
#define PG8_MMA(ai, bj, At, Bt) do { __builtin_amdgcn_s_setprio(1); _Pragma("unroll") for (int m = 0; m < 4; ++m) _Pragma("unroll") for (int n = 0; n < 2; ++n) _Pragma("unroll") for (int k = 0; k < 2; ++k) \
        acc[ai][bj][m][n] = __builtin_amdgcn_mfma_f32_16x16x32_bf16(Bt[n][k], At[m][k], acc[ai][bj][m][n], 0, 0, 0); __builtin_amdgcn_s_setprio(0); } while (0)
#define PG8_WAIT_V(n) asm volatile("s_waitcnt vmcnt(" #n ")" ::: "memory")
#define PG8_WAIT_L(n) asm volatile("s_waitcnt lgkmcnt(" #n ")" ::: "memory")
#define PG8_BAR __builtin_amdgcn_s_barrier()
#define PG8_SCHED __builtin_amdgcn_sched_barrier(0)
    Unit cur, nxt; int ui = 0;
    if (!S.next(0, cur)) return;
    f32x4 acc[2][2][4][2];
#pragma unroll
    for (int a = 0; a < 2; ++a)
#pragma unroll
        for (int b = 0; b < 2; ++b)
#pragma unroll
            for (int m = 0; m < 4; ++m)
#pragma unroll
                for (int n = 0; n < 2; ++n) acc[a][b][m][n] = (f32x4){0.f, 0.f, 0.f, 0.f};
    bf16x8 At[4][2], B0[2][2], B1[2][2];
    const char* cA = GATHER ? (const char*)g.A : (const char*)g.A + (size_t)cur.pm * tstep; const char* cB = (const char*)g.Bt + (size_t)cur.pn * tstep;
    const size_t ahstep = GATHER ? 0 : hstep;
    if constexpr (GATHER) PG8_GOFF(vC, 0);
#define PG8_VA(sel_next, h) (GATHER ? vC[h] : voffA)
    S.a_ready(cur);
    if constexpr (SP2) {
        PG8_STAGE(PG8_SB(0, 0), cB, voffB); PG8_STAGE(PG8_SB(0, 1), cB + hstep, voffB); PG8_STAGE(PG8_SA(0, 0), cA, PG8_VA(false, 0)); PG8_STAGE(PG8_SA(0, 1), cA + ahstep, PG8_VA(false, 1));
        if (wr == 1) PG8_BAR;
        PG8_WAIT_V(2); PG8_BAR;
        PG8_STAGE(PG8_SB(1, 0), cB + kstep, voffB); PG8_STAGE(PG8_SA(1, 0), cA + kstep, PG8_VA(false, 0)); PG8_STAGE(PG8_SB(1, 1), cB + hstep + kstep, voffB);
        PG8_WAIT_V(6); PG8_BAR;
    } else {
        PG8_STAGE(PG8_SB(0, 0), cB, voffB); PG8_STAGE(PG8_SA(0, 0), cA, voffA); PG8_STAGE(PG8_SB(0, 1), cB + hstep, voffB); PG8_STAGE(PG8_SA(0, 1), cA + hstep, voffA);
        if (wr == 1) PG8_BAR;
        PG8_WAIT_V(4); PG8_BAR;
        PG8_STAGE(PG8_SB(1, 0), cB + kstep, voffB); PG8_STAGE(PG8_SA(1, 0), cA + kstep, voffA); PG8_STAGE(PG8_SB(1, 1), cB + hstep + kstep, voffB);
        PG8_WAIT_V(6); PG8_BAR;
    }
    for (;;) {
        const bool has_next = S.next(ui + 1, nxt);
        const char* nA = (has_next && !GATHER) ? (const char*)g.A + (size_t)nxt.pm * tstep : cA; const char* nB = has_next ? (const char*)g.Bt + (size_t)nxt.pn * tstep : cB;
        if constexpr (GATHER) { if (has_next) PG8_GOFF(vN, ui + 1); else { _Pragma("unroll") for (int h_ = 0; h_ < 2; ++h_) _Pragma("unroll") for (int i_ = 0; i_ < 2; ++i_) vN[h_][i_] = vC[h_][i_]; } }
        for (int t = 0; t < nt; t += 2) {
            const bool last = (t == nt - 2);
            const char* a1 = cA + (size_t)(t + 1) * kstep;
            const char* a2 = last ? nA : cA + (size_t)(t + 2) * kstep; const char* b2 = last ? nB : cB + (size_t)(t + 2) * kstep;
            const char* a3 = a2 + kstep; const char* b3 = b2 + kstep;
            if (last && has_next) S.a_ready(nxt);
            unsigned vs0[2], vs1[2];
            _Pragma("unroll") for (int i_ = 0; i_ < 2; ++i_) { vs0[i_] = GATHER ? (last ? vN[0][i_] : vC[0][i_]) : voffA[i_]; vs1[i_] = GATHER ? (last ? vN[1][i_] : vC[1][i_]) : voffA[i_]; }
            if constexpr (SP2) {
            PG8_LDB(B0, 0, 0); PG8_LDB(B1, 0, 1); PG8_SCHED; PG8_LDA(At, 0, 0); PG8_STAGE(PG8_SA(1, 1), a1 + ahstep, PG8_VA(false, 1));
            PG8_WAIT_V(8); PG8_WAIT_L(0); PG8_BAR; PG8_MMA(0, 0, At, B0); PG8_MMA(0, 1, At, B1); PG8_BAR; PG8_SCHED;
            PG8_LDA(At, 0, 1); PG8_STAGE(PG8_SB(0, 0), b2, voffB); PG8_STAGE(PG8_SB(0, 1), b2 + hstep, voffB); PG8_STAGE(PG8_SA(0, 0), a2, vs0);
            PG8_WAIT_V(8); PG8_WAIT_L(0); PG8_BAR; PG8_MMA(1, 0, At, B0); PG8_MMA(1, 1, At, B1); PG8_BAR; PG8_SCHED;
            PG8_LDB(B0, 1, 0); PG8_LDB(B1, 1, 1); PG8_SCHED; PG8_LDA(At, 1, 0); PG8_STAGE(PG8_SA(0, 1), a2 + ahstep, vs1);
            PG8_WAIT_V(8); PG8_WAIT_L(0); PG8_BAR; PG8_MMA(0, 0, At, B0); PG8_MMA(0, 1, At, B1); PG8_BAR; PG8_SCHED;
            PG8_LDA(At, 1, 1); PG8_STAGE(PG8_SB(1, 0), b3, voffB); PG8_STAGE(PG8_SB(1, 1), b3 + hstep, voffB); PG8_STAGE(PG8_SA(1, 0), a3, vs0);
            PG8_WAIT_V(8); PG8_WAIT_L(0); PG8_BAR; PG8_MMA(1, 0, At, B0); PG8_MMA(1, 1, At, B1); PG8_BAR; PG8_SCHED;
            } else {
            PG8_LDB(B0, 0, 0); PG8_SCHED; PG8_LDA(At, 0, 0); PG8_STAGE(PG8_SA(1, 1), a1 + hstep, voffA);
            PG8_WAIT_L(8); PG8_BAR; PG8_WAIT_L(0); PG8_MMA(0, 0, At, B0); PG8_BAR; PG8_SCHED;
            PG8_LDB(B1, 0, 1); PG8_STAGE(PG8_SB(0, 0), b2, voffB);
            PG8_BAR; PG8_WAIT_L(0); PG8_MMA(0, 1, At, B1); PG8_BAR;
            PG8_LDA(At, 0, 1); PG8_STAGE(PG8_SA(0, 0), a2, voffA);
            PG8_BAR; PG8_WAIT_L(0); PG8_MMA(1, 0, At, B0); PG8_BAR; PG8_SCHED;
            PG8_STAGE(PG8_SB(0, 1), b2 + hstep, voffB);
            PG8_WAIT_V(6); PG8_BAR; PG8_MMA(1, 1, At, B1); PG8_BAR;
            PG8_LDB(B0, 1, 0); PG8_SCHED; PG8_LDA(At, 1, 0); PG8_STAGE(PG8_SA(0, 1), a2 + hstep, voffA);
            PG8_WAIT_L(8); PG8_BAR; PG8_WAIT_L(0); PG8_MMA(0, 0, At, B0); PG8_BAR; PG8_SCHED;
            PG8_LDB(B1, 1, 1); PG8_STAGE(PG8_SB(1, 0), b3, voffB);
            PG8_BAR; PG8_WAIT_L(0); PG8_MMA(0, 1, At, B1); PG8_BAR;
            PG8_LDA(At, 1, 1); PG8_STAGE(PG8_SA(1, 0), a3, voffA);
            PG8_BAR; PG8_WAIT_L(0); PG8_MMA(1, 0, At, B0); PG8_BAR; PG8_SCHED;
            PG8_STAGE(PG8_SB(1, 1), b3 + hstep, voffB);
            PG8_WAIT_V(6); PG8_BAR; PG8_MMA(1, 1, At, B1); PG8_BAR;
            }
        }
        if constexpr (ALIGN_EPI) { if (wr == 0) PG8_BAR; }
        if constexpr (!Epi::AFTER_DRAIN) { E(acc, cur, wr, wc, fr, fq); S.done(cur); }
        if (!has_next) break;
#pragma unroll
        for (int a = 0; a < 2; ++a)
#pragma unroll
            for (int b = 0; b < 2; ++b)
#pragma unroll
                for (int m = 0; m < 4; ++m)
#pragma unroll
                    for (int n = 0; n < 2; ++n) acc[a][b][m][n] = (f32x4){0.f, 0.f, 0.f, 0.f};
        cur = nxt; cA = nA; cB = nB; ++ui;
        if constexpr (GATHER) { _Pragma("unroll") for (int h_ = 0; h_ < 2; ++h_) _Pragma("unroll") for (int i_ = 0; i_ < 2; ++i_) vC[h_][i_] = vN[h_][i_]; }
        if constexpr (ALIGN_EPI) { if (wr == 1) PG8_BAR; }
    }
    PG8_WAIT_V(0);
    if constexpr (!ALIGN_EPI) { if (wr == 0) PG8_BAR; }
    PG8_BAR;
    if constexpr (Epi::AFTER_DRAIN) { E.fused(acc, cur, wr, wc, fr, fq, lds, wid, lane); S.done(cur); }
#undef PG8_SA
#undef PG8_GOFF
#undef PG8_VA
#undef PG8_SB
#undef PG8_STAGE
#undef PG8_LDA
#undef PG8_LDB
#undef PG8_MMA
#undef PG8_WAIT_V
#undef PG8_WAIT_L
#undef PG8_BAR
#undef PG8_SCHED
}
}
#define XB_TMO      128
#define XB_XCNT(j)  (256  + 64 * (j))
#define XB_XSUB(j)  (1280 + 64 * (j))
#define XB_XGEN(j)  (2304 + 64 * (j))
#define XB_TOP      3328
#define XB_TOPGEN   3392
#define XCD_BAR_WORDS 3456
#define XB_SPIN_CAP (1u << 18)

__device__ __forceinline__ unsigned xb_ld(unsigned* p)              { return __hip_atomic_load(p, __ATOMIC_RELAXED, __HIP_MEMORY_SCOPE_AGENT); }
__device__ __forceinline__ unsigned xb_add(unsigned* p, unsigned v) { return __hip_atomic_fetch_add(p, v, __ATOMIC_RELAXED, __HIP_MEMORY_SCOPE_AGENT); }
__device__ __forceinline__ unsigned xb_xcc_id() { return (unsigned)__builtin_amdgcn_s_getreg((3 << 11) | 20) & 0xFu; }
#define XB_SPIN(cond, bar) do { unsigned _sp = 0; while (cond) { __builtin_amdgcn_s_sleep(1); \
    if ((++_sp & 255u) == 0u) { if (xb_ld(&(bar)[XB_TMO])) break; if (_sp > XB_SPIN_CAP) { atomicAdd(&(bar)[XB_TMO], 1u); break; } } } } while (0)

struct XcdBarrier {
    unsigned* bar; unsigned x;
    volatile LAS unsigned* st;
};

__device__ __forceinline__ XcdBarrier xcd_barrier_post(unsigned* bar, volatile LAS unsigned* st) {
    XcdBarrier b; b.bar = bar; b.x = xb_xcc_id(); b.st = st;
    if (threadIdx.x == 0) (void)xb_add(&bar[XB_XCNT(b.x)], 1u);
    return b;
}
__device__ __forceinline__ void xcd_barrier_complete(unsigned* bar, unsigned x, unsigned& nloc, unsigned& nx) {
    const unsigned G = gridDim.x * gridDim.y * gridDim.z;
    unsigned sum, cnt, mine, sp = 0u;
    for (;;) {
        sum = 0u; cnt = 0u; mine = 0u;
#pragma unroll
        for (unsigned j = 0; j < 16; ++j) { const unsigned c = xb_ld(&bar[XB_XCNT(j)]); sum += c; cnt += (c > 0u) ? 1u : 0u; mine = (j == x) ? c : mine; }
        if (sum == G) break;
        __builtin_amdgcn_s_sleep(1);
        if ((++sp & 255u) == 0u) { if (xb_ld(&bar[XB_TMO])) break; if (sp > XB_SPIN_CAP) { atomicAdd(&bar[XB_TMO], 1u); break; } }
    }
    nloc = mine > 0u ? mine : 1u; nx = cnt > 0u ? cnt : 1u;
}

__device__ __forceinline__ void xcd_barrier(const XcdBarrier& b) {
    asm volatile("s_waitcnt vmcnt(0)" ::: "memory");
    __syncthreads();
    if (threadIdx.x == 0) {
        unsigned* bar = b.bar;
        __builtin_amdgcn_s_waitcnt(0);
        unsigned nloc = b.st[0], nx = b.st[1];
        if (nloc == 0u) { xcd_barrier_complete(bar, b.x, nloc, nx); b.st[0] = nloc; b.st[1] = nx; }
        const unsigned old = xb_add(&bar[XB_XSUB(b.x)], 1u);
        const unsigned gen = old / nloc;
        if (old + 1u == (gen + 1u) * nloc) {
            __builtin_amdgcn_fence(__ATOMIC_RELEASE, "agent");
            asm volatile("s_waitcnt vmcnt(0)" ::: "memory");
            const unsigned og = xb_add(&bar[XB_TOP], 1u);
            const unsigned tg = og / nx;
            if (og + 1u == (tg + 1u) * nx) xb_add(&bar[XB_TOPGEN], 1u);
            else XB_SPIN(xb_ld(&bar[XB_TOPGEN]) == tg, bar);
            __builtin_amdgcn_fence(__ATOMIC_ACQUIRE, "agent");
            xb_add(&bar[XB_XGEN(b.x)], 1u);
            asm volatile("s_waitcnt vmcnt(0)" ::: "memory");
        } else {
            XB_SPIN(xb_ld(&bar[XB_XGEN(b.x)]) == gen, bar);
            __builtin_amdgcn_fence(__ATOMIC_ACQUIRE, "agent");
            asm volatile("s_waitcnt vmcnt(0)" ::: "memory");
        }
    }
    __syncthreads();
}

using pg8::Unit;
struct EpiStoreBf16 {
    static constexpr bool PERM = true, AFTER_DRAIN = false;
    bf16* O; int ldc;
    __device__ __forceinline__ void operator()(const pg8::f32x4 (&acc)[2][2][4][2], const Unit& u, int wr, int wc, int fr, int fq) const {
        const int row0 = u.pm * 256 + wr * 64 + fr, col0 = u.pn * 256 + wc * 32 + 8 * fq;
#pragma unroll
        for (int ai = 0; ai < 2; ++ai)
#pragma unroll
            for (int m = 0; m < 4; ++m) { bf16* rowp = O + (size_t)(row0 + ai * 128 + m * 16) * ldc + col0;
#pragma unroll
                for (int bj = 0; bj < 2; ++bj) { const pg8::f32x4 v0 = acc[ai][bj][m][0], v1 = acc[ai][bj][m][1];
                    v4u w; w.x = pg8::cvt_pk_bf16(v0[0], v0[1]); w.y = pg8::cvt_pk_bf16(v0[2], v0[3]); w.z = pg8::cvt_pk_bf16(v1[0], v1[1]); w.w = pg8::cvt_pk_bf16(v1[2], v1[3]);
                    *(v4u*)(rowp + bj * 128) = w; } }
    }
};
__device__ __forceinline__ float fast_sigmoid(float x) { return __builtin_amdgcn_rcpf(1.0f + __builtin_amdgcn_exp2f(-1.4426950408889634f * x)); }
struct EpiAux {
    static constexpr bool PERM = true, AFTER_DRAIN = false;
    bf16* G; bf16* YB; const bf16* AUXA; const float* gate_b  ; const float* sp8l2  ; const float* pool_b  ; const float* pool_scale  ;
    __device__ __forceinline__ void operator()(const pg8::f32x4 (&acc)[2][2][4][2], const Unit& u, int wr, int wc, int fr, int fq) const {
        const int q = u.pn, pmrow = u.pm % NTM; const int row0 = pmrow * 256 + wr * 64 + fr; const int c0 = wc * 32 + 8 * fq;
        if (q < 8) {
            const int blk = q >> 1, dir = q & 1;
            float br[8], bi[8], sp[8];
            { const float* p0 = gate_b + ((dir * 2 + 0) * 4 + blk) * 128 + c0, *p1 = gate_b + ((dir * 2 + 1) * 4 + blk) * 128 + c0, *p2 = sp8l2 + dir * 512 + blk * 128 + c0;
#pragma unroll
              for (int i = 0; i < 8; ++i) { br[i] = p0[i]; bi[i] = p1[i]; sp[i] = p2[i]; } }
            bf16* obase = G + (size_t)row0 * DM + q * 256 + c0; const bf16* ubase = AUXA + ((size_t)blk * T + row0) * 128 + c0;
#pragma unroll
            for (int ai = 0; ai < 2; ++ai) { v4u uq[4];
#pragma unroll
                for (int m = 0; m < 4; ++m) uq[m] = *(const v4u*)(ubase + (size_t)(ai * 128 + m * 16) * 128);
#pragma unroll
                for (int m = 0; m < 4; ++m) { const int ro = ai * 128 + m * 16;
                    const v4u uw = uq[m]; const float uu[8] = {bflo(uw.x), bfhi(uw.x), bflo(uw.y), bfhi(uw.y), bflo(uw.z), bfhi(uw.z), bflo(uw.w), bfhi(uw.w)};
                    float la[8], bx[8];
#pragma unroll
                    for (int i = 0; i < 8; ++i) { const float gr = acc[ai][0][m][i >> 2][i & 3] + br[i], gi = acc[ai][1][m][i >> 2][i & 3] + bi[i];
                        const float r = fast_sigmoid(gr), ig = fast_sigmoid(gi); const float l2 = -sp[i] * r;
                        const float x = -1.3862943611198906f * l2;
                        const float em = 1.0f - __builtin_amdgcn_exp2f(2.0f * l2);
                        const float sr = x * (1.0f + x * (-0.5f + x * (0.16666667f - 0.041666668f * x)));
                        const float om = x < 0.125f ? sr : em;
                        la[i] = l2; bx[i] = __builtin_amdgcn_sqrtf(om) * (ig * uu[i]); }
                    v4u w; w.x = pg8::cvt_pk_bf16(la[0], la[1]); w.y = pg8::cvt_pk_bf16(la[2], la[3]); w.z = pg8::cvt_pk_bf16(la[4], la[5]); w.w = pg8::cvt_pk_bf16(la[6], la[7]);
                    *(v4u*)(obase + (size_t)ro * DM) = w;
                    w.x = pg8::cvt_pk_bf16(bx[0], bx[1]); w.y = pg8::cvt_pk_bf16(bx[2], bx[3]); w.z = pg8::cvt_pk_bf16(bx[4], bx[5]); w.w = pg8::cvt_pk_bf16(bx[6], bx[7]);
                    *(v4u*)(obase + (size_t)ro * DM + 128) = w; } }
        } else {
            const int g = q - 8;
            const pg8::f32x4 b0 = *(const pg8::f32x4*)(pool_b + g * 128 + c0) * *(const pg8::f32x4*)(pool_scale + g * 128 + c0), b1 = *(const pg8::f32x4*)(pool_b + g * 128 + c0 + 4) * *(const pg8::f32x4*)(pool_scale + g * 128 + c0 + 4);
            bf16* obase = YB + (size_t)row0 * DM + 1024 + g * 128 + c0;
#pragma unroll
            for (int ai = 0; ai < 2; ++ai)
#pragma unroll
                for (int m = 0; m < 4; ++m) { const pg8::f32x4 v0 = acc[ai][0][m][0] + b0, v1 = acc[ai][0][m][1] + b1;
                    v4u w; w.x = pg8::cvt_pk_bf16(v0[0], v0[1]); w.y = pg8::cvt_pk_bf16(v0[2], v0[3]); w.z = pg8::cvt_pk_bf16(v1[0], v1[1]); w.w = pg8::cvt_pk_bf16(v1[2], v1[3]);
                    *(v4u*)(obase + (size_t)(ai * 128 + m * 16) * DM) = w; }
        }
    }
};
struct AuxSched {
    int G, c;
    __device__ __forceinline__ bool next(int i, Unit& u) const { const int L = i * G + c; if (L >= NTM * 12) return false; const int pmrow = L / 12, q = L % 12; u.pn = q; u.pm = (q < 8 ? (q >> 1) : (q - 4)) * NTM + pmrow; return true; }
    __device__ __forceinline__ void a_ready(const Unit&) const {}
    __device__ __forceinline__ void done(const Unit&) const {}
};
struct EpiResid {
    static constexpr bool PERM = true, AFTER_DRAIN = false;
    bf16* X; const float* mod  ; const float* in_x; const float* in_ctx;
    __device__ __forceinline__ void operator()(const pg8::f32x4 (&acc)[2][2][4][2], const Unit& u, int wr, int wc, int fr, int fq) const {
        const int b = u.pm / TPB, tb = u.pm - b * TPB; const int mrow = (tb == 0) ? 2 : b;
        const float* rin = !in_x ? nullptr : (tb == 0 ? in_ctx + (size_t)b * NCTX * DM : in_x + ((size_t)b * LSEQ + (size_t)(tb - 1) * 256) * DM);
        bf16* xb = X + (size_t)u.pm * 256 * DM;
        const int col0 = u.pn * 256 + wc * 32 + 8 * fq; const float* m2 = mod + (size_t)mrow * NMODC + 2 * DM + col0;
#pragma unroll
        for (int bj = 0; bj < 2; ++bj) { const pg8::f32x4 g0 = *(const pg8::f32x4*)(m2 + bj * 128), g1 = *(const pg8::f32x4*)(m2 + bj * 128 + 4);
#pragma unroll
            for (int ai = 0; ai < 2; ++ai) { pg8::f32x4 r0[4], r1[4];
                if (rin) {
#pragma unroll
                    for (int m = 0; m < 4; ++m) { const size_t ro = (size_t)(ai * 128 + wr * 64 + m * 16 + fr) * DM + col0 + bj * 128; r0[m] = *(const pg8::f32x4*)(rin + ro); r1[m] = *(const pg8::f32x4*)(rin + ro + 4); }
                } else { v4u w4[4];
#pragma unroll
                    for (int m = 0; m < 4; ++m) { const size_t ro = (size_t)(ai * 128 + wr * 64 + m * 16 + fr) * DM + col0 + bj * 128; w4[m] = *(const v4u*)(xb + ro); }
#pragma unroll
                    for (int m = 0; m < 4; ++m) { const v4u w = w4[m]; r0[m][0] = bflo(w.x); r0[m][1] = bfhi(w.x); r0[m][2] = bflo(w.y); r0[m][3] = bfhi(w.y); r1[m][0] = bflo(w.z); r1[m][1] = bfhi(w.z); r1[m][2] = bflo(w.w); r1[m][3] = bfhi(w.w); }
                }
#pragma unroll
                for (int m = 0; m < 4; ++m) { const size_t ro = (size_t)(ai * 128 + wr * 64 + m * 16 + fr) * DM + col0 + bj * 128;
                    const pg8::f32x4 o0 = r0[m] + g0 * acc[ai][bj][m][0], o1 = r1[m] + g1 * acc[ai][bj][m][1];
                    v4u w; w.x = pg8::cvt_pk_bf16(o0[0], o0[1]); w.y = pg8::cvt_pk_bf16(o0[2], o0[3]); w.z = pg8::cvt_pk_bf16(o1[0], o1[1]); w.w = pg8::cvt_pk_bf16(o1[2], o1[3]);
                    *(v4u*)(xb + ro) = w; } } }
    }
};
struct MoeSched {
    const LAS int* perm; int ncol, G, c, lim;
    const LAS int* gt;
    __device__ __forceinline__ int row(int ui, int r) const { return gt[ui * 256 + r]; }
    __device__ __forceinline__ bool next(int i, Unit& u) const {
        const int L = i * G + c; const int nt = perm[0]; if (L >= nt * ncol || L >= lim) return false;
        const int q = L / ncol, j = L - q * ncol; const int pe = perm[1 + q];
        u.pm = pe & 0xffff; u.pn = (pe >> 16) * ncol + j; u.aux = q; return true;
    }
    __device__ __forceinline__ void a_ready(const Unit&) const {}
    __device__ __forceinline__ void done(const Unit&) const {}
};
struct MoeOneUp {
    const LAS int* perm; int L; const LAS int* gt;
    __device__ __forceinline__ int row(int, int r) const { return gt[r]; }
    __device__ __forceinline__ bool next(int i, Unit& u) const { if (i > 0) return false; const int q = L >> 2, j = L & 3; const int pe = perm[1 + q]; u.pm = pe & 0xffff; u.pn = (pe >> 16) * 4 + j; u.aux = q; return true; }
    __device__ __forceinline__ void a_ready(const Unit&) const {}
    __device__ __forceinline__ void done(const Unit&) const {}
};
struct MoeDownSched {
    const LAS int* perm; int G, c, R, qov; const unsigned* cnt;
    __device__ __forceinline__ bool next(int i, Unit& u) const {
        int L;
        if (R == 0) L = i * G + c;
        else { const int vi = c < R ? i + 2 : i; L = vi < 2 ? vi * (G - R) + (c - R) : 2 * (G - R) + (vi - 2) * G + c; }
        const int nt = perm[0]; if (L >= nt * 8) return false;
        const int q = L >> 3, j = L & 7; const int pe = perm[1 + q];
        u.pm = pe & 0xffff; u.pn = (pe >> 16) * 8 + j; u.aux = q; return true;
    }
    __device__ __forceinline__ void a_ready(const Unit& u) const {
        if (R == 0 || u.aux < qov) return;
        const unsigned* w = cnt + u.aux;
        for (unsigned sp = 0; sp < (1u << 24); ++sp) { if ((unsigned)__builtin_amdgcn_readfirstlane((int)__hip_atomic_load(w, __ATOMIC_RELAXED, __HIP_MEMORY_SCOPE_AGENT)) >= 4u) break; __builtin_amdgcn_s_sleep(2); }
        __builtin_amdgcn_fence(__ATOMIC_ACQUIRE, "agent");
    }
    __device__ __forceinline__ void done(const Unit&) const {}
};
struct EpiSwiGLU {
    static constexpr bool PERM = true, AFTER_DRAIN = false;
    bf16* HM; const float* wslot;
    __device__ __forceinline__ void operator()(const pg8::f32x4 (&acc)[2][2][4][2], const Unit& u, int wr, int wc, int fr, int fq) const {
        const int j = u.pn & 3; const int row0 = u.pm * 256 + wr * 64 + fr, col0 = j * 128 + wc * 32 + 8 * fq;
        float ws[8];
#pragma unroll
        for (int i = 0; i < 8; ++i) ws[i] = wslot[row0 + (i >> 2) * 128 + (i & 3) * 16];
#pragma unroll
        for (int ai = 0; ai < 2; ++ai)
#pragma unroll
            for (int m = 0; m < 4; ++m) { float h[8];
#pragma unroll
                for (int n = 0; n < 2; ++n)
#pragma unroll
                    for (int x = 0; x < 4; ++x) h[n * 4 + x] = ws[ai * 4 + m] * siluf_(acc[ai][0][m][n][x]) * acc[ai][1][m][n][x];
                v4u w; w.x = pg8::cvt_pk_bf16(h[0], h[1]); w.y = pg8::cvt_pk_bf16(h[2], h[3]); w.z = pg8::cvt_pk_bf16(h[4], h[5]); w.w = pg8::cvt_pk_bf16(h[6], h[7]);
                *(v4u*)(HM + (size_t)(row0 + ai * 128 + m * 16) * DEXP + col0) = w; }
    }
};
struct EpiDown {
    static constexpr bool PERM = true, AFTER_DRAIN = false;
    bf16* YS;
    __device__ __forceinline__ void operator()(const pg8::f32x4 (&acc)[2][2][4][2], const Unit& u, int wr, int wc, int fr, int fq) const {
        const int j = u.pn & 7; const int row0 = u.pm * 256 + wr * 64 + fr, col0 = j * 256 + wc * 32 + 8 * fq;
#pragma unroll
        for (int ai = 0; ai < 2; ++ai)
#pragma unroll
            for (int m = 0; m < 4; ++m) { const int row = row0 + ai * 128 + m * 16;
#pragma unroll
                for (int bj = 0; bj < 2; ++bj) { const pg8::f32x4 v0 = acc[ai][bj][m][0], v1 = acc[ai][bj][m][1];
                    v4u w; w.x = pg8::cvt_pk_bf16(v0[0], v0[1]); w.y = pg8::cvt_pk_bf16(v0[2], v0[3]); w.z = pg8::cvt_pk_bf16(v1[0], v1[1]); w.w = pg8::cvt_pk_bf16(v1[2], v1[3]);
                    *(v4u*)(YS + (size_t)row * DM + col0 + bj * 128) = w; } }
    }
};
struct RowOrder {
    pg8::StaticOrder S; bool latent_only;
    __device__ __forceinline__ bool next(int i, Unit& u) const { if (!S.next(i, u)) return false; if (latent_only) u.pm = u.pm + 1 + (u.pm >= TPB - 1 ? 1 : 0); return true; }
    __device__ __forceinline__ void a_ready(const Unit&) const {}
    __device__ __forceinline__ void done(const Unit&) const {}
};
struct OneUnit {
    int pm, pn;
    __device__ __forceinline__ bool next(int i, Unit& u) const { if (i > 0) return false; u.pm = pm; u.pn = pn; return true; }
    __device__ __forceinline__ void a_ready(const Unit&) const {}
    __device__ __forceinline__ void done(const Unit&) const {}
};

struct Frame {
    LAS unsigned char* lds; unsigned char* ws; const float* const* in;
    int tid, lane, wave, vcu, G;
};
enum { I_X = 0, I_C, I_CTX, I_CCTX, I_MODW, I_MODB, I_NMIX, I_NFFN, I_WIN, I_WOUT, I_RGCW, I_RGCB, I_RGGW, I_RGGB, I_RGLAM, I_SCW, I_POOLW, I_POOLB, I_POOLS, I_DALAM, I_DANORM,
       I_GRPW, I_GRPB, I_EXPW, I_EXPB, I_UP, I_DOWN, I_NFINAL };

__device__ __forceinline__ void transpose_item(const float* W, int K, int N, bf16* WT, int k0, int n0, int n0_out, LAS float* scr, int lane) {
    float v[32];
#pragma unroll
    for (int i = 0; i < 32; ++i) { const int kk = 2 * i + (lane >> 5); v[i] = W[(size_t)(k0 + kk) * N + n0 + (lane & 31)]; }
#pragma unroll
    for (int i = 0; i < 32; ++i) { const int kk = 2 * i + (lane >> 5); scr[kk * 33 + (lane & 31)] = v[i]; }
    LDS_WAIT(); asm volatile("" ::: "memory");
    const int c = lane & 7;
#pragma unroll
    for (int j = 0; j < 4; ++j) { const int n = (lane >> 3) + 8 * j; const LAS float* s = scr + (8 * c) * 33 + n;
        v4u o; o.x = pk2_hw(s[0 * 33], s[1 * 33]); o.y = pk2_hw(s[2 * 33], s[3 * 33]); o.z = pk2_hw(s[4 * 33], s[5 * 33]); o.w = pk2_hw(s[6 * 33], s[7 * 33]);
        *(GAS v4u*)(WT + (size_t)(n0_out + n) * K + k0 + 8 * c) = o; }
    LDS_WAIT(); asm volatile("" ::: "memory");
}
__device__ __forceinline__ void p0_prologue(Frame& F) {
    const int gw = F.vcu * NWAVES + F.wave, NGW = F.G * NWAVES;
    LAS float* S = (LAS float*)(F.lds);
    for (int i = F.tid; i < 3 * DM; i += NWAVES * 64) { const int r = i / DM, k = i % DM; const float c = r < 2 ? F.in[I_C][r * DM + k] : F.in[I_CCTX][k]; S[i] = siluf_(c); }
    __syncthreads();
    {
        float* MODP = (float*)(F.ws + WS_MODP);
        for (int it = gw; it < DEPTH * 48 * KSPLIT; it += NGW) {
            const int kc = it % KSPLIT, nch = (it / KSPLIT) % 48, l = it / (KSPLIT * 48);
            const float* W = F.in[I_MODW] + ((size_t)l * DM + kc * 128) * NMODC + 4 * (nch * 64 + F.lane);
            f32x4 a0 = {0.f, 0.f, 0.f, 0.f}, a1 = a0, a2 = a0;
            for (int k0 = 0; k0 < 128; k0 += 32) {
                f32x4 wv[32];
#pragma unroll
                for (int k = 0; k < 32; ++k) wv[k] = __builtin_nontemporal_load((const GAS f32x4*)(W + (size_t)(k0 + k) * NMODC));
                __builtin_amdgcn_sched_barrier(0);
#pragma unroll
                for (int k = 0; k < 32; ++k) { const int kk = kc * 128 + k0 + k; a0 += wv[k] * S[kk]; a1 += wv[k] * S[DM + kk]; a2 += wv[k] * S[2 * DM + kk]; }
            }
            float* o = MODP + ((size_t)(l * KSPLIT + kc) * 3) * NMODC + 4 * (nch * 64 + F.lane);
            *(f32x4*)o = a0; *(f32x4*)(o + NMODC) = a1; *(f32x4*)(o + 2 * NMODC) = a2;
        }
    }
    __syncthreads();
    {
        LAS float* scr = (LAS float*)(F.lds + F.wave * 16384);
        constexpr int I_IN = 32 * 144, I_OUT = 32 * 64;
        constexpr int PER_L = I_IN + I_OUT;
        for (int it = gw; it < DEPTH * PER_L; it += NGW) {
            const int l = it / PER_L; int r = it % PER_L;
            if (r < I_IN) { const int kb = r / 144, nb = r % 144; transpose_item(F.in[I_WIN] + (size_t)l * DM * PIN, DM, PIN, (bf16*)(F.ws + WS_WIN) + (size_t)l * PIN * DM, 64 * kb, 32 * nb, 32 * nb, scr, F.lane); continue; } r -= I_IN;
            { const int kb = r / 64, nb = r % 64; transpose_item(F.in[I_WOUT] + (size_t)l * DM * DM, DM, DM, (bf16*)(F.ws + WS_WOUT) + (size_t)l * DM * DM, 64 * kb, 32 * nb, 32 * nb, scr, F.lane); }
        }
    }
    {
        const int gt = F.vcu * NWAVES * 64 + F.tid, NGT = F.G * NWAVES * 64;
        bf16* AUXB = (bf16*)(F.ws + WS_AUXB);
        for (int idx0 = gt; idx0 < DEPTH * 12 * 256 * 128; idx0 += 6 * NGT) {
            float vv[6];
#pragma unroll
            for (int u = 0; u < 6; ++u) { const int idx = idx0 + u * NGT; vv[u] = 0.f;
                if (idx < DEPTH * 12 * 256 * 128) { const int k = idx & 127, rr = (idx >> 7) & 255, q = (idx >> 15) % 12, l = idx / (12 * 256 * 128);
                    if (q < 8) { const int blk = q >> 1, dir = q & 1, gate = rr >> 7, e = rr & 127; vv[u] = F.in[I_RGGW][((((size_t)(l * 2 + dir) * 2 + gate) * 4 + blk) * 128 + k) * 128 + e]; }
                    else { const int g = q - 8; vv[u] = rr < 128 ? F.in[I_POOLW][(((size_t)l * 4 + g) * 128 + k) * 128 + rr] * F.in[I_POOLS][l * 512 + g * 128 + rr] : 0.f; } } }
#pragma unroll
            for (int u = 0; u < 6; ++u) { const int idx = idx0 + u * NGT; if (idx < DEPTH * 12 * 256 * 128) AUXB[idx] = (bf16)f2bf(vv[u]); }
        }
        float* SP8 = (float*)(F.ws + WS_WRT) + DEPTH * NROUTE * DM;
        for (int idx = gt; idx < DEPTH * 2 * 512; idx += NGT) SP8[idx] = 8.0f * 1.4426950408889634f * log1pf(__expf(-F.in[I_RGLAM][idx]));
        float* WRT = (float*)(F.ws + WS_WRT);
        for (int idx = gt; idx < DEPTH * NROUTE * DM; idx += NGT) {
            const int k = idx % DM, n = (idx / DM) % NROUTE, l = idx / (DM * NROUTE);
            WRT[idx] = n < 4 ? F.in[I_GRPW][((size_t)l * DM + k) * 4 + n] : F.in[I_EXPW][((size_t)l * DM + k) * 32 + (n - 4)];
        }
    }
}
struct CvtItem { const float* W; bf16* WT; int K, N, k0, n0, n0_out; };
constexpr int CVT_UPE = 32 * 8, CVT_DNE = 8 * 16;
constexpr int CVT_L = NEXP * (CVT_UPE + CVT_DNE);
__device__ __forceinline__ CvtItem moe_item(Frame& F, int it) {
    const int l = it / CVT_L; int r = it % CVT_L; CvtItem c;
    if (r < NEXP * CVT_UPE) { const int e = r / CVT_UPE, q = r % CVT_UPE, kb = q / 8, nb = q % 8; const int n0 = 128 * nb, half = n0 >> 9, jj = (n0 & 511) >> 7;
        c.W = F.in[I_UP] + ((size_t)l * NEXP + e) * DM * 1024; c.WT = (bf16*)(F.ws + WS_UP) + ((size_t)l * NEXP + e) * 1024 * DM; c.K = DM; c.N = 1024; c.k0 = 64 * kb; c.n0 = n0; c.n0_out = jj * 256 + half * 128; }
    else { r -= NEXP * CVT_UPE; const int e = r / CVT_DNE, q = r % CVT_DNE, kb = q / 16, nb = q % 16;
        c.W = F.in[I_DOWN] + ((size_t)l * NEXP + e) * DEXP * DM; c.WT = (bf16*)(F.ws + WS_DOWN) + ((size_t)l * NEXP + e) * DM * DEXP; c.K = DEXP; c.N = DM; c.k0 = 64 * kb; c.n0 = 128 * nb; c.n0_out = 128 * nb; }
    return c;
}
__device__ __forceinline__ void cvt_load(const CvtItem& c, v2u (&v)[32], int lane) {
    const float* p = c.W + (size_t)(c.k0 + (lane >> 5)) * c.N + c.n0 + 4 * (lane & 31); const size_t step = (size_t)2 * c.N;
    f32x4 t[32];
#pragma unroll
    for (int i = 0; i < 32; ++i) { t[i] = __builtin_nontemporal_load((const GAS f32x4*)p); p += step; asm volatile("" : "+v"(p)); }
#pragma unroll
    for (int i = 0; i < 32; ++i) { v[i].x = pk2_hw(t[i].x, t[i].y); v[i].y = pk2_hw(t[i].z, t[i].w); }
}
__device__ __forceinline__ void cvt_finish(const CvtItem& c, const v2u (&v)[32], LAS unsigned char* scr, int lane) {
    constexpr int PT = 264;
#pragma unroll
    for (int i = 0; i < 32; ++i) *(LAS v2u*)(scr + (2 * i + (lane >> 5)) * PT + 8 * (lane & 31)) = v[i];
    LDS_WAIT(); asm volatile("" ::: "memory");
#pragma unroll 4
    for (int q = 0; q < 16; ++q) { const int ci = lane + 64 * q, n = ci >> 3, cq = ci & 7; const LAS unsigned char* s = scr + (8 * cq) * PT + 2 * n;
        v4u o; o.x = (unsigned)*(const LAS unsigned short*)(s) | ((unsigned)*(const LAS unsigned short*)(s + PT) << 16); o.y = (unsigned)*(const LAS unsigned short*)(s + 2 * PT) | ((unsigned)*(const LAS unsigned short*)(s + 3 * PT) << 16);
        o.z = (unsigned)*(const LAS unsigned short*)(s + 4 * PT) | ((unsigned)*(const LAS unsigned short*)(s + 5 * PT) << 16); o.w = (unsigned)*(const LAS unsigned short*)(s + 6 * PT) | ((unsigned)*(const LAS unsigned short*)(s + 7 * PT) << 16);
        __builtin_nontemporal_store(o, (GAS v4u*)(c.WT + (size_t)(c.n0_out + n) * c.K + c.k0 + 8 * cq)); }
    LDS_WAIT(); asm volatile("" ::: "memory");
}
__device__ __forceinline__ void moe_convert_range(Frame& F, int lo, int hi, int rank, int nrank) {
    const int step = nrank * NWAVES;
    LAS unsigned char* scr = F.lds + F.wave * 16896;
    for (int it = lo + rank * NWAVES + F.wave; it < hi; it += step) {
        v2u va[32]; const CvtItem ca = moe_item(F, it); cvt_load(ca, va, F.lane); cvt_finish(ca, va, scr, F.lane);
    }
}
__device__ __forceinline__ void p0b_modreduce(Frame& F) {
    const int gt = F.vcu * NWAVES * 64 + F.tid, NGT = F.G * NWAVES * 64;
    const float* MODP = (const float*)(F.ws + WS_MODP); float* MOD = (float*)(F.ws + WS_MOD);
    for (int idx = gt; idx < DEPTH * 3 * NMODC; idx += NGT) {
        const int n = idx % NMODC, r = (idx / NMODC) % 3, l = idx / (3 * NMODC);
        float s = F.in[I_MODB][l * NMODC + n];
#pragma unroll
        for (int kc = 0; kc < KSPLIT; ++kc) s += MODP[((size_t)(l * KSPLIT + kc) * 3 + r) * NMODC + n];
        MOD[idx] = s;
    }
}
template <int MODE> __device__ __forceinline__ void phase_norm1(Frame& F, int l, float* out) {
    const int gw = F.vcu * NWAVES + F.wave, NGW = F.G * NWAVES;
    bf16* X = (bf16*)(F.ws + WS_X); bf16* H = (bf16*)(F.ws + WS_H); const bf16* YS = (const bf16*)(F.ws + WS_YS);
    const float* MOD = (const float*)(F.ws + WS_MOD); const int* slot = (const int*)(F.ws + WS_ROUTE) + RT_SLOT;
    for (int r = gw; r < T; r += NGW) {
        const int b = r / SEGB, i = r - b * SEGB; const bool isctx = i < NCTX; const int mrow = isctx ? 2 : b;
        if (MODE == 2 && isctx) continue;
        f32x4 v[8];
        if (MODE == 0) {
            const float* src = isctx ? F.in[I_CTX] + ((size_t)b * NCTX + i) * DM : F.in[I_X] + ((size_t)b * LSEQ + (i - NCTX)) * DM;
#pragma unroll
            for (int j = 0; j < 4; ++j) { const int c = 8 * (F.lane + 64 * j); v[2 * j] = *(const GAS f32x4*)(src + c); v[2 * j + 1] = *(const GAS f32x4*)(src + c + 4); }
        } else {
            const int lp = (MODE == 2) ? DEPTH - 1 : l - 1;
            const float* m5 = MOD + ((size_t)lp * 3 + mrow) * NMODC + 5 * DM;
            const int s1 = slot[2 * r], s2 = slot[2 * r + 1];
            const bf16* y1 = YS + (size_t)s1 * DM, *y2 = YS + (size_t)s2 * DM;
#pragma unroll
            for (int j = 0; j < 4; ++j) { const int c = 8 * (F.lane + 64 * j);
                const v4u xw = *(const GAS v4u*)(X + (size_t)r * DM + c), a = *(const GAS v4u*)(y1 + c), bb = *(const GAS v4u*)(y2 + c);
                const f32x4 g0 = *(const GAS f32x4*)(m5 + c), g1 = *(const GAS f32x4*)(m5 + c + 4);
                f32x4 x0, x1, ys0, ys1;
                x0.x = bflo(xw.x); x0.y = bfhi(xw.x); x0.z = bflo(xw.y); x0.w = bfhi(xw.y); x1.x = bflo(xw.z); x1.y = bfhi(xw.z); x1.z = bflo(xw.w); x1.w = bfhi(xw.w);
                ys0.x = bflo(a.x) + bflo(bb.x); ys0.y = bfhi(a.x) + bfhi(bb.x); ys0.z = bflo(a.y) + bflo(bb.y); ys0.w = bfhi(a.y) + bfhi(bb.y);
                ys1.x = bflo(a.z) + bflo(bb.z); ys1.y = bfhi(a.z) + bfhi(bb.z); ys1.z = bflo(a.w) + bflo(bb.w); ys1.w = bfhi(a.w) + bfhi(bb.w);
                v[2 * j] = x0 + g0 * ys0; v[2 * j + 1] = x1 + g1 * ys1; }
        }
        float ss = 0.f;
#pragma unroll
        for (int j = 0; j < 8; ++j) ss += (v[j].x * v[j].x + v[j].y * v[j].y) + (v[j].z * v[j].z + v[j].w * v[j].w);
        const float rstd = 1.0f / sqrtf(wave_sum(ss) * (1.0f / DM) + EPS);
        if (MODE == 2) {
            float* o = out + ((size_t)b * LSEQ + (i - NCTX)) * DM; const float* g = F.in[I_NFINAL];
#pragma unroll
            for (int j = 0; j < 4; ++j) { const int c = 8 * (F.lane + 64 * j); v[2 * j] = v[2 * j] * rstd * *(const GAS f32x4*)(g + c); v[2 * j + 1] = v[2 * j + 1] * rstd * *(const GAS f32x4*)(g + c + 4); }
#pragma unroll
            for (int j = 0; j < 4; ++j) { const int c = 8 * (F.lane + 64 * j); *(GAS f32x4*)(o + c) = v[2 * j]; *(GAS f32x4*)(o + c + 4) = v[2 * j + 1]; }
        } else {
            const float* g = F.in[I_NMIX] + (size_t)l * DM; const float* sh = MOD + ((size_t)l * 3 + mrow) * NMODC, *sc = sh + DM;
            v4u hw[4];
            f32x4 gg[8], cc[8], ss[8];
#pragma unroll
            for (int j = 0; j < 4; ++j) { const int c = 8 * (F.lane + 64 * j);
                gg[2 * j] = *(const GAS f32x4*)(g + c); gg[2 * j + 1] = *(const GAS f32x4*)(g + c + 4); cc[2 * j] = *(const GAS f32x4*)(sc + c); cc[2 * j + 1] = *(const GAS f32x4*)(sc + c + 4);
                ss[2 * j] = *(const GAS f32x4*)(sh + c); ss[2 * j + 1] = *(const GAS f32x4*)(sh + c + 4); }
            asm volatile("" : "+v"(gg[0]), "+v"(gg[7]), "+v"(cc[0]), "+v"(cc[7]), "+v"(ss[0]), "+v"(ss[7]));
#pragma unroll
            for (int j = 0; j < 4; ++j) {
                const f32x4 h0 = v[2 * j] * rstd * gg[2 * j] * (cc[2 * j] + 1.0f) + ss[2 * j];
                const f32x4 h1 = v[2 * j + 1] * rstd * gg[2 * j + 1] * (cc[2 * j + 1] + 1.0f) + ss[2 * j + 1];
                hw[j].x = pk2(h0.x, h0.y); hw[j].y = pk2(h0.z, h0.w); hw[j].z = pk2(h1.x, h1.y); hw[j].w = pk2(h1.z, h1.w); }
#pragma unroll
            for (int j = 0; j < 4; ++j) { const int c = 8 * (F.lane + 64 * j);
                if (MODE != 0) { v4u xw; xw.x = pk2(v[2 * j].x, v[2 * j].y); xw.y = pk2(v[2 * j].z, v[2 * j].w); xw.z = pk2(v[2 * j + 1].x, v[2 * j + 1].y); xw.w = pk2(v[2 * j + 1].z, v[2 * j + 1].w);
                    *(GAS v4u*)(X + (size_t)r * DM + c) = xw; }
                *(GAS v4u*)(H + (size_t)r * DM + c) = hw[j]; }
        }
    }
}
__device__ __forceinline__ void unpack8(const v4u w, float (&f)[8]) { f[0] = bflo(w.x); f[1] = bfhi(w.x); f[2] = bflo(w.y); f[3] = bfhi(w.y); f[4] = bflo(w.z); f[5] = bfhi(w.z); f[6] = bflo(w.w); f[7] = bfhi(w.w); }
__device__ __forceinline__ v4u pack8f(const float (&f)[8]) { v4u w; w.x = pk2(f[0], f[1]); w.y = pk2(f[2], f[3]); w.z = pk2(f[4], f[5]); w.w = pk2(f[6], f[7]); return w; }
__device__ __forceinline__ void phase_prep(Frame& F, int l) {
    const bf16* P = (const bf16*)(F.ws + WS_P); bf16* AUXA = (bf16*)(F.ws + WS_AUXA); bf16* YB = (bf16*)(F.ws + WS_YB);
    bf16* QP = (bf16*)(F.ws + WS_QP); bf16* KP = (bf16*)(F.ws + WS_KP); bf16* VT = (bf16*)(F.ws + WS_VT);
    const int tid = F.tid, lane = F.lane, cg = tid & 63, tw = tid >> 6;
    LAS unsigned char* vl = F.lds;
    constexpr int VP = 1040;
    for (int it = F.vcu; it < NBATCH * CH64 * 5; it += F.G) {
        const int u = it / 5, st = it - 5 * u;
        const int b = u / CH64, cj = u % CH64; const bool isctx = cj < 4;
        const int seg0 = b * SEGB + (isctx ? 0 : NCTX), seglen = isctx ? NCTX : LSEQ, s0 = (isctx ? cj : cj - 4) * 64;
        const int r0 = seg0 + s0;
        const v4u zero4 = {0u, 0u, 0u, 0u};
#define LDV(s, col) (((s) >= 0 && (s) < seglen) ? *(const GAS v4u*)(P + (size_t)(seg0 + (s)) * PIN + (col)) : zero4)
        if (st == 0) {
            const int c0 = 8 * cg, t0 = s0 + 8 * tw; float w0[8], w1[8], w2[8], w3[8], bs[8];
            const float* cw = F.in[I_RGCW] + (size_t)l * 4 * 512 + c0;
#pragma unroll
            for (int i = 0; i < 8; ++i) { w0[i] = cw[i]; w1[i] = cw[512 + i]; w2[i] = cw[1024 + i]; w3[i] = cw[1536 + i]; bs[i] = F.in[I_RGCB][l * 512 + c0 + i]; }
            float xa[8], xb[8], xc[8], xd[8]; v4u raw[11];
#pragma unroll
            for (int t = 0; t < 11; ++t) raw[t] = LDV(t0 - 2 + t, c0);
            unpack8(raw[0], xa); unpack8(raw[1], xb); unpack8(raw[2], xc);
            bf16* o = AUXA + ((size_t)(cg >> 4) * T + (r0 + 8 * tw)) * 128 + (cg & 15) * 8;
#pragma unroll
            for (int t = 0; t < 8; ++t) { unpack8(raw[t + 3], xd); float y[8];
#pragma unroll
                for (int i = 0; i < 8; ++i) { y[i] = bs[i] + w0[i] * xa[i] + w1[i] * xb[i] + w2[i] * xc[i] + w3[i] * xd[i]; xa[i] = xb[i]; xb[i] = xc[i]; xc[i] = xd[i]; }
                *(GAS v4u*)(o + (size_t)t * 128) = pack8f(y); }
        }
        if (st == 1) {
            const int c0 = 8 * cg; float w0[8], w1[8], w2[8];
            const float* sw = F.in[I_SCW] + (size_t)l * 3 * 512 + c0;
#pragma unroll
            for (int i = 0; i < 8; ++i) { w0[i] = sw[i]; w1[i] = sw[512 + i]; w2[i] = sw[1024 + i]; }
#pragma unroll 1
            for (int hf = 0; hf < 2; ++hf) {
                const int t0 = s0 + 8 * tw + 4 * hf; float za[8], zb[8], zc[8], p1[8], p2[8]; v4u rc[6], rx[6], rb[4];
#pragma unroll
                for (int t = 0; t < 6; ++t) { rc[t] = LDV(t0 - 1 + t, 1536 + c0); rx[t] = LDV(t0 - 1 + t, 2048 + c0); }
#pragma unroll
                for (int t = 0; t < 4; ++t) rb[t] = LDV(t0 + t, 1024 + c0);
                unpack8(rc[0], p1); unpack8(rx[0], p2);
#pragma unroll
                for (int i = 0; i < 8; ++i) za[i] = p1[i] * p2[i];
                unpack8(rc[1], p1); unpack8(rx[1], p2);
#pragma unroll
                for (int i = 0; i < 8; ++i) zb[i] = p1[i] * p2[i];
#pragma unroll
                for (int t = 0; t < 4; ++t) { unpack8(rc[t + 2], p1); unpack8(rx[t + 2], p2); float bb[8], y[8]; unpack8(rb[t], bb);
#pragma unroll
                    for (int i = 0; i < 8; ++i) { zc[i] = p1[i] * p2[i]; y[i] = bb[i] * (w0[i] * za[i] + w1[i] * zb[i] + w2[i] * zc[i]); za[i] = zb[i]; zb[i] = zc[i]; }
                    *(GAS v4u*)(YB + (size_t)(r0 + 8 * tw + 4 * hf + t) * DM + 512 + c0) = pack8f(y); }
            }
        }
        if (st == 2) {
            const int g = tw & 3, th = tw >> 2, hw = 1 << g, c0 = 2560 + g * 128 + 8 * (lane & 15), tl0 = 32 * th + 8 * (lane >> 4), t0 = s0 + tl0;
            float sum[8], xv[8];
#pragma unroll
            for (int i = 0; i < 8; ++i) sum[i] = 0.f;
            { v4u wv[16];
#pragma unroll
              for (int k = 0; k < 16; ++k) wv[k] = (k < 2 * hw) ? LDV(t0 - hw + k, c0) : zero4;
#pragma unroll
              for (int k = 0; k < 16; ++k) { unpack8(wv[k], xv);
#pragma unroll
                for (int i = 0; i < 8; ++i) sum[i] += xv[i]; } }
            bf16* o = AUXA + ((size_t)(4 + g) * T + (r0 + tl0)) * 128 + 8 * (lane & 15);
#pragma unroll 1
            for (int hf = 0; hf < 2; ++hf) {
            v4u rv[4], re[4], rl[4];
#pragma unroll
            for (int t = 0; t < 4; ++t) { rv[t] = LDV(t0 + 4 * hf + t, c0); re[t] = LDV(t0 + 4 * hf + t + hw, c0); rl[t] = LDV(t0 + 4 * hf + t - hw, c0); }
#pragma unroll
            for (int t = 0; t < 4; ++t) { const int s = t0 + 4 * hf + t; const int lo = s - hw < 0 ? 0 : s - hw, hi = s + hw > seglen ? seglen : s + hw; const float rc = 1.0f / (float)(hi - lo);
                float y[8], xe[8], xl[8]; unpack8(rv[t], xv); unpack8(re[t], xe); unpack8(rl[t], xl);
#pragma unroll
                for (int i = 0; i < 8; ++i) { y[i] = sum[i] * rc - xv[i]; sum[i] += xe[i] - xl[i]; }
                *(GAS v4u*)(o + (size_t)(4 * hf + t) * 128) = pack8f(y); }
            }
        }
        if (st == 3) {
            const int vec = tid & 127, tq = tid >> 7, which = vec >> 6, hc = (vec >> 3) & 7, dg = vec & 7, axis = dg >> 2, part = (dg >> 1) & 1, jj0 = (dg & 1) * 8;
            const int col = 3072 + 8 * vec, pcol = 3072 + 8 * (vec ^ 2);
            bf16* dst = (which ? KP : QP) + ((size_t)(b * 8 + hc) * SEGB + cj * 64 + 16 * tq) * 64 + 8 * dg;
            const float scl = which ? 1.0f : QSCALE; const float sgn = part ? 1.0f : -1.0f;
            float inv[8];
#pragma unroll
            for (int i = 0; i < 8; ++i) inv[i] = __builtin_amdgcn_exp2f(-(float)(jj0 + i) * (13.287712379549449f / 16.0f)) * 0.15915494309189535f;
            for (int tg = 0; tg < 16; tg += 8) {
            v4u ro[8], rp[8];
#pragma unroll
            for (int t = 0; t < 8; ++t) { ro[t] = *(const GAS v4u*)(P + (size_t)(r0 + 16 * tq + tg + t) * PIN + col); rp[t] = *(const GAS v4u*)(P + (size_t)(r0 + 16 * tq + tg + t) * PIN + pcol); }
#pragma unroll
            for (int t8 = 0; t8 < 8; ++t8) { const int t = tg + t8; const int tl = 16 * tq + t; float xo[8], xp[8], y[8];
                unpack8(ro[t8], xo); unpack8(rp[t8], xp);
                if (!isctx) { const float pos = (float)(axis ? ((s0 + tl) & 63) : ((s0 + tl) >> 6));
#pragma unroll
                    for (int i = 0; i < 8; ++i) { const float rev = pos * inv[i]; const float sn = __builtin_amdgcn_sinf(rev), cs = __builtin_amdgcn_cosf(rev); y[i] = (xo[i] * cs + sgn * xp[i] * sn) * scl; }
                } else {
#pragma unroll
                    for (int i = 0; i < 8; ++i) y[i] = xo[i] * scl;
                }
                *(GAS v4u*)(dst + (size_t)t * 64) = pack8f(y); }
            }
        }
        if (st == 4) {
            __syncthreads();
            v4u vr[8];
#pragma unroll
            for (int t = 0; t < 8; ++t) vr[t] = *(const GAS v4u*)(P + (size_t)(r0 + 8 * tw + t) * PIN + 4096 + 8 * cg);
#pragma unroll
            for (int t = 0; t < 8; ++t) *(LAS v4u*)(vl + (8 * tw + t) * VP + 16 * cg) = vr[t];
            __syncthreads();
            const int h = tid >> 7, e = tid & 127; unsigned w[32];
#pragma unroll
            for (int i = 0; i < 32; ++i) w[i] = 0u;
#pragma unroll
            for (int t = 0; t < 64; ++t) { const int q = t & 15, pq = (q & 3) | ((q & 4) << 1) | ((q & 8) >> 1); const int kvp = (t & 48) + pq;
                const unsigned v = *(const LAS unsigned short*)(vl + t * VP + 2 * tid); w[kvp >> 1] |= v << (16 * (kvp & 1)); }
            v4u* o = (v4u*)(VT + (((size_t)(b * 4 + h) * CH64 + cj) * 128 + e) * 64);
#pragma unroll
            for (int i = 0; i < 8; ++i) { v4u x; x.x = w[4 * i]; x.y = w[4 * i + 1]; x.z = w[4 * i + 2]; x.w = w[4 * i + 3]; o[i] = x; }
        }
#undef LDV
    }
    __syncthreads();
}
__device__ __forceinline__ void phase_scan1(Frame& F, int l) {
    const bf16* G = (const bf16*)(F.ws + WS_G); float* SUM = (float*)(F.ws + WS_SUM);
    const int ch = F.tid, blk = ch >> 7, e = ch & 127;
    for (int u = F.vcu; u < NBATCH * 2 * CH64; u += F.G) {
        const int cj = u % CH64, dir = (u / CH64) & 1, b = u / (2 * CH64); const int r0 = b * SEGB + cj * 64;
        const bf16* g = G + (size_t)r0 * DM + blk * 512 + dir * 256 + e;
        float h = 0.f, ls = 0.f;
        for (int tb = 0; tb < 64; tb += 32) {
            unsigned short ql[32], qx[32];
#pragma unroll
            for (int i = 0; i < 32; ++i) { const int tt = dir ? 63 - (tb + i) : tb + i; ql[i] = g[(size_t)tt * DM]; qx[i] = g[(size_t)tt * DM + 128]; }
#pragma unroll
            for (int i = 0; i < 32; ++i) { const float l2 = bf2f(ql[i]); h = __builtin_amdgcn_exp2f(l2) * h + bf2f(qx[i]); ls += l2; }
        }
        float* o = SUM + ((size_t)((b * 2 + dir) * CH64 + cj) * 2) * 512 + ch; o[0] = __builtin_amdgcn_exp2f(ls); o[512] = h;
    }
}
__device__ __forceinline__ void phase_scan2(Frame& F, int l) {
    { int* s2t = (int*)(F.ws + WS_ROUTE) + RT_S2T; for (int i = F.vcu * NWAVES * 64 + F.tid; i < SLOT_CAP; i += F.G * NWAVES * 64) s2t[i] = 0; }
    const bf16* G = (const bf16*)(F.ws + WS_G); const float* SUM = (const float*)(F.ws + WS_SUM);
    const bf16* P = (const bf16*)(F.ws + WS_P); bf16* YB = (bf16*)(F.ws + WS_YB);
    LAS float* HF = (LAS float*)F.lds;
    const int ch = F.tid, blk = ch >> 7, e = ch & 127;
    const bool skipctx = (l == DEPTH - 1);
    const int nun = skipctx ? NBATCH * (CH64 - 4) : NBATCH * CH64;
    for (int u = F.vcu; u < nun; u += F.G) {
        const int b = skipctx ? u / (CH64 - 4) : u / CH64, cj = skipctx ? 4 + u % (CH64 - 4) : u % CH64; const int r0 = b * SEGB + cj * 64;
        float hf = 0.f, hb = 0.f;
        { const float* S0 = SUM + ((size_t)((b * 2 + 0) * CH64) * 2) * 512 + ch; const float* S1 = SUM + ((size_t)((b * 2 + 1) * CH64) * 2) * 512 + ch;
          const int nf = cj, nb = cj < 4 ? 3 - cj : 135 - cj; const int nmax = nf > nb ? nf : nb;
          for (int p0 = 0; p0 < nmax; p0 += 32) {
              float fa[32], fb[32], ba[32], bb[32];
#pragma unroll
              for (int i = 0; i < 32; ++i) { const int pp = p0 + i; const bool vf = pp < nf, vb = pp < nb; const int p = pp < CH64 ? pp : CH64 - 1; const int cb = p < 4 ? 3 - p : 135 - p;
                  fa[i] = vf ? S0[(size_t)p * 1024] : 1.f; fb[i] = vf ? S0[(size_t)p * 1024 + 512] : 0.f;
                  ba[i] = vb ? S1[(size_t)cb * 1024] : 1.f; bb[i] = vb ? S1[(size_t)cb * 1024 + 512] : 0.f; }
#pragma unroll
              for (int i = 0; i < 32; ++i) { hf = fa[i] * hf + fb[i]; hb = ba[i] * hb + bb[i]; }
          } }
        __syncthreads();
        const bf16* gf = G + (size_t)r0 * DM + blk * 512 + e; const bf16* gb = gf + 256;
        for (int tb = 0; tb < 64; tb += 32) {
            unsigned short fl[32], fx[32];
#pragma unroll
            for (int i = 0; i < 32; ++i) { fl[i] = gf[(size_t)(tb + i) * DM]; fx[i] = gf[(size_t)(tb + i) * DM + 128]; }
#pragma unroll
            for (int i = 0; i < 32; ++i) { hf = __builtin_amdgcn_exp2f(bf2f(fl[i])) * hf + bf2f(fx[i]); HF[(tb + i) * 512 + ch] = hf; }
        }
        for (int tb = 32; tb >= 0; tb -= 32) {
            unsigned short ql[32], qb[32], qa[32];
#pragma unroll
            for (int i = 0; i < 32; ++i) { ql[i] = gb[(size_t)(tb + i) * DM]; qb[i] = gb[(size_t)(tb + i) * DM + 128]; qa[i] = P[(size_t)(r0 + tb + i) * PIN + 512 + ch]; }
#pragma unroll
            for (int i = 31; i >= 0; --i) { hb = __builtin_amdgcn_exp2f(bf2f(ql[i])) * hb + bf2f(qb[i]);
                YB[(size_t)(r0 + tb + i) * DM + ch] = (bf16)f2bf(gelu_tanh(bf2f(qa[i])) * (HF[(tb + i) * 512 + ch] + hb)); }
        }
    }
    __syncthreads();
}

namespace att {
#ifndef ATT_BIG
#define ATT_BIG 16777216.0f
#endif
constexpr int SLOT = 65536, K1_OFF = 16384, V_OFF = 32768;
static_assert(2 * SLOT <= RING_BYTES, "attention LDS");
__device__ __forceinline__ bf16x8 pack8(const f32x16& p, int o) {
    v4u w; w.x = pg8::cvt_pk_bf16(p[o], p[o + 1]); w.y = pg8::cvt_pk_bf16(p[o + 2], p[o + 3]); w.z = pg8::cvt_pk_bf16(p[o + 4], p[o + 5]); w.w = pg8::cvt_pk_bf16(p[o + 6], p[o + 7]);
    return __builtin_bit_cast(bf16x8, w);
}
__device__ __forceinline__ void glds16(const void* sbase, unsigned voff, unsigned lds_dst) { unsigned keep;
    asm volatile("s_mov_b32 %0, m0\n\ts_mov_b32 m0, %3\n\ts_nop 0\n\tglobal_load_lds_dwordx4 %1, %2\n\ts_mov_b32 m0, %0" : "=&s"(keep) : "v"(voff), "s"(sbase), "s"(lds_dst) : "memory"); }
__device__ __forceinline__ float fadd_s(float a, float b) { float r; asm("v_add_f32_e32 %0, %1, %2" : "=v"(r) : "v"(a), "v"(b)); return r; }
__device__ __forceinline__ float max3f(float a, float b, float c) { float r; asm("v_max3_f32 %0, %1, %2, %3" : "=v"(r) : "v"(a), "v"(b), "v"(c)); return r; }
__device__ __forceinline__ float xhalf_max(float m) { auto rr = __builtin_amdgcn_permlane32_swap(__float_as_uint(m), __float_as_uint(m), false, false); return fmaxf(__uint_as_float(rr[0]), __uint_as_float(rr[1])); }
__device__ __forceinline__ float xhalf_sum(float m) { auto rr = __builtin_amdgcn_permlane32_swap(__float_as_uint(m), __float_as_uint(m), false, false); return __uint_as_float(rr[0]) + __uint_as_float(rr[1]); }
__device__ __forceinline__ float max16(const f32x16& p) {
    float a = max3f(p[0], p[1], p[2]), b = max3f(p[3], p[4], p[5]), c = max3f(p[6], p[7], p[8]), d = max3f(p[9], p[10], p[11]);
    a = max3f(a, p[12], p[13]); b = max3f(b, p[14], p[15]); c = fmaxf(c, d); return max3f(a, b, c);
}
}
template <int AB> __device__ __forceinline__ void phase_attn(Frame& F, int l) {
    using namespace att;
    const bf16* QP = (const bf16*)(F.ws + WS_QP); const bf16* KP = (const bf16*)(F.ws + WS_KP); const bf16* VT = (const bf16*)(F.ws + WS_VT); bf16* YB = (bf16*)(F.ws + WS_YB);
    const int lane = F.lane, r32 = lane & 31, hi = lane >> 5, wave = F.wave, c = wave >> 2, g = wave & 3;
    const float lam_init = 0.8f - 0.6f * __expf(-0.3f * (float)l);
    float lam;
    { const float* lp = F.in[I_DALAM] + (size_t)l * 256; const float s01 = wave_sum(lp[lane] * lp[64 + lane]), s23 = wave_sum(lp[128 + lane] * lp[192 + lane]); lam = __expf(s01) - __expf(s23) + lam_init; }
    const float* dan = F.in[I_DANORM] + (size_t)l * 128;
    LAS unsigned char* lds = F.lds; const unsigned lds0 = (unsigned)(size_t)lds;
    int foff[4];
#pragma unroll
    for (int s = 0; s < 4; ++s) foff[s] = r32 * 128 + (((2 * s + hi) ^ ((r32 >> 1) & 7)) << 4);
    constexpr int NLAT = NBATCH * 4 * (LSEQ / 128);
    constexpr int NU = NLAT + NBATCH * 4 * 2;
    const int conv_slot = F.vcu % 3; bool conv_done = false;
    const int gsz = F.G;
    const int cv_lo0 = l * CVT_L;
    for (int it = 0;; ++it) {
        if (it == conv_slot) { __syncthreads(); moe_convert_range(F, cv_lo0, cv_lo0 + CVT_L, F.vcu, F.G); __syncthreads(); conv_done = true; }
        int bh, qb, i0, nt;
        if (gsz == 256) {
            if (it < 2) { bh = F.vcu >> 5; qb = (F.vcu & 31) + 32 * it; i0 = NCTX + qb * 128; nt = SEGB / 128; }
            else if (it == 2 && F.vcu < 16 && l < DEPTH - 1) { bh = F.vcu >> 1; qb = F.vcu & 1; i0 = qb * 128; nt = NCTX / 128; }
            else break;
        } else {
            const int u = it * gsz + F.vcu; if (u >= NU) break;
            if (u < NLAT) { bh = u >> 6; qb = u & 63; i0 = NCTX + qb * 128; nt = SEGB / 128; } else { const int v = u - NLAT; bh = v >> 1; qb = v & 1; i0 = qb * 128; nt = NCTX / 128; }
        }
        const int b = bh >> 2, h = bh & 3;
        bf16x8 qf[4];
        { const bf16* qrow = QP + ((size_t)(bh * 2 + c) * SEGB + i0 + g * 32 + r32) * 64 + 8 * hi;
#pragma unroll
          for (int s = 0; s < 4; ++s) qf[s] = *(const GAS bf16x8*)(qrow + 16 * s); }
        unsigned voff[8];
#pragma unroll
        for (int q = 0; q < 8; ++q) { const int pp = (wave * 8 + q) & 15; const int row = 8 * pp + (lane >> 3), ch = (lane & 7) ^ ((row >> 1) & 7); voff[q] = (unsigned)(row * 128 + ch * 16); }
        const char* kbase0 = (const char*)(KP + (size_t)(bh * 2) * SEGB * 64); const char* vbase0 = (const char*)(VT + (size_t)bh * CH64 * 8192);
        const int reg = wave >> 1;
        const char* rbase = reg >= 2 ? vbase0 + (reg - 2) * 16384 : kbase0 + (size_t)reg * SEGB * 128;
        const unsigned dst0 = lds0 + reg * 16384 + ((wave * 8) & 15) * 1024;
        const int rstride = reg >= 2 ? 32768 : 16384;
#define ATT_DMA(jt) do { const char* sb_ = rbase + (size_t)(jt) * rstride; const unsigned d_ = dst0 + ((jt) & 1) * SLOT; _Pragma("unroll") for (int q_ = 0; q_ < 8; ++q_) \
            glds16(sb_, voff[q_], (unsigned)__builtin_amdgcn_readfirstlane((int)(d_ + q_ * 1024))); } while (0)
        f32x16 o0 = {}, o1 = {}, o2 = {}, o3 = {}, negm = {};
        float mref = 0.f, lsum = 0.f;
        VM_WAIT();
        asm volatile("" : "+v"(qf[0]), "+v"(qf[1]), "+v"(qf[2]), "+v"(qf[3]));
        ATT_DMA(0);
#define ATT_PVH(oa, ob, base_, pa, pb, pc, pd) do { bf16x8 vf_[8]; __builtin_amdgcn_sched_barrier(0); \
            _Pragma("unroll") for (int i_ = 0; i_ < 8; ++i_) vf_[i_] = *(const LAS bf16x8*)((base_) + (i_ >> 2) * 4096 + foff[i_ & 3]);         \
            __builtin_amdgcn_sched_barrier(0); \
            oa = __builtin_amdgcn_mfma_f32_32x32x16_bf16(vf_[0], pa, oa, 0, 0, 0); ob = __builtin_amdgcn_mfma_f32_32x32x16_bf16(vf_[4], pa, ob, 0, 0, 0); \
            oa = __builtin_amdgcn_mfma_f32_32x32x16_bf16(vf_[1], pb, oa, 0, 0, 0); ob = __builtin_amdgcn_mfma_f32_32x32x16_bf16(vf_[5], pb, ob, 0, 0, 0); \
            oa = __builtin_amdgcn_mfma_f32_32x32x16_bf16(vf_[2], pc, oa, 0, 0, 0); ob = __builtin_amdgcn_mfma_f32_32x32x16_bf16(vf_[6], pc, ob, 0, 0, 0); \
            oa = __builtin_amdgcn_mfma_f32_32x32x16_bf16(vf_[3], pd, oa, 0, 0, 0); ob = __builtin_amdgcn_mfma_f32_32x32x16_bf16(vf_[7], pd, ob, 0, 0, 0); \
            __builtin_amdgcn_sched_barrier(0); } while (0)
        for (int j = 0; j < nt; ++j) {
            asm volatile("s_waitcnt vmcnt(0)" ::: "memory");
            __builtin_amdgcn_s_barrier(); asm volatile("" ::: "memory");
            if (j + 1 < nt) ATT_DMA(j + 1);
            if ((AB & 64) && c == 1) continue;
            const LAS unsigned char* st = lds + (j & 1) * SLOT;
            const LAS unsigned char* kb = st + c * K1_OFF;
            f32x16 p0, p1, p2, p3;
#define ATT_QK(pa, kbase_) do { bf16x8 ka[4]; __builtin_amdgcn_sched_barrier(0); \
              _Pragma("unroll") for (int s_ = 0; s_ < 4; ++s_) ka[s_] = *(const LAS bf16x8*)((kbase_) + foff[s_]); \
              __builtin_amdgcn_sched_barrier(0); \
              pa = negm; \
              _Pragma("unroll") for (int s_ = 0; s_ < 4; ++s_) pa = __builtin_amdgcn_mfma_f32_32x32x16_bf16(ka[s_], qf[s_], pa, 0, 0, 0); \
              __builtin_amdgcn_sched_barrier(0); } while (0)
#define ATT_QK4() do { ATT_QK(p0, kb); ATT_QK(p1, kb + 4096); ATT_QK(p2, kb + 8192); ATT_QK(p3, kb + 12288); } while (0)
#define ATT_RAISE(first) do { asm volatile("s_nop 15\n\ts_nop 7" : "+v"(p0), "+v"(p1), "+v"(p2), "+v"(p3));     \
              const float mx_ = xhalf_max(fmaxf(fmaxf(max16(p0), max16(p1)), fmaxf(max16(p2), max16(p3)))); \
              const float dl_ = (first) ? mx_ : fmaxf(mx_, 0.f); mref += dl_; const float f_ = (first) ? 0.f : __builtin_amdgcn_exp2f(-dl_); lsum *= f_; \
              _Pragma("unroll") for (int r_ = 0; r_ < 16; ++r_) { p0[r_] -= dl_; p1[r_] -= dl_; p2[r_] -= dl_; p3[r_] -= dl_; o0[r_] *= f_; o1[r_] *= f_; o2[r_] *= f_; o3[r_] *= f_; negm[r_] = -mref; } } while (0)
#define ATT_EXPSUM() do {   \
              _Pragma("unroll") for (int r_ = 0; r_ < 16; ++r_) p0[r_] = __builtin_amdgcn_exp2f(p0[r_]); __builtin_amdgcn_sched_barrier(0); \
              _Pragma("unroll") for (int r_ = 0; r_ < 16; ++r_) p1[r_] = __builtin_amdgcn_exp2f(p1[r_]); __builtin_amdgcn_sched_barrier(0); \
              _Pragma("unroll") for (int r_ = 0; r_ < 16; ++r_) p2[r_] = __builtin_amdgcn_exp2f(p2[r_]); __builtin_amdgcn_sched_barrier(0); \
              _Pragma("unroll") for (int r_ = 0; r_ < 16; ++r_) p3[r_] = __builtin_amdgcn_exp2f(p3[r_]); \
              __builtin_amdgcn_sched_barrier(0); asm volatile("s_nop 0"); __builtin_amdgcn_sched_barrier(0);       \
              float sa_ = p0[0], sb_ = p1[0], sc_ = p2[0], sd_ = p3[0];         \
              _Pragma("unroll") for (int r_ = 1; r_ < 16; ++r_) { sa_ = fadd_s(sa_, p0[r_]); sb_ = fadd_s(sb_, p1[r_]); sc_ = fadd_s(sc_, p2[r_]); sd_ = fadd_s(sd_, p3[r_]); } \
              ts = fadd_s(fadd_s(sa_, sb_), fadd_s(sc_, sd_)); } while (0)
            ATT_QK4();
            float ts;
            if (j == 0) ATT_RAISE(true);
            ATT_EXPSUM();
            if (__any(!(ts < ATT_BIG))) { ATT_QK4(); ATT_RAISE(false); ATT_EXPSUM(); }
            lsum += ts;
#undef ATT_QK4
#undef ATT_RAISE
#undef ATT_EXPSUM
#undef ATT_QK
            const bf16x8 pa0 = pack8(p0, 0), pa1 = pack8(p0, 8), pa2 = pack8(p1, 0), pa3 = pack8(p1, 8), pb0 = pack8(p2, 0), pb1 = pack8(p2, 8), pb2 = pack8(p3, 0), pb3 = pack8(p3, 8);
            const LAS unsigned char* vb = st + V_OFF;
            ATT_PVH(o0, o1, vb, pa0, pa1, pa2, pa3); ATT_PVH(o2, o3, vb + 8192, pa0, pa1, pa2, pa3);
            ATT_PVH(o0, o1, vb + 16384, pb0, pb1, pb2, pb3); ATT_PVH(o2, o3, vb + 16384 + 8192, pb0, pb1, pb2, pb3);
        }
#undef ATT_PVH
#undef ATT_DMA
        LDS_WAIT(); __builtin_amdgcn_s_barrier(); asm volatile("" ::: "memory");
        lsum = xhalf_sum(lsum);
        const float inv = 1.0f / lsum;
        LAS float* xch = (LAS float*)lds + g * 4096 + lane;
        if (c == 1) {
            const float f = inv * lam;
#pragma unroll
            for (int r = 0; r < 16; ++r) { xch[(0 * 16 + r) * 64] = o0[r] * f; xch[(1 * 16 + r) * 64] = o1[r] * f; xch[(2 * 16 + r) * 64] = o2[r] * f; xch[(3 * 16 + r) * 64] = o3[r] * f; }
        }
        __syncthreads();
        if (c == 0) {
            float ss = 0.f;
#pragma unroll
            for (int r = 0; r < 16; ++r) { o0[r] = o0[r] * inv - xch[(0 * 16 + r) * 64]; o1[r] = o1[r] * inv - xch[(1 * 16 + r) * 64]; o2[r] = o2[r] * inv - xch[(2 * 16 + r) * 64]; o3[r] = o3[r] * inv - xch[(3 * 16 + r) * 64];
                ss += (o0[r] * o0[r] + o1[r] * o1[r]) + (o2[r] * o2[r] + o3[r] * o3[r]); }
            ss = xhalf_sum(ss);
            const float rs = (1.0f / sqrtf(ss * (1.0f / 128.0f) + EPS)) * (1.0f - lam_init);
            bf16* orow = YB + (size_t)(b * SEGB + i0 + g * 32 + r32) * DM + 1536 + h * 128 + 4 * hi;
            v2u ow[16];
#define ATT_ST(oacc, db) do { _Pragma("unroll") for (int rq = 0; rq < 4; ++rq) { const int d0 = (db) * 32 + 8 * rq + 4 * hi; const f32x4 nv = *(const GAS f32x4*)(dan + d0); \
                ow[(db) * 4 + rq].x = pk2(oacc[4 * rq] * rs * nv.x, oacc[4 * rq + 1] * rs * nv.y); ow[(db) * 4 + rq].y = pk2(oacc[4 * rq + 2] * rs * nv.z, oacc[4 * rq + 3] * rs * nv.w); } } while (0)
            ATT_ST(o0, 0); ATT_ST(o1, 1); ATT_ST(o2, 2); ATT_ST(o3, 3);
#undef ATT_ST
#pragma unroll
            for (int k = 0; k < 16; ++k) *(GAS v2u*)(orow + (k >> 2) * 32 + 8 * (k & 3)) = ow[k];
        }
        __syncthreads();
    }
    if (conv_slot >= 0 && !conv_done) { __syncthreads(); moe_convert_range(F, cv_lo0, cv_lo0 + CVT_L, F.vcu, F.G); __syncthreads(); }
}
constexpr size_t WQ_ELEMS = (size_t)DEPTH * 3 * 48 * DM;
__device__ __forceinline__ void router_tables(Frame& F) {
    bf16* WQH = (bf16*)(F.ws + WS_MODP); bf16* WQL = WQH + WQ_ELEMS; float* CC = (float*)(WQL + WQ_ELEMS);
    const float* MOD = (const float*)(F.ws + WS_MOD); const float* WRT = (const float*)(F.ws + WS_WRT);
    const int gt = F.vcu * NWAVES * 64 + F.tid, NGT = F.G * NWAVES * 64;
    for (int idx0 = gt; idx0 < (int)WQ_ELEMS; idx0 += 5 * NGT) {
        float wv[5];
#pragma unroll
        for (int q = 0; q < 5; ++q) { const int idx = idx0 + q * NGT; wv[q] = 0.f;
            if (idx < (int)WQ_ELEMS) { const int k = idx % DM, n = (idx / DM) % 48, mr = (idx / (DM * 48)) % 3, l = idx / (DM * 48 * 3);
                if (n < NROUTE) { const float a = F.in[I_NFFN][l * DM + k] * (1.0f + MOD[((size_t)l * 3 + mr) * NMODC + 4 * DM + k]); wv[q] = a * WRT[((size_t)l * NROUTE + n) * DM + k]; } } }
#pragma unroll
        for (int q = 0; q < 5; ++q) { const int idx = idx0 + q * NGT;
            if (idx < (int)WQ_ELEMS) { const float w = wv[q]; const unsigned h = f2bf(w); const float rem = w - bf2f(h); WQH[idx] = (bf16)h; WQL[idx] = (bf16)f2bf(rem); } }
    }
    const int gw = F.vcu * NWAVES + F.wave, NGW = F.G * NWAVES;
    for (int it = gw; it < DEPTH * 3 * NROUTE; it += NGW) {
        const int n = it % NROUTE, mr = (it / NROUTE) % 3, l = it / (NROUTE * 3); float sacc = 0.f;
        { float ma[32], wa[32];
#pragma unroll
          for (int q = 0; q < 32; ++q) { const int k = F.lane + 64 * q; ma[q] = MOD[((size_t)l * 3 + mr) * NMODC + 3 * DM + k]; wa[q] = WRT[((size_t)l * NROUTE + n) * DM + k]; }
#pragma unroll
          for (int q = 0; q < 32; ++q) sacc += ma[q] * wa[q]; }
        sacc = wave_sum(sacc);
        if (F.lane == 0) CC[it] = sacc + (n < 4 ? F.in[I_GRPB][l * 4 + n] : F.in[I_EXPB][l * 32 + n - 4]);
    }
}
__device__ __forceinline__ void phase_norm2_router(Frame& F, int l, int part, int dummy = 0) {
    typedef float f32x4_ __attribute__((ext_vector_type(4)));
    const bf16* X = (const bf16*)(F.ws + WS_X); const float* MOD = (const float*)(F.ws + WS_MOD);
    const bf16* WQH = (const bf16*)(F.ws + WS_MODP); const bf16* WQL = WQH + WQ_ELEMS; const float* CC = (const float*)(WQL + WQ_ELEMS);
    int* RT = (int*)(F.ws + WS_ROUTE) + (dummy ? RT_WSLOT + SLOT_CAP : 0); unsigned* cnt = (unsigned*)(F.ws + WS_CTL) + CW_CNT + l * 64 + (dummy ? 4096 : 0);
    LAS float* PART = (LAS float*)F.lds;
    LAS float* SSQ = PART + 8 * 12 * 64;
    LAS float* LGT = SSQ + 8 * 16;
    LAS float* RSTD = LGT + 16 * 40;
    LAS int* SLT = (LAS int*)(RSTD + 16);
    bf16* HS = (bf16*)(F.ws + WS_HS); unsigned* moe = (unsigned*)(F.ws + WS_CTL) + CW_MOE + l * CW_MOE_L + (dummy ? 2048 : 0);
    const float* gn = F.in[I_NFFN] + (size_t)l * DM;
    const int lane = F.lane, wave = F.wave, m16 = lane & 15, kg = lane >> 4;
    const int ntile = part == 0 ? T / 16 : part == 2 ? NBATCH * NCTX / 16 : NBATCH * LSEQ / 16;
    const int cu = (part == 1 || part == 2) ? F.vcu - 16 : F.vcu, ncu = part == 1 ? F.G - 16 : part == 2 ? 32 : F.G;
    int t0 = (int)(((long)ntile * cu) / ncu), t1 = (int)(((long)ntile * (cu + 1)) / ncu);
    if (part == 1 && ncu > 32 && ntile > 128) {
        if (cu < 32) { t0 = 4 * cu; t1 = t0 + 4; } else { const int rest = ntile - 128, nc = ncu - 32; t0 = 128 + (int)(((long)rest * (cu - 32)) / nc); t1 = 128 + (int)(((long)rest * (cu - 31)) / nc); } }
#define RT_SYNC() do { LDS_WAIT(); __builtin_amdgcn_s_barrier(); asm volatile("" ::: "memory"); } while (0)
#define RT_ROW0(tl_) (part == 0 ? (tl_) * 16 : part == 2 ? ((tl_) / (NCTX / 16)) * SEGB + ((tl_) % (NCTX / 16)) * 16 : ((tl_) / (LSEQ / 16)) * SEGB + NCTX + ((tl_) % (LSEQ / 16)) * 16)
#define RT_LOAD(xx, hh, ll, kb, xr_, wh_, wl_) do { _Pragma("unroll") for (int s_ = 0; s_ < 2; ++s_) { xx[s_] = *(const GAS bf16x8*)((xr_) + 32 * ((kb) * 2 + s_)); \
            _Pragma("unroll") for (int nt_ = 0; nt_ < 3; ++nt_) { hh[3 * s_ + nt_] = *(const GAS bf16x8*)((wh_) + (size_t)nt_ * 16 * DM + 32 * ((kb) * 2 + s_)); ll[3 * s_ + nt_] = *(const GAS bf16x8*)((wl_) + (size_t)nt_ * 16 * DM + 32 * ((kb) * 2 + s_)); } } } while (0)
#define RT_MMA(xx, hh, ll) do { _Pragma("unroll") for (int s_ = 0; s_ < 2; ++s_) { const bf16x8 xh_ = xx[s_]; const v4u xw_ = __builtin_bit_cast(v4u, xh_); \
            ssq += (bflo(xw_.x) * bflo(xw_.x) + bfhi(xw_.x) * bfhi(xw_.x)) + (bflo(xw_.y) * bflo(xw_.y) + bfhi(xw_.y) * bfhi(xw_.y)) + (bflo(xw_.z) * bflo(xw_.z) + bfhi(xw_.z) * bfhi(xw_.z)) + (bflo(xw_.w) * bflo(xw_.w) + bfhi(xw_.w) * bfhi(xw_.w)); \
            acc0 = __builtin_amdgcn_mfma_f32_16x16x32_bf16(xh_, hh[3 * s_], acc0, 0, 0, 0); acc1 = __builtin_amdgcn_mfma_f32_16x16x32_bf16(xh_, hh[3 * s_ + 1], acc1, 0, 0, 0); acc2 = __builtin_amdgcn_mfma_f32_16x16x32_bf16(xh_, hh[3 * s_ + 2], acc2, 0, 0, 0); \
            acc0 = __builtin_amdgcn_mfma_f32_16x16x32_bf16(xh_, ll[3 * s_], acc0, 0, 0, 0); acc1 = __builtin_amdgcn_mfma_f32_16x16x32_bf16(xh_, ll[3 * s_ + 1], acc1, 0, 0, 0); acc2 = __builtin_amdgcn_mfma_f32_16x16x32_bf16(xh_, ll[3 * s_ + 2], acc2, 0, 0, 0); } } while (0)
    bf16x8 xa[2], xb[2]; bf16x8 ha[6], la[6], hb[6], lb[6];
    const bf16* xr = X, *wh = WQH, *wl = WQL;
    if (t0 < t1) { const int r0_ = RT_ROW0(t0), mr_ = mod_row(r0_);
        xr = X + (size_t)(r0_ + m16) * DM + 256 * wave + 8 * kg; wh = WQH + ((size_t)(l * 3 + mr_) * 48 + m16) * DM + 256 * wave + 8 * kg; wl = WQL + ((size_t)(l * 3 + mr_) * 48 + m16) * DM + 256 * wave + 8 * kg;
        RT_LOAD(xa, ha, la, 0, xr, wh, wl); RT_LOAD(xb, hb, lb, 1, xr, wh, wl); }
    for (int tl = t0; tl < t1; ++tl) {
        const int r0 = RT_ROW0(tl);
        const int mrow = mod_row(r0);
        f32x4_ acc0 = {0.f, 0.f, 0.f, 0.f}, acc1 = acc0, acc2 = acc0; float ssq = 0.f;
        __builtin_amdgcn_sched_barrier(0);
        RT_MMA(xa, ha, la); __builtin_amdgcn_sched_barrier(0); RT_LOAD(xa, ha, la, 2, xr, wh, wl); __builtin_amdgcn_sched_barrier(0);
        RT_MMA(xb, hb, lb); __builtin_amdgcn_sched_barrier(0); RT_LOAD(xb, hb, lb, 3, xr, wh, wl); __builtin_amdgcn_sched_barrier(0);
        RT_MMA(xa, ha, la); __builtin_amdgcn_sched_barrier(0);
        RT_MMA(xb, hb, lb); __builtin_amdgcn_sched_barrier(0);
        if (tl + 1 < t1) { const int r0_ = RT_ROW0(tl + 1), mr_ = mod_row(r0_);
            xr = X + (size_t)(r0_ + m16) * DM + 256 * wave + 8 * kg; wh = WQH + ((size_t)(l * 3 + mr_) * 48 + m16) * DM + 256 * wave + 8 * kg; wl = WQL + ((size_t)(l * 3 + mr_) * 48 + m16) * DM + 256 * wave + 8 * kg;
            RT_LOAD(xa, ha, la, 0, xr, wh, wl); RT_LOAD(xb, hb, lb, 1, xr, wh, wl); }
        __builtin_amdgcn_sched_barrier(0);
        { const int ln_ = fresh_lane(); ssq += __builtin_bit_cast(float, __builtin_amdgcn_ds_bpermute((ln_ ^ 16) << 2, __builtin_bit_cast(int, ssq))); ssq += __builtin_bit_cast(float, __builtin_amdgcn_ds_bpermute((ln_ ^ 32) << 2, __builtin_bit_cast(int, ssq))); }
        RT_SYNC();
#pragma unroll
        for (int r = 0; r < 4; ++r) { PART[(wave * 12 + 0 + r) * 64 + lane] = acc0[r]; PART[(wave * 12 + 4 + r) * 64 + lane] = acc1[r]; PART[(wave * 12 + 8 + r) * 64 + lane] = acc2[r]; }
        if (kg == 0) SSQ[wave * 16 + m16] = ssq;
        RT_SYNC();
        if (F.tid < 16) { float s = 0.f;
#pragma unroll
            for (int w = 0; w < 8; ++w) s += SSQ[w * 16 + F.tid];
            RSTD[F.tid] = 1.0f / sqrtf(s * (1.0f / DM) + EPS); }
        RT_SYNC();
        for (int e = F.tid; e < 16 * NROUTE; e += NWAVES * 64) { const int row = e / NROUTE, n = e % NROUTE; const int nt = n >> 4, col = n & 15, ln = col + 16 * (row >> 2), rg = row & 3; float s = 0.f;
#pragma unroll
            for (int w = 0; w < 8; ++w) s += PART[(w * 12 + nt * 4 + rg) * 64 + ln];
            LGT[row * 40 + n] = s * RSTD[row] + CC[(l * 3 + mrow) * NROUTE + n]; }
        RT_SYNC();
        if (F.tid < 16) { const int r = r0 + F.tid; const LAS float* lgp = LGT + F.tid * 40;
            float lg[4];
#pragma unroll
            for (int n = 0; n < 4; ++n) lg[n] = lgp[n];
            int gi = 0; float gm = lg[0];
#pragma unroll
            for (int n = 1; n < 4; ++n) if (lg[n] > gm) { gm = lg[n]; gi = n; }
            float den = 0.f;
#pragma unroll
            for (int n = 0; n < 4; ++n) den += __expf(lg[n] - gm);
            const float gw = 1.0f / den;
            float el[8];
#pragma unroll
            for (int j = 0; j < 8; ++j) el[j] = lgp[4 + gi * 8 + j];
            int i1 = 0; float v1 = el[0];
#pragma unroll
            for (int j = 1; j < 8; ++j) if (el[j] > v1) { v1 = el[j]; i1 = j; }
            int i2 = -1; float v2 = -3.0e38f;
#pragma unroll
            for (int j = 0; j < 8; ++j) if (j != i1 && el[j] > v2) { v2 = el[j]; i2 = j; }
            if (i2 < 0) i2 = (i1 + 1) & 7;
            const float ex = __expf(v2 - v1), w1 = gw / (1.0f + ex), w2 = gw * ex / (1.0f + ex);
            const int e1 = gi * 8 + i1, e2 = gi * 8 + i2;
            const unsigned p1 = __hip_atomic_fetch_add(cnt + e1, 1u, RLX_AGENT), p2 = __hip_atomic_fetch_add(cnt + e2, 1u, RLX_AGENT);
            if ((p1 & 255u) == 0u) { const unsigned t = __hip_atomic_fetch_add(moe + MOE_NT, 1u, RLX_AGENT); __hip_atomic_store(moe + MOE_TILE_E + t, (unsigned)e1, RLX_AGENT); __hip_atomic_store(moe + MOE_TMAP + e1 * TMAP_STRIDE + (p1 >> 8), t + 1u, RLX_AGENT); }
            if ((p2 & 255u) == 0u) { const unsigned t = __hip_atomic_fetch_add(moe + MOE_NT, 1u, RLX_AGENT); __hip_atomic_store(moe + MOE_TILE_E + t, (unsigned)e2, RLX_AGENT); __hip_atomic_store(moe + MOE_TMAP + e2 * TMAP_STRIDE + (p2 >> 8), t + 1u, RLX_AGENT); }
            unsigned t1 = 0u, t2 = 0u;
            for (unsigned sp = 0; sp < (1u << 22); ++sp) { if (!t1) t1 = __hip_atomic_load(moe + MOE_TMAP + e1 * TMAP_STRIDE + (p1 >> 8), RLX_AGENT); if (!t2) t2 = __hip_atomic_load(moe + MOE_TMAP + e2 * TMAP_STRIDE + (p2 >> 8), RLX_AGENT); if (t1 && t2) break; __builtin_amdgcn_s_sleep(1); }
            if (!t1) t1 = 1u; if (!t2) t2 = 1u;
            const int s1 = (int)((t1 - 1u) * 256u + (p1 & 255u)), s2 = (int)((t2 - 1u) * 256u + (p2 & 255u));
            RT[RT_SLOT + 2 * r] = s1; RT[RT_SLOT + 2 * r + 1] = s2; ((float*)RT)[RT_WSLOT + s1] = w1; ((float*)RT)[RT_WSLOT + s2] = w2; RT[RT_S2T + s1] = r; RT[RT_S2T + s2] = r;
            SLT[2 * F.tid] = s1; SLT[2 * F.tid + 1] = s2; }
        RT_SYNC();
        { const float* sh = MOD + ((size_t)l * 3 + mrow) * NMODC + 3 * DM, *sc = sh + DM;
          const int c = (F.tid & 255) * 8, rw0 = F.tid >> 8;
          v4u xw[8];
#pragma unroll
          for (int q = 0; q < 8; ++q) xw[q] = *(const GAS v4u*)(X + (size_t)(r0 + rw0 + 2 * q) * DM + c);
          const f32x4 a0 = *(const GAS f32x4*)(gn + c) * (*(const GAS f32x4*)(sc + c) + 1.0f), a1 = *(const GAS f32x4*)(gn + c + 4) * (*(const GAS f32x4*)(sc + c + 4) + 1.0f);
          const f32x4 b0 = *(const GAS f32x4*)(sh + c), b1 = *(const GAS f32x4*)(sh + c + 4);
#pragma unroll
          for (int q = 0; q < 8; ++q) { const int row = rw0 + 2 * q; const float rs = RSTD[row]; f32x4 x0, x1;
              x0.x = bflo(xw[q].x); x0.y = bfhi(xw[q].x); x0.z = bflo(xw[q].y); x0.w = bfhi(xw[q].y); x1.x = bflo(xw[q].z); x1.y = bfhi(xw[q].z); x1.z = bflo(xw[q].w); x1.w = bfhi(xw[q].w);
              const f32x4 h0 = x0 * rs * a0 + b0, h1 = x1 * rs * a1 + b1;
              v4u w; w.x = pk2(h0.x, h0.y); w.y = pk2(h0.z, h0.w); w.z = pk2(h1.x, h1.y); w.w = pk2(h1.z, h1.w);
              *(GAS v4u*)(HS + (size_t)(r0 + row) * DM + c) = w; } }
    }
    __syncthreads();
#undef RT_SYNC
#undef RT_LOAD
#undef RT_MMA
#undef RT_ROW0
}
__device__ __forceinline__ void moe_fill_rows(Frame& F, const LAS int* perm, int first, int stride, int lim) {
    const int* s2t = (const int*)(F.ws + WS_ROUTE) + RT_S2T; LAS int* gt = (LAS int*)(F.lds + GT_OFF);
    const int nu = perm[0] * 4;
    for (int e = F.tid; e < 4 * 256; e += NWAVES * 64) { const int ui = e >> 8, r = e & 255; const int L = first + ui * stride;
        if (L < nu && L < lim) { const int pm = perm[1 + (L >> 2)] & 0xffff; gt[e] = s2t[pm * 256 + r]; } }
    __syncthreads();
}
constexpr int PERM_OFF = MISC_OFF + 1024;
static_assert(PERM_OFF + 4 * (176 + 176) <= LDS_BYTES, "perm");
__device__ __forceinline__ void moe_sort_tiles(Frame& F, int l) {
    const unsigned* moe = (const unsigned*)(F.ws + WS_CTL) + CW_MOE + l * CW_MOE_L;
    LAS int* perm = (LAS int*)(F.lds + PERM_OFF); LAS int* etab = perm + 176;
    int nt = (int)moe[MOE_NT]; if (nt > SLOT_CAP / 256) nt = SLOT_CAP / 256;
    if (F.tid < 176) etab[F.tid] = F.tid < nt ? (int)(moe[MOE_TILE_E + F.tid] & 31) : 255;
    __syncthreads();
    if (F.tid < nt) { const int e = etab[F.tid]; int pos = 0;
        for (int t = 0; t < nt; ++t) { const int e2 = etab[t]; pos += (e2 < e || (e2 == e && t < F.tid)) ? 1 : 0; }
        perm[1 + pos] = F.tid | (e << 16); }
    if (F.tid == 0) perm[0] = nt;
    __syncthreads();
}

constexpr int PH_PER_LAYER = 11, N_PHASES = 2 + DEPTH * PH_PER_LAYER + 1;
struct Args { const float* in[28]; float* out; unsigned char* ws; int ph_lo, ph_hi; };
static_assert(sizeof(Args) == 28 * 8 + 8 + 8 + 8, "Args has no padding");

__global__ void __launch_bounds__(NWAVES * 64, 2) hymba_fwd(Args args) {
    extern __shared__ __attribute__((aligned(16))) unsigned char lds_raw[];
    Frame F;
    F.lds = (LAS unsigned char*)lds_raw; F.ws = args.ws; F.in = args.in;
    F.tid = threadIdx.x; F.lane = F.tid & 63; F.wave = __builtin_amdgcn_readfirstlane(F.tid >> 6);
    F.G = gridDim.x; { const int bx = blockIdx.x; F.vcu = (F.G % 8 == 0) ? (bx % 8) * (F.G / 8) + bx / 8 : bx; }
    volatile LAS unsigned* MISC = (volatile LAS unsigned*)(F.lds + MISC_OFF);
    if (F.tid < 32) MISC[F.tid] = 0u;
    const int wave0 = F.wave, vcu0 = F.vcu, g0 = F.G;
    __syncthreads();
    unsigned* ctl = (unsigned*)(F.ws + WS_CTL);
#if MK_SPLIT
#define GRID_BAR() do { } while (0)
#else
    XcdBarrier bar = xcd_barrier_post(ctl + CW_BAR, MISC + 8);
#define GRID_BAR() xcd_barrier(bar)
#endif
    const int lo = args.ph_lo, hi = args.ph_hi;
#ifndef PH_MASK
#define PH_MASK 0x3fff
#endif
#define PHON(x) (((PH_MASK) >> (x)) & 1)
#ifndef REP_MASK
#define REP_MASK 0
#endif
#define NREP(x) ((((REP_MASK) >> (x)) & 1) ? 2 : 1)
#define REFRESH() do { const int ln_ = fresh_lane(); F.tid = (wave0 << 6) | ln_; F.lane = ln_; F.wave = wave0; int v_ = vcu0, g_ = g0; asm volatile("" : "+s"(v_), "+s"(g_)); F.vcu = v_; F.G = g_; } while (0)
#define IN(k) (lo <= (k) && (k) < hi)
#define SEAM(k) do { if (IN(k) && IN((k) + 1)) GRID_BAR(); } while (0)
    LAS unsigned char* ring = F.lds;
    const bool CTX_IN_E = (F.G == 256);

    if (PHON(0) && IN(0)) { for (int rep = 0; rep < NREP(0); ++rep) { REFRESH(); p0_prologue(F); __syncthreads(); } } SEAM(0);
    if (PHON(1) && IN(1)) { REFRESH(); p0b_modreduce(F); } SEAM(1);

    for (int l = 0; l < DEPTH; ++l) {
        const int pb = 2 + l * PH_PER_LAYER;
        if (PHON(2) && IN(pb + 0)) { for (int rep = 0; rep < (l == 0 ? NREP(2) : 1); ++rep) { REFRESH(); if (l == 0) { router_tables(F); phase_norm1<0>(F, l, nullptr); } else phase_norm1<1>(F, l, nullptr); } } SEAM(pb + 0);
        if (PHON(3) && IN(pb + 1)) { REFRESH();
            pg8::Gemm g{(const bf16*)(F.ws + WS_H), (const bf16*)(F.ws + WS_WIN) + (size_t)l * PIN * DM, T, PIN, DM}; pg8::StaticOrder S; S.init(T, PIN, F.G, (int)blockIdx.x);
            EpiStoreBf16 E{(bf16*)(F.ws + WS_P), PIN};
            for (int rep = 0; rep < NREP(3); ++rep) pg8::gemm_phase<EpiStoreBf16, pg8::StaticOrder, true, true>(ring, g, S, E, F.tid);
        } SEAM(pb + 1);
        if (PHON(4) && IN(pb + 2)) { for (int rep = 0; rep < NREP(4); ++rep) { REFRESH(); phase_prep(F, l); } } SEAM(pb + 2);
        if (PHON(5) && IN(pb + 3)) { REFRESH();
            int kaux = 128; asm volatile("" : "+s"(kaux));
            pg8::Gemm g{(const bf16*)(F.ws + WS_AUXA), (const bf16*)(F.ws + WS_AUXB) + (size_t)l * 12 * 256 * 128, 8 * T, 12 * 256, kaux}; AuxSched S{F.G, F.vcu};
            EpiAux E{(bf16*)(F.ws + WS_G), (bf16*)(F.ws + WS_YB), (const bf16*)(F.ws + WS_AUXA), F.in[I_RGGB] + (size_t)l * 2 * 2 * 4 * 128, (const float*)(F.ws + WS_WRT) + DEPTH * NROUTE * DM + (size_t)l * 1024, F.in[I_POOLB] + (size_t)l * 512, F.in[I_POOLS] + (size_t)l * 512};
            for (int rep = 0; rep < NREP(5); ++rep) pg8::gemm_phase<EpiAux, AuxSched, true, true>(ring, g, S, E, F.tid);
        } SEAM(pb + 3);
        if (PHON(6) && IN(pb + 4)) { for (int rep = 0; rep < NREP(6); ++rep) { REFRESH(); phase_scan1(F, l); __syncthreads(); phase_attn<0>(F, l); } } SEAM(pb + 4);
        if (PHON(7) && IN(pb + 5)) { for (int rep = 0; rep < NREP(7); ++rep) { REFRESH(); phase_scan2(F, l); } } SEAM(pb + 5);
        if (PHON(8) && IN(pb + 6)) { REFRESH();
            pg8::Gemm g{(const bf16*)(F.ws + WS_YB), (const bf16*)(F.ws + WS_WOUT) + (size_t)l * DM * DM, T, DM, DM};
            RowOrder S; S.latent_only = (l == DEPTH - 1) || CTX_IN_E; S.S.init(S.latent_only ? NBATCH * LSEQ : T, DM, F.G, (int)blockIdx.x);
            EpiResid E{(bf16*)(F.ws + WS_X), (const float*)(F.ws + WS_MOD) + (size_t)l * 3 * NMODC, l == 0 ? F.in[I_X] : nullptr, F.in[I_CTX]};
            pg8::gemm_phase<EpiResid, RowOrder, true, true>(ring, g, S, E, F.tid);
        } SEAM(pb + 6);
        if (PHON(9) && IN(pb + 7)) {
            if (l == DEPTH - 1) { for (int rep = NREP(9) - 1; rep >= 0; --rep) { REFRESH(); phase_norm2_router(F, l, 3, rep); } }
            else if (!CTX_IN_E) { for (int rep = NREP(9) - 1; rep >= 0; --rep) { REFRESH(); phase_norm2_router(F, l, 0, rep); } }
            else if (F.vcu >= 16) { REFRESH(); phase_norm2_router(F, l, 1);
                if (F.vcu < 48) {
                    if (F.tid == 0) { unsigned* cw = ctl + CW_CTXD + l;
                        for (unsigned sp = 0; sp < (1u << 26) && __hip_atomic_load(cw, __ATOMIC_ACQUIRE, __HIP_MEMORY_SCOPE_AGENT) < 16u; ++sp) __builtin_amdgcn_s_sleep(2); }
                    __syncthreads();
                    REFRESH(); phase_norm2_router(F, l, 2); } }
            else { REFRESH();
                pg8::Gemm g{(const bf16*)(F.ws + WS_YB), (const bf16*)(F.ws + WS_WOUT) + (size_t)l * DM * DM, T, DM, DM};
                OneUnit S{(F.vcu >> 3) * TPB, F.vcu & 7};
                EpiResid E{(bf16*)(F.ws + WS_X), (const float*)(F.ws + WS_MOD) + (size_t)l * 3 * NMODC, l == 0 ? F.in[I_X] : nullptr, F.in[I_CTX]};
                pg8::gemm_phase<EpiResid, OneUnit, true, true>(ring, g, S, E, F.tid);
                __syncthreads();
                if (F.tid == 0) __hip_atomic_fetch_add(ctl + CW_CTXD + l, 1u, __ATOMIC_RELEASE, __HIP_MEMORY_SCOPE_AGENT);
            }
        } SEAM(pb + 7);
        if (PHON(11) && IN(pb + 9)) { REFRESH();
            moe_sort_tiles(F, l);
            const LAS int* perm = (const LAS int*)(F.lds + PERM_OFF); const int nF = perm[0] * 4, rf = nF / F.G, R = nF - rf * F.G;
            pg8::Gemm g{(const bf16*)(F.ws + WS_HS), (const bf16*)(F.ws + WS_UP) + (size_t)l * NEXP * 1024 * DM, SLOT_CAP, NEXP * 1024, DM}; MoeSched S{perm, 4, F.G, F.vcu, (R > 0 && rf > 0) ? rf * F.G : 0x7fffffff, (const LAS int*)(F.lds + GT_OFF)};
            moe_fill_rows(F, perm, F.vcu, F.G, S.lim);
            EpiSwiGLU E{(bf16*)(F.ws + WS_HM), (const float*)(F.ws + WS_ROUTE) + RT_WSLOT};
            for (int rep = 0; rep < NREP(11); ++rep) pg8::gemm_phase<EpiSwiGLU, MoeSched, true, true, true>(ring, g, S, E, F.tid);
        } SEAM(pb + 9);
        if (PHON(12) && IN(pb + 10)) { REFRESH();
            moe_sort_tiles(F, l);
            const LAS int* perm = (const LAS int*)(F.lds + PERM_OFF); const int nF = perm[0] * 4, rf = nF / F.G; int R = nF - rf * F.G; if (rf == 0) R = 0;
            unsigned* fov = ctl + CW_FOV + l * 256;
            if (F.vcu < R) {
                pg8::Gemm g{(const bf16*)(F.ws + WS_HS), (const bf16*)(F.ws + WS_UP) + (size_t)l * NEXP * 1024 * DM, SLOT_CAP, NEXP * 1024, DM}; MoeOneUp S{perm, rf * F.G + F.vcu, (const LAS int*)(F.lds + GT_OFF)};
                moe_fill_rows(F, perm, rf * F.G + F.vcu, 0x10000000, 0x7fffffff);
                EpiSwiGLU E{(bf16*)(F.ws + WS_HM), (const float*)(F.ws + WS_ROUTE) + RT_WSLOT};
                pg8::gemm_phase<EpiSwiGLU, MoeOneUp, true, true, true>(ring, g, S, E, F.tid);
                __syncthreads();
                if (F.tid == 0) __hip_atomic_fetch_add(fov + ((rf * F.G + F.vcu) >> 2), 1u, __ATOMIC_RELEASE, __HIP_MEMORY_SCOPE_AGENT);
                REFRESH();
            }
            pg8::Gemm g{(const bf16*)(F.ws + WS_HM), (const bf16*)(F.ws + WS_DOWN) + (size_t)l * NEXP * DM * DEXP, SLOT_CAP, NEXP * DM, DEXP}; MoeDownSched S{perm, F.G, F.vcu, R, (rf * F.G) >> 2, fov};
            EpiDown E{(bf16*)(F.ws + WS_YS)};
            for (int rep = 0; rep < NREP(12); ++rep) pg8::gemm_phase<EpiDown, MoeDownSched, true, true>(ring, g, S, E, F.tid);
        } SEAM(pb + 10);
    }
    if (PHON(13) && IN(N_PHASES - 1)) { for (int rep = 0; rep < NREP(13); ++rep) { REFRESH(); phase_norm1<2>(F, DEPTH, args.out); } }
#undef IN
#undef SEAM
}

extern "C" void kernel_launch(void* const* d_in, const int* in_sizes, int n_in, void* d_out, int out_size, void* d_ws, size_t ws_size, hipStream_t stream) {
    static int grid = 0;
    if (grid == 0) {
        if (n_in != 28 || in_sizes[0] != NBATCH * LSEQ * DM || out_size != NBATCH * LSEQ * DM || ws_size < WS_END) {
            fprintf(stderr, "kernel_launch: unexpected shapes (n_in %d, in0 %d, out %d, ws %zu need %zu); nothing launched\n", n_in, n_in > 0 ? in_sizes[0] : -1, out_size, ws_size, (size_t)WS_END); grid = -1; return; }
        int dev = 0, cus = 0, per_cu = 0;
        if (hipGetDevice(&dev) != hipSuccess || hipDeviceGetAttribute(&cus, hipDeviceAttributeMultiprocessorCount, dev) != hipSuccess) { fprintf(stderr, "kernel_launch: device query failed\n"); grid = -1; return; }
        if (hipFuncSetAttribute((const void*)hymba_fwd, hipFuncAttributeMaxDynamicSharedMemorySize, LDS_BYTES) != hipSuccess) { fprintf(stderr, "kernel_launch: hipFuncSetAttribute failed\n"); grid = -1; return; }
        if (hipOccupancyMaxActiveBlocksPerMultiprocessor(&per_cu, (const void*)hymba_fwd, NWAVES * 64, LDS_BYTES) != hipSuccess || per_cu < 1)
            fprintf(stderr, "kernel_launch: note: occupancy query reports %d workgroups per CU\n", per_cu);
        (void)hipGetLastError();
        grid = cus;
    }
    if (grid < 0) return;
    if (hipMemsetAsync((char*)d_ws + WS_CTL, 0, CTL_ZERO_BYTES, stream) != hipSuccess) { fprintf(stderr, "kernel_launch: memset failed\n"); return; }
    Args a{};
    for (int i = 0; i < 28; ++i) a.in[i] = (const float*)d_in[i];
    a.out = (float*)d_out; a.ws = (unsigned char*)d_ws;
#if MK_SPLIT
    for (int p = 0; p < N_PHASES; ++p) { a.ph_lo = p; a.ph_hi = p + 1; hipLaunchKernelGGL(hymba_fwd, dim3(grid), dim3(NWAVES * 64), LDS_BYTES, stream, a); }
#else
    a.ph_lo = 0; a.ph_hi = N_PHASES;
    hipLaunchKernelGGL(hymba_fwd, dim3(grid), dim3(NWAVES * 64), LDS_BYTES, stream, a);
#endif
    const hipError_t le = hipPeekAtLastError();
    if (le != hipSuccess) fprintf(stderr, "kernel_launch: launch failed: %s\n", hipGetErrorName(le));
}
```

```cpp
#include <hip/hip_runtime.h>
#include <cstdio>
#include <cstdint>
#ifndef MK_SPLIT
#define MK_SPLIT 0
#endif

constexpr int DM = 2048, NBATCH = 2, LSEQ = 8192, NCTX = 256, SEGB = NCTX + LSEQ, T = NBATCH * SEGB;
constexpr int DEPTH = 2, PIN = 4608, NEXP = 32, DEXP = 512, NROUTE = 36, NMODC = 6 * DM;
constexpr int NTM = T / 256;
constexpr int TPB = SEGB / 256;
constexpr int CH64 = SEGB / 64;
constexpr int SLOT_CAP = 42240;
constexpr int KSPLIT = 16;
constexpr float EPS = 1e-6f;
constexpr float QSCALE = 0.125f * 1.4426950408889634f;
constexpr int NWAVES = 8;

constexpr size_t MiB = 1u << 20;
constexpr size_t WS_CTL = 0, CTL_ZERO_BYTES = 1 * MiB;
constexpr size_t WS_MODP = 1 * MiB, WS_MOD = 6 * MiB, WS_WRT = 7 * MiB, WS_AUXB = 8 * MiB;
constexpr size_t WS_WIN = 10 * MiB, WS_WOUT = 46 * MiB, WS_UP = 62 * MiB, WS_DOWN = 318 * MiB;
constexpr size_t WS_X = 446 * MiB, WS_H = 578 * MiB, WS_P = 644 * MiB, WS_QP = 793 * MiB, WS_KP = 810 * MiB, WS_VT = 827 * MiB;
constexpr size_t WS_AUXA = 844 * MiB, WS_G = 877 * MiB, WS_YB = 943 * MiB, WS_SUM = 1009 * MiB, WS_ROUTE = 1012 * MiB;
constexpr size_t WS_HS = 1013 * MiB, WS_HM = 1178 * MiB, WS_YS = 1220 * MiB, WS_END = 1385 * MiB;
static_assert(WS_MODP + (size_t)DEPTH * KSPLIT * 3 * NMODC * 4 <= WS_MOD, "modp");
static_assert(WS_WIN + (size_t)DEPTH * PIN * DM * 2 <= WS_WOUT && WS_WOUT + (size_t)DEPTH * DM * DM * 2 <= WS_UP, "w");
static_assert(WS_UP + (size_t)DEPTH * NEXP * 1024 * DM * 2 <= WS_DOWN && WS_DOWN + (size_t)DEPTH * NEXP * DM * DEXP * 2 <= WS_X, "w2");
static_assert(WS_X + (size_t)T * DM * 4 <= WS_H && WS_H + (size_t)T * DM * 2 <= WS_P && WS_P + (size_t)T * PIN * 2 <= WS_QP, "act");
static_assert(WS_QP + (size_t)T * 512 * 2 <= WS_KP && WS_VT + (size_t)T * 512 * 2 <= WS_AUXA && WS_AUXA + (size_t)8 * T * 128 * 2 <= WS_G, "act2");
static_assert(WS_G + (size_t)T * DM * 2 <= WS_YB && WS_YB + (size_t)T * DM * 2 <= WS_SUM, "act3");
static_assert(WS_HS + (size_t)SLOT_CAP * DM * 2 <= WS_HM && WS_HM + (size_t)SLOT_CAP * DEXP * 2 <= WS_YS && WS_YS + (size_t)SLOT_CAP * DM * 2 <= WS_END, "moe");
constexpr int RT_TOKE = 0, RT_POS = T, RT_W = 3 * T, RT_SLOT = 5 * T, RT_WSLOT = 7 * T;
constexpr int RT_S2T = RT_WSLOT + SLOT_CAP;
static_assert((size_t)(RT_S2T + SLOT_CAP) * 4 <= 1 * MiB, "route");
constexpr int CW_TMO = 0, CW_CTXD = 64  , CW_FOV = 512  , CW_BAR = 4096, CW_CNT = 16384;
constexpr int CW_MOE = 32768, CW_MOE_L = 4096, MOE_NT = 0, MOE_TILE_E = 64, MOE_TMAP = 256, TMAP_STRIDE = 68;
static_assert(MOE_TMAP + 32 * TMAP_STRIDE <= CW_MOE_L && (CW_MOE + DEPTH * CW_MOE_L) * 4 <= (int)CTL_ZERO_BYTES, "moe ctl");

constexpr int RING_BYTES = 131072;
constexpr int MISC_OFF = 139264 + 320;
constexpr int TP_OFF = MISC_OFF + 128;
constexpr int GT_OFF = RING_BYTES;
constexpr int LDS_BYTES = 147456;
static_assert(TP_OFF + 33 * 4 + 64 <= LDS_BYTES && 8 * 16896 <= 139264 && GT_OFF + 4 * 256 * 4 <= 139264, "lds");

#define GAS __attribute__((address_space(1)))
#define LAS __attribute__((address_space(3)))
typedef unsigned short bf16;
typedef unsigned v4u __attribute__((ext_vector_type(4)));
typedef unsigned v2u __attribute__((ext_vector_type(2)));
typedef float f32x4 __attribute__((ext_vector_type(4)));
typedef float f32x16 __attribute__((ext_vector_type(16)));
typedef short bf16x8 __attribute__((ext_vector_type(8)));
typedef GAS unsigned gu32;
#define RLX_AGENT __ATOMIC_RELAXED, __HIP_MEMORY_SCOPE_AGENT
#define LDS_WAIT() asm volatile("s_waitcnt lgkmcnt(0)" ::: "memory")
#define VM_WAIT() asm volatile("s_waitcnt vmcnt(0)" ::: "memory")
__device__ __forceinline__ unsigned f2bf(float f) { unsigned u = __builtin_bit_cast(unsigned, f); return (u + 0x7fffu + ((u >> 16) & 1u)) >> 16; }
__device__ __forceinline__ unsigned pk2(float lo, float hi) { return f2bf(lo) | (f2bf(hi) << 16); }
__device__ __forceinline__ unsigned pk2_hw(float lo, float hi) { unsigned r; asm("v_cvt_pk_bf16_f32 %0, %1, %2" : "=v"(r) : "v"(lo), "v"(hi)); return r; }
__device__ __forceinline__ float bf2f(unsigned u16) { return __builtin_bit_cast(float, u16 << 16); }
__device__ __forceinline__ float bflo(unsigned w) { return __builtin_bit_cast(float, w << 16); }
__device__ __forceinline__ float bfhi(unsigned w) { return __builtin_bit_cast(float, w & 0xffff0000u); }
__device__ __forceinline__ int fresh_lane() { int ln; asm volatile("v_mbcnt_lo_u32_b32 %0, -1, 0\n\tv_mbcnt_hi_u32_b32 %0, -1, %0" : "=v"(ln)); return ln; }
template <int PAT> __device__ __forceinline__ float swz_xor(float v) { return __builtin_bit_cast(float, __builtin_amdgcn_ds_swizzle(__builtin_bit_cast(int, v), PAT)); }
__device__ __forceinline__ float half_swap_sum(float v) { auto rr = __builtin_amdgcn_permlane32_swap(__builtin_bit_cast(unsigned, v), __builtin_bit_cast(unsigned, v), false, false); return __builtin_bit_cast(float, rr[0]) + __builtin_bit_cast(float, rr[1]); }
__device__ __forceinline__ float wave_sum(float v) {
    const int ln = fresh_lane();
#pragma unroll
    for (int o = 1; o < 64; o <<= 1) v += __builtin_bit_cast(float, __builtin_amdgcn_ds_bpermute((ln ^ o) << 2, __builtin_bit_cast(int, v)));
    return v;
}
__device__ __forceinline__ float sigmoidf_(float x) { return 1.0f / (1.0f + __expf(-x)); }
__device__ __forceinline__ float siluf_(float x) { return x / (1.0f + __expf(-x)); }
__device__ __forceinline__ float gelu_tanh(float x) { const float z = 0.7978845608028654f * (x + 0.044715f * x * x * x); const float e = __expf(2.0f * z); return 0.5f * x * (2.0f - 2.0f / (e + 1.0f)); }
__device__ __forceinline__ int mod_row(int r) { const int b = r / SEGB; return (r - b * SEGB) < NCTX ? 2 : b; }

namespace pg8 {
#define PG8_LAS __attribute__((address_space(3)))
typedef unsigned short bf16_t;
typedef short bf16x8 __attribute__((ext_vector_type(8)));
typedef float f32x4 __attribute__((ext_vector_type(4)));
typedef unsigned u32x4 __attribute__((ext_vector_type(4)));
constexpr int BM = 256, BK = 64, HALF = 128, HTB = HALF * BK * 2  , STAGE_BYTES = 8 * HTB, NXCD = 8, WGM = 8;

__host__ __device__ __forceinline__ int lds_byte(int r, int c) { const int st = (r >> 4) * 2 + (c >> 5), rr = r & 15, cc = c & 31, ob = rr * 64 + cc * 2; return st * 1024 + (ob ^ (((ob >> 9) & 1) << 5)); }
__host__ __device__ __forceinline__ void stage_rc(int b, int& R, int& C) { const int st = b / 1024, sb = b % 1024, swz = sb ^ (((sb >> 9) & 1) << 5); R = (st >> 1) * 16 + swz / 64; C = (st & 1) * 32 + (swz % 64) / 2; }
__host__ __device__ __forceinline__ int perm32(int rho) { const int n = rho >> 4, i = rho & 15; return 8 * (i >> 2) + 4 * n + (i & 3); }

struct Unit { int pm, pn, aux; };
struct Gemm { const bf16_t* A; const bf16_t* Bt; int M, N, K; };

struct StaticOrder {
    int nM, nN, nwg, G, c;
    __host__ __device__ void init(int M, int N, int G_, int c_) { nM = M / BM; nN = N / BM; nwg = nM * nN; G = G_; c = c_; }
    __host__ __device__ bool next(int i, Unit& u) const {
        const long L = (long)i * G + c; if (L >= nwg) return false;
        int wgid = (int)L; { const int q = nwg / NXCD, r = nwg % NXCD, xcd = wgid % NXCD, off = wgid / NXCD; wgid = (xcd < r ? xcd * (q + 1) : r * (q + 1) + (xcd - r) * q) + off; }
        const int nig = WGM * nN, gid = wgid / nig, fm = gid * WGM, gsz = (nM - fm) < WGM ? (nM - fm) : WGM;
        u.pm = fm + ((wgid % nig) % gsz); u.pn = (wgid % nig) / gsz; return true;
    }
    __device__ __forceinline__ void a_ready(const Unit&) const {}
    __device__ __forceinline__ void done(const Unit&) const {}
};
__device__ __forceinline__ unsigned cvt_pk_bf16(float lo, float hi) { unsigned r; asm volatile("v_cvt_pk_bf16_f32 %0, %1, %2" : "=v"(r) : "v"(lo), "v"(hi)); return r; }
typedef float f32x2 __attribute__((ext_vector_type(2)));
template <class Epi, class Sched, bool ALIGN_EPI = false, bool SP2 = false, bool GATHER = false>
__device__ __forceinline__ void gemm_phase(PG8_LAS unsigned char* lds, const Gemm g, const Sched& S, const Epi& E, const int tid_in) {
    int tid_ = tid_in;
    const int tid = tid_, wid = __builtin_amdgcn_readfirstlane(tid >> 6), lane = tid & 63, wr = wid >> 2, wc = wid & 3, fr = lane & 15, fq = lane >> 4;
    const int K = g.K, nt = K / BK;
    unsigned voffA[2], voffB[2];
#pragma unroll
    for (int i = 0; i < 2; ++i) { int R, C; stage_rc(tid * 16 + i * 8192, R, C); const int Rb = Epi::PERM ? ((R & ~31) + perm32(R & 31)) : R;
        voffA[i] = (unsigned)(R * K + C) * 2u; voffB[i] = (unsigned)(Rb * K + C) * 2u; }
    static_assert(!GATHER || SP2, "GATHER is written for the SP2 loop");
    unsigned vC[2][2] = {}, vN[2][2] = {};
    int gR0 = 0, gC0 = 0; if constexpr (GATHER) stage_rc(tid * 16, gR0, gC0);
#define PG8_GOFF(v, ui_) do { _Pragma("unroll") for (int h_ = 0; h_ < 2; ++h_) _Pragma("unroll") for (int i_ = 0; i_ < 2; ++i_) v[h_][i_] = (unsigned)(S.row((ui_), h_ * 128 + gR0 + 64 * i_) * K + gC0) * 2u; } while (0)
    const size_t kstep = (size_t)(BK * 2);
    const size_t hstep = (size_t)HALF * K * 2;
    const size_t tstep = 2 * hstep;
    const unsigned ldsw = (unsigned)wid * 1024u;
    const int aoff = lds_byte(wr * 64 + fr, fq * 8), boff = lds_byte(wc * 32 + fr, fq * 8);
#define PG8_SA(b, h) (((b) * 2 + (h)) * HTB)
#define PG8_SB(b, h) ((4 + (b) * 2 + (h)) * HTB)
#define PG8_STAGE(bufoff, gbase, voff) do { _Pragma("unroll") for (int _i = 0; _i < 2; ++_i) \
        __builtin_amdgcn_global_load_lds((const unsigned*)((const char*)(gbase) + (voff)[_i]), (PG8_LAS unsigned*)(lds + (bufoff) + ldsw + _i * 8192), 16, 0, 0); } while (0)
#define PG8_LDA(dst, b, h) do { _Pragma("unroll") for (int m = 0; m < 4; ++m) _Pragma("unroll") for (int k = 0; k < 2; ++k) dst[m][k] = *(const PG8_LAS bf16x8*)(lds + PG8_SA(b, h) + aoff + m * 2048 + k * 1024); } while (0)
#define PG8_LDB(dst, b, h) do { _Pragma("unroll") for (int n = 0; n < 2; ++n) _Pragma("unroll") for (int k = 0; k < 2; ++k) dst[n][k] = *(const PG8_LAS bf16x8*)(lds + PG8_SB(b, h) + boff + n * 2048 + k * 1024); } while (0)
#define PG8_MMA(ai, bj, At, Bt) do { __builtin_amdgcn_s_setprio(1); _Pragma("unroll") for (int m = 0; m < 4; ++m) _Pragma("unroll") for (int n = 0; n < 2; ++n) _Pragma("unroll") for (int k = 0; k < 2; ++k) \
        acc[ai][bj][m][n] = __builtin_amdgcn_mfma_f32_16x16x32_bf16(Bt[n][k], At[m][k], acc[ai][bj][m][n], 0, 0, 0); __builtin_amdgcn_s_setprio(0); } while (0)
#define PG8_WAIT_V(n) asm volatile("s_waitcnt vmcnt(" #n ")" ::: "memory")
#define PG8_WAIT_L(n) asm volatile("s_waitcnt lgkmcnt(" #n ")" ::: "memory")
#define PG8_BAR __builtin_amdgcn_s_barrier()
#define PG8_SCHED __builtin_amdgcn_sched_barrier(0)
    Unit cur, nxt; int ui = 0;
    if (!S.next(0, cur)) return;
    f32x4 acc[2][2][4][2];
#pragma unroll
    for (int a = 0; a < 2; ++a)
#pragma unroll
        for (int b = 0; b < 2; ++b)
#pragma unroll
            for (int m = 0; m < 4; ++m)
#pragma unroll
                for (int n = 0; n < 2; ++n) acc[a][b][m][n] = (f32x4){0.f, 0.f, 0.f, 0.f};
    bf16x8 At[4][2], B0[2][2], B1[2][2];
    const char* cA = GATHER ? (const char*)g.A : (const char*)g.A + (size_t)cur.pm * tstep; const char* cB = (const char*)g.Bt + (size_t)cur.pn * tstep;
    const size_t ahstep = GATHER ? 0 : hstep;
    if constexpr (GATHER) PG8_GOFF(vC, 0);
#define PG8_VA(sel_next, h) (GATHER ? vC[h] : voffA)
    S.a_ready(cur);
    if constexpr (SP2) {
        PG8_STAGE(PG8_SB(0, 0), cB, voffB); PG8_STAGE(PG8_SB(0, 1), cB + hstep, voffB); PG8_STAGE(PG8_SA(0, 0), cA, PG8_VA(false, 0)); PG8_STAGE(PG8_SA(0, 1), cA + ahstep, PG8_VA(false, 1));
        if (wr == 1) PG8_BAR;
        PG8_WAIT_V(2); PG8_BAR;
        PG8_STAGE(PG8_SB(1, 0), cB + kstep, voffB); PG8_STAGE(PG8_SA(1, 0), cA + kstep, PG8_VA(false, 0)); PG8_STAGE(PG8_SB(1, 1), cB + hstep + kstep, voffB);
        PG8_WAIT_V(6); PG8_BAR;
    } else {
        PG8_STAGE(PG8_SB(0, 0), cB, voffB); PG8_STAGE(PG8_SA(0, 0), cA, voffA); PG8_STAGE(PG8_SB(0, 1), cB + hstep, voffB); PG8_STAGE(PG8_SA(0, 1), cA + hstep, voffA);
        if (wr == 1) PG8_BAR;
        PG8_WAIT_V(4); PG8_BAR;
        PG8_STAGE(PG8_SB(1, 0), cB + kstep, voffB); PG8_STAGE(PG8_SA(1, 0), cA + kstep, voffA); PG8_STAGE(PG8_SB(1, 1), cB + hstep + kstep, voffB);
        PG8_WAIT_V(6); PG8_BAR;
    }
    for (;;) {
        const bool has_next = S.next(ui + 1, nxt);
        const char* nA = (has_next && !GATHER) ? (const char*)g.A + (size_t)nxt.pm * tstep : cA; const char* nB = has_next ? (const char*)g.Bt + (size_t)nxt.pn * tstep : cB;
        if constexpr (GATHER) { if (has_next) PG8_GOFF(vN, ui + 1); else { _Pragma("unroll") for (int h_ = 0; h_ < 2; ++h_) _Pragma("unroll") for (int i_ = 0; i_ < 2; ++i_) vN[h_][i_] = vC[h_][i_]; } }
        for (int t = 0; t < nt; t += 2) {
            const bool last = (t == nt - 2);
            const char* a1 = cA + (size_t)(t + 1) * kstep;
            const char* a2 = last ? nA : cA + (size_t)(t + 2) * kstep; const char* b2 = last ? nB : cB + (size_t)(t + 2) * kstep;
            const char* a3 = a2 + kstep; const char* b3 = b2 + kstep;
            if (last && has_next) S.a_ready(nxt);
            unsigned vs0[2], vs1[2];
            _Pragma("unroll") for (int i_ = 0; i_ < 2; ++i_) { vs0[i_] = GATHER ? (last ? vN[0][i_] : vC[0][i_]) : voffA[i_]; vs1[i_] = GATHER ? (last ? vN[1][i_] : vC[1][i_]) : voffA[i_]; }
            if constexpr (SP2) {
            PG8_LDB(B0, 0, 0); PG8_LDB(B1, 0, 1); PG8_SCHED; PG8_LDA(At, 0, 0); PG8_STAGE(PG8_SA(1, 1), a1 + ahstep, PG8_VA(false, 1));
            PG8_WAIT_V(8); PG8_WAIT_L(0); PG8_BAR; PG8_MMA(0, 0, At, B0); PG8_MMA(0, 1, At, B1); PG8_BAR; PG8_SCHED;
            PG8_LDA(At, 0, 1); PG8_STAGE(PG8_SB(0, 0), b2, voffB); PG8_STAGE(PG8_SB(0, 1), b2 + hstep, voffB); PG8_STAGE(PG8_SA(0, 0), a2, vs0);
            PG8_WAIT_V(8); PG8_WAIT_L(0); PG8_BAR; PG8_MMA(1, 0, At, B0); PG8_MMA(1, 1, At, B1); PG8_BAR; PG8_SCHED;
            PG8_LDB(B0, 1, 0); PG8_LDB(B1, 1, 1); PG8_SCHED; PG8_LDA(At, 1, 0); PG8_STAGE(PG8_SA(0, 1), a2 + ahstep, vs1);
            PG8_WAIT_V(8); PG8_WAIT_L(0); PG8_BAR; PG8_MMA(0, 0, At, B0); PG8_MMA(0, 1, At, B1); PG8_BAR; PG8_SCHED;
            PG8_LDA(At, 1, 1); PG8_STAGE(PG8_SB(1, 0), b3, voffB); PG8_STAGE(PG8_SB(1, 1), b3 + hstep, voffB); PG8_STAGE(PG8_SA(1, 0), a3, vs0);
            PG8_WAIT_V(8); PG8_WAIT_L(0); PG8_BAR; PG8_MMA(1, 0, At, B0); PG8_MMA(1, 1, At, B1); PG8_BAR; PG8_SCHED;
            } else {
            PG8_LDB(B0, 0, 0); PG8_SCHED; PG8_LDA(At, 0, 0); PG8_STAGE(PG8_SA(1, 1), a1 + hstep, voffA);
            PG8_WAIT_L(8); PG8_BAR; PG8_WAIT_L(0); PG8_MMA(0, 0, At, B0); PG8_BAR; PG8_SCHED;
            PG8_LDB(B1, 0, 1); PG8_STAGE(PG8_SB(0, 0), b2, voffB);
            PG8_BAR; PG8_WAIT_L(0); PG8_MMA(0, 1, At, B1); PG8_BAR;
            PG8_LDA(At, 0, 1); PG8_STAGE(PG8_SA(0, 0), a2, voffA);
            PG8_BAR; PG8_WAIT_L(0); PG8_MMA(1, 0, At, B0); PG8_BAR; PG8_SCHED;
            PG8_STAGE(PG8_SB(0, 1), b2 + hstep, voffB);
            PG8_WAIT_V(6); PG8_BAR; PG8_MMA(1, 1, At, B1); PG8_BAR;
            PG8_LDB(B0, 1, 0); PG8_SCHED; PG8_LDA(At, 1, 0); PG8_STAGE(PG8_SA(0, 1), a2 + hstep, voffA);
            PG8_WAIT_L(8); PG8_BAR; PG8_WAIT_L(0); PG8_MMA(0, 0, At, B0); PG8_BAR; PG8_SCHED;
            PG8_LDB(B1, 1, 1); PG8_STAGE(PG8_SB(1, 0), b3, voffB);
            PG8_BAR; PG8_WAIT_L(0); PG8_MMA(0, 1, At, B1); PG8_BAR;
            PG8_LDA(At, 1, 1); PG8_STAGE(PG8_SA(1, 0), a3, voffA);
            PG8_BAR; PG8_WAIT_L(0); PG8_MMA(1, 0, At, B0); PG8_BAR; PG8_SCHED;
            PG8_STAGE(PG8_SB(1, 1), b3 + hstep, voffB);
            PG8_WAIT_V(6); PG8_BAR; PG8_MMA(1, 1, At, B1); PG8_BAR;
            }
        }
        if constexpr (ALIGN_EPI) { if (wr == 0) PG8_BAR; }
        if constexpr (!Epi::AFTER_DRAIN) { E(acc, cur, wr, wc, fr, fq); S.done(cur); }
        if (!has_next) break;
#pragma unroll
        for (int a = 0; a < 2; ++a)
#pragma unroll
            for (int b = 0; b < 2; ++b)
#pragma unroll
                for (int m = 0; m < 4; ++m)
#pragma unroll
                    for (int n = 0; n < 2; ++n) acc[a][b][m][n] = (f32x4){0.f, 0.f, 0.f, 0.f};
        cur = nxt; cA = nA; cB = nB; ++ui;
        if constexpr (GATHER) { _Pragma("unroll") for (int h_ = 0; h_ < 2; ++h_) _Pragma("unroll") for (int i_ = 0; i_ < 2; ++i_) vC[h_][i_] = vN[h_][i_]; }
        if constexpr (ALIGN_EPI) { if (wr == 1) PG8_BAR; }
    }
    PG8_WAIT_V(0);
    if constexpr (!ALIGN_EPI) { if (wr == 0) PG8_BAR; }
    PG8_BAR;
    if constexpr (Epi::AFTER_DRAIN) { E.fused(acc, cur, wr, wc, fr, fq, lds, wid, lane); S.done(cur); }
#undef PG8_SA
#undef PG8_GOFF
#undef PG8_VA
#undef PG8_SB
#undef PG8_STAGE
#undef PG8_LDA
#undef PG8_LDB
#undef PG8_MMA
#undef PG8_WAIT_V
#undef PG8_WAIT_L
#undef PG8_BAR
#undef PG8_SCHED
}
}
#define XB_TMO      128
#define XB_XCNT(j)  (256  + 64 * (j))
#define XB_XSUB(j)  (1280 + 64 * (j))
#define XB_XGEN(j)  (2304 + 64 * (j))
#define XB_TOP      3328
#define XB_TOPGEN   3392
#define XCD_BAR_WORDS 3456
#define XB_SPIN_CAP (1u << 18)

__device__ __forceinline__ unsigned xb_ld(unsigned* p)              { return __hip_atomic_load(p, __ATOMIC_RELAXED, __HIP_MEMORY_SCOPE_AGENT); }
__device__ __forceinline__ unsigned xb_add(unsigned* p, unsigned v) { return __hip_atomic_fetch_add(p, v, __ATOMIC_RELAXED, __HIP_MEMORY_SCOPE_AGENT); }
__device__ __forceinline__ unsigned xb_xcc_id() { return (unsigned)__builtin_amdgcn_s_getreg((3 << 11) | 20) & 0xFu; }
#define XB_SPIN(cond, bar) do { unsigned _sp = 0; while (cond) { __builtin_amdgcn_s_sleep(1); \
    if ((++_sp & 255u) == 0u) { if (xb_ld(&(bar)[XB_TMO])) break; if (_sp > XB_SPIN_CAP) { atomicAdd(&(bar)[XB_TMO], 1u); break; } } } } while (0)

struct XcdBarrier {
    unsigned* bar; unsigned x;
    volatile LAS unsigned* st;
};

__device__ __forceinline__ XcdBarrier xcd_barrier_post(unsigned* bar, volatile LAS unsigned* st) {
    XcdBarrier b; b.bar = bar; b.x = xb_xcc_id(); b.st = st;
    if (threadIdx.x == 0) (void)xb_add(&bar[XB_XCNT(b.x)], 1u);
    return b;
}
__device__ __forceinline__ void xcd_barrier_complete(unsigned* bar, unsigned x, unsigned& nloc, unsigned& nx) {
    const unsigned G = gridDim.x * gridDim.y * gridDim.z;
    unsigned sum, cnt, mine, sp = 0u;
    for (;;) {
        sum = 0u; cnt = 0u; mine = 0u;
#pragma unroll
        for (unsigned j = 0; j < 16; ++j) { const unsigned c = xb_ld(&bar[XB_XCNT(j)]); sum += c; cnt += (c > 0u) ? 1u : 0u; mine = (j == x) ? c : mine; }
        if (sum == G) break;
        __builtin_amdgcn_s_sleep(1);
        if ((++sp & 255u) == 0u) { if (xb_ld(&bar[XB_TMO])) break; if (sp > XB_SPIN_CAP) { atomicAdd(&bar[XB_TMO], 1u); break; } }
    }
    nloc = mine > 0u ? mine : 1u; nx = cnt > 0u ? cnt : 1u;
}

__device__ __forceinline__ void xcd_barrier(const XcdBarrier& b) {
    asm volatile("s_waitcnt vmcnt(0)" ::: "memory");
    __syncthreads();
    if (threadIdx.x == 0) {
        unsigned* bar = b.bar;
        __builtin_amdgcn_s_waitcnt(0);
        unsigned nloc = b.st[0], nx = b.st[1];
        if (nloc == 0u) { xcd_barrier_complete(bar, b.x, nloc, nx); b.st[0] = nloc; b.st[1] = nx; }
        const unsigned old = xb_add(&bar[XB_XSUB(b.x)], 1u);
        const unsigned gen = old / nloc;
        if (old + 1u == (gen + 1u) * nloc) {
            __builtin_amdgcn_fence(__ATOMIC_RELEASE, "agent");
            asm volatile("s_waitcnt vmcnt(0)" ::: "memory");
            const unsigned og = xb_add(&bar[XB_TOP], 1u);
            const unsigned tg = og / nx;
            if (og + 1u == (tg + 1u) * nx) xb_add(&bar[XB_TOPGEN], 1u);
            else XB_SPIN(xb_ld(&bar[XB_TOPGEN]) == tg, bar);
            __builtin_amdgcn_fence(__ATOMIC_ACQUIRE, "agent");
            xb_add(&bar[XB_XGEN(b.x)], 1u);
            asm volatile("s_waitcnt vmcnt(0)" ::: "memory");
        } else {
            XB_SPIN(xb_ld(&bar[XB_XGEN(b.x)]) == gen, bar);
            __builtin_amdgcn_fence(__ATOMIC_ACQUIRE, "agent");
            asm volatile("s_waitcnt vmcnt(0)" ::: "memory");
        }
    }
    __syncthreads();
}

using pg8::Unit;
struct EpiStoreBf16 {
    static constexpr bool PERM = true, AFTER_DRAIN = false;
    bf16* O; int ldc;
    __device__ __forceinline__ void operator()(const pg8::f32x4 (&acc)[2][2][4][2], const Unit& u, int wr, int wc, int fr, int fq) const {
        const int row0 = u.pm * 256 + wr * 64 + fr, col0 = u.pn * 256 + wc * 32 + 8 * fq;
#pragma unroll
        for (int ai = 0; ai < 2; ++ai)
#pragma unroll
            for (int m = 0; m < 4; ++m) { bf16* rowp = O + (size_t)(row0 + ai * 128 + m * 16) * ldc + col0;
#pragma unroll
                for (int bj = 0; bj < 2; ++bj) { const pg8::f32x4 v0 = acc[ai][bj][m][0], v1 = acc[ai][bj][m][1];
                    v4u w; w.x = pg8::cvt_pk_bf16(v0[0], v0[1]); w.y = pg8::cvt_pk_bf16(v0[2], v0[3]); w.z = pg8::cvt_pk_bf16(v1[0], v1[1]); w.w = pg8::cvt_pk_bf16(v1[2], v1[3]);
                    *(v4u*)(rowp + bj * 128) = w; } }
    }
};
__device__ __forceinline__ float fast_sigmoid(float x) { return __builtin_amdgcn_rcpf(1.0f + __builtin_amdgcn_exp2f(-1.4426950408889634f * x)); }
struct EpiAux {
    static constexpr bool PERM = true, AFTER_DRAIN = false;
    bf16* G; bf16* YB; const bf16* AUXA; const float* gate_b  ; const float* sp8l2  ; const float* pool_b  ; const float* pool_scale  ;
    __device__ __forceinline__ void operator()(const pg8::f32x4 (&acc)[2][2][4][2], const Unit& u, int wr, int wc, int fr, int fq) const {
        const int q = u.pn, pmrow = u.pm % NTM; const int row0 = pmrow * 256 + wr * 64 + fr; const int c0 = wc * 32 + 8 * fq;
        if (q < 8) {
            const int blk = q >> 1, dir = q & 1;
            float br[8], bi[8], sp[8];
            { const float* p0 = gate_b + ((dir * 2 + 0) * 4 + blk) * 128 + c0, *p1 = gate_b + ((dir * 2 + 1) * 4 + blk) * 128 + c0, *p2 = sp8l2 + dir * 512 + blk * 128 + c0;
#pragma unroll
              for (int i = 0; i < 8; ++i) { br[i] = p0[i]; bi[i] = p1[i]; sp[i] = p2[i]; } }
            bf16* obase = G + (size_t)row0 * DM + q * 256 + c0; const bf16* ubase = AUXA + ((size_t)blk * T + row0) * 128 + c0;
#pragma unroll
            for (int ai = 0; ai < 2; ++ai) { v4u uq[4];
#pragma unroll
                for (int m = 0; m < 4; ++m) uq[m] = *(const v4u*)(ubase + (size_t)(ai * 128 + m * 16) * 128);
#pragma unroll
                for (int m = 0; m < 4; ++m) { const int ro = ai * 128 + m * 16;
                    const v4u uw = uq[m]; const float uu[8] = {bflo(uw.x), bfhi(uw.x), bflo(uw.y), bfhi(uw.y), bflo(uw.z), bfhi(uw.z), bflo(uw.w), bfhi(uw.w)};
                    float la[8], bx[8];
#pragma unroll
                    for (int i = 0; i < 8; ++i) { const float gr = acc[ai][0][m][i >> 2][i & 3] + br[i], gi = acc[ai][1][m][i >> 2][i & 3] + bi[i];
                        const float r = fast_sigmoid(gr), ig = fast_sigmoid(gi); const float l2 = -sp[i] * r;
                        const float x = -1.3862943611198906f * l2;
                        const float em = 1.0f - __builtin_amdgcn_exp2f(2.0f * l2);
                        const float sr = x * (1.0f + x * (-0.5f + x * (0.16666667f - 0.041666668f * x)));
                        const float om = x < 0.125f ? sr : em;
                        la[i] = l2; bx[i] = __builtin_amdgcn_sqrtf(om) * (ig * uu[i]); }
                    v4u w; w.x = pg8::cvt_pk_bf16(la[0], la[1]); w.y = pg8::cvt_pk_bf16(la[2], la[3]); w.z = pg8::cvt_pk_bf16(la[4], la[5]); w.w = pg8::cvt_pk_bf16(la[6], la[7]);
                    *(v4u*)(obase + (size_t)ro * DM) = w;
                    w.x = pg8::cvt_pk_bf16(bx[0], bx[1]); w.y = pg8::cvt_pk_bf16(bx[2], bx[3]); w.z = pg8::cvt_pk_bf16(bx[4], bx[5]); w.w = pg8::cvt_pk_bf16(bx[6], bx[7]);
                    *(v4u*)(obase + (size_t)ro * DM + 128) = w; } }
        } else {
            const int g = q - 8;
            const pg8::f32x4 b0 = *(const pg8::f32x4*)(pool_b + g * 128 + c0) * *(const pg8::f32x4*)(pool_scale + g * 128 + c0), b1 = *(const pg8::f32x4*)(pool_b + g * 128 + c0 + 4) * *(const pg8::f32x4*)(pool_scale + g * 128 + c0 + 4);
            bf16* obase = YB + (size_t)row0 * DM + 1024 + g * 128 + c0;
#pragma unroll
            for (int ai = 0; ai < 2; ++ai)
#pragma unroll
                for (int m = 0; m < 4; ++m) { const pg8::f32x4 v0 = acc[ai][0][m][0] + b0, v1 = acc[ai][0][m][1] + b1;
                    v4u w; w.x = pg8::cvt_pk_bf16(v0[0], v0[1]); w.y = pg8::cvt_pk_bf16(v0[2], v0[3]); w.z = pg8::cvt_pk_bf16(v1[0], v1[1]); w.w = pg8::cvt_pk_bf16(v1[2], v1[3]);
                    *(v4u*)(obase + (size_t)(ai * 128 + m * 16) * DM) = w; }
        }
    }
};
struct AuxSched {
    int G, c;
    __device__ __forceinline__ bool next(int i, Unit& u) const { const int L = i * G + c; if (L >= NTM * 12) return false; const int pmrow = L / 12, q = L % 12; u.pn = q; u.pm = (q < 8 ? (q >> 1) : (q - 4)) * NTM + pmrow; return true; }
    __device__ __forceinline__ void a_ready(const Unit&) const {}
    __device__ __forceinline__ void done(const Unit&) const {}
};
struct EpiResid {
    static constexpr bool PERM = true, AFTER_DRAIN = false;
    bf16* X; const float* mod  ; const float* in_x; const float* in_ctx;
    __device__ __forceinline__ void operator()(const pg8::f32x4 (&acc)[2][2][4][2], const Unit& u, int wr, int wc, int fr, int fq) const {
        const int b = u.pm / TPB, tb = u.pm - b * TPB; const int mrow = (tb == 0) ? 2 : b;
        const float* rin = !in_x ? nullptr : (tb == 0 ? in_ctx + (size_t)b * NCTX * DM : in_x + ((size_t)b * LSEQ + (size_t)(tb - 1) * 256) * DM);
        bf16* xb = X + (size_t)u.pm * 256 * DM;
        const int col0 = u.pn * 256 + wc * 32 + 8 * fq; const float* m2 = mod + (size_t)mrow * NMODC + 2 * DM + col0;
#pragma unroll
        for (int bj = 0; bj < 2; ++bj) { const pg8::f32x4 g0 = *(const pg8::f32x4*)(m2 + bj * 128), g1 = *(const pg8::f32x4*)(m2 + bj * 128 + 4);
#pragma unroll
            for (int ai = 0; ai < 2; ++ai) { pg8::f32x4 r0[4], r1[4];
                if (rin) {
#pragma unroll
                    for (int m = 0; m < 4; ++m) { const size_t ro = (size_t)(ai * 128 + wr * 64 + m * 16 + fr) * DM + col0 + bj * 128; r0[m] = *(const pg8::f32x4*)(rin + ro); r1[m] = *(const pg8::f32x4*)(rin + ro + 4); }
                } else { v4u w4[4];
#pragma unroll
                    for (int m = 0; m < 4; ++m) { const size_t ro = (size_t)(ai * 128 + wr * 64 + m * 16 + fr) * DM + col0 + bj * 128; w4[m] = *(const v4u*)(xb + ro); }
#pragma unroll
                    for (int m = 0; m < 4; ++m) { const v4u w = w4[m]; r0[m][0] = bflo(w.x); r0[m][1] = bfhi(w.x); r0[m][2] = bflo(w.y); r0[m][3] = bfhi(w.y); r1[m][0] = bflo(w.z); r1[m][1] = bfhi(w.z); r1[m][2] = bflo(w.w); r1[m][3] = bfhi(w.w); }
                }
#pragma unroll
                for (int m = 0; m < 4; ++m) { const size_t ro = (size_t)(ai * 128 + wr * 64 + m * 16 + fr) * DM + col0 + bj * 128;
                    const pg8::f32x4 o0 = r0[m] + g0 * acc[ai][bj][m][0], o1 = r1[m] + g1 * acc[ai][bj][m][1];
                    v4u w; w.x = pg8::cvt_pk_bf16(o0[0], o0[1]); w.y = pg8::cvt_pk_bf16(o0[2], o0[3]); w.z = pg8::cvt_pk_bf16(o1[0], o1[1]); w.w = pg8::cvt_pk_bf16(o1[2], o1[3]);
                    *(v4u*)(xb + ro) = w; } } }
    }
};
struct MoeSched {
    const LAS int* perm; int ncol, G, c, lim;
    const LAS int* gt;
    __device__ __forceinline__ int row(int ui, int r) const { return gt[ui * 256 + r]; }
    __device__ __forceinline__ bool next(int i, Unit& u) const {
        const int L = i * G + c; const int nt = perm[0]; if (L >= nt * ncol || L >= lim) return false;
        const int q = L / ncol, j = L - q * ncol; const int pe = perm[1 + q];
        u.pm = pe & 0xffff; u.pn = (pe >> 16) * ncol + j; u.aux = q; return true;
    }
    __device__ __forceinline__ void a_ready(const Unit&) const {}
    __device__ __forceinline__ void done(const Unit&) const {}
};
struct MoeOneUp {
    const LAS int* perm; int L; const LAS int* gt;
    __device__ __forceinline__ int row(int, int r) const { return gt[r]; }
    __device__ __forceinline__ bool next(int i, Unit& u) const { if (i > 0) return false; const int q = L >> 2, j = L & 3; const int pe = perm[1 + q]; u.pm = pe & 0xffff; u.pn = (pe >> 16) * 4 + j; u.aux = q; return true; }
    __device__ __forceinline__ void a_ready(const Unit&) const {}
    __device__ __forceinline__ void done(const Unit&) const {}
};
struct MoeDownSched {
    const LAS int* perm; int G, c, R, qov; const unsigned* cnt;
    __device__ __forceinline__ bool next(int i, Unit& u) const {
        int L;
        if (R == 0) L = i * G + c;
        else { const int vi = c < R ? i + 2 : i; L = vi < 2 ? vi * (G - R) + (c - R) : 2 * (G - R) + (vi - 2) * G + c; }
        const int nt = perm[0]; if (L >= nt * 8) return false;
        const int q = L >> 3, j = L & 7; const int pe = perm[1 + q];
        u.pm = pe & 0xffff; u.pn = (pe >> 16) * 8 + j; u.aux = q; return true;
    }
    __device__ __forceinline__ void a_ready(const Unit& u) const {
        if (R == 0 || u.aux < qov) return;
        const unsigned* w = cnt + u.aux;
        for (unsigned sp = 0; sp < (1u << 24); ++sp) { if ((unsigned)__builtin_amdgcn_readfirstlane((int)__hip_atomic_load(w, __ATOMIC_RELAXED, __HIP_MEMORY_SCOPE_AGENT)) >= 4u) break; __builtin_amdgcn_s_sleep(2); }
        __builtin_amdgcn_fence(__ATOMIC_ACQUIRE, "agent");
    }
    __device__ __forceinline__ void done(const Unit&) const {}
};
struct EpiSwiGLU {
    static constexpr bool PERM = true, AFTER_DRAIN = false;
    bf16* HM; const float* wslot;
    __device__ __forceinline__ void operator()(const pg8::f32x4 (&acc)[2][2][4][2], const Unit& u, int wr, int wc, int fr, int fq) const {
        const int j = u.pn & 3; const int row0 = u.pm * 256 + wr * 64 + fr, col0 = j * 128 + wc * 32 + 8 * fq;
        float ws[8];
#pragma unroll
        for (int i = 0; i < 8; ++i) ws[i] = wslot[row0 + (i >> 2) * 128 + (i & 3) * 16];
#pragma unroll
        for (int ai = 0; ai < 2; ++ai)
#pragma unroll
            for (int m = 0; m < 4; ++m) { float h[8];
#pragma unroll
                for (int n = 0; n < 2; ++n)
#pragma unroll
                    for (int x = 0; x < 4; ++x) h[n * 4 + x] = ws[ai * 4 + m] * siluf_(acc[ai][0][m][n][x]) * acc[ai][1][m][n][x];
                v4u w; w.x = pg8::cvt_pk_bf16(h[0], h[1]); w.y = pg8::cvt_pk_bf16(h[2], h[3]); w.z = pg8::cvt_pk_bf16(h[4], h[5]); w.w = pg8::cvt_pk_bf16(h[6], h[7]);
                *(v4u*)(HM + (size_t)(row0 + ai * 128 + m * 16) * DEXP + col0) = w; }
    }
};
struct EpiDown {
    static constexpr bool PERM = true, AFTER_DRAIN = false;
    bf16* YS;
    __device__ __forceinline__ void operator()(const pg8::f32x4 (&acc)[2][2][4][2], const Unit& u, int wr, int wc, int fr, int fq) const {
        const int j = u.pn & 7; const int row0 = u.pm * 256 + wr * 64 + fr, col0 = j * 256 + wc * 32 + 8 * fq;
#pragma unroll
        for (int ai = 0; ai < 2; ++ai)
#pragma unroll
            for (int m = 0; m < 4; ++m) { const int row = row0 + ai * 128 + m * 16;
#pragma unroll
                for (int bj = 0; bj < 2; ++bj) { const pg8::f32x4 v0 = acc[ai][bj][m][0], v1 = acc[ai][bj][m][1];
                    v4u w; w.x = pg8::cvt_pk_bf16(v0[0], v0[1]); w.y = pg8::cvt_pk_bf16(v0[2], v0[3]); w.z = pg8::cvt_pk_bf16(v1[0], v1[1]); w.w = pg8::cvt_pk_bf16(v1[2], v1[3]);
                    *(v4u*)(YS + (size_t)row * DM + col0 + bj * 128) = w; } }
    }
};
struct RowOrder {
    pg8::StaticOrder S; bool latent_only;
    __device__ __forceinline__ bool next(int i, Unit& u) const { if (!S.next(i, u)) return false; if (latent_only) u.pm = u.pm + 1 + (u.pm >= TPB - 1 ? 1 : 0); return true; }
    __device__ __forceinline__ void a_ready(const Unit&) const {}
    __device__ __forceinline__ void done(const Unit&) const {}
};
struct OneUnit {
    int pm, pn;
    __device__ __forceinline__ bool next(int i, Unit& u) const { if (i > 0) return false; u.pm = pm; u.pn = pn; return true; }
    __device__ __forceinline__ void a_ready(const Unit&) const {}
    __device__ __forceinline__ void done(const Unit&) const {}
};

struct Frame {
    LAS unsigned char* lds; unsigned char* ws; const float* const* in;
    int tid, lane, wave, vcu, G;
};
enum { I_X = 0, I_C, I_CTX, I_CCTX, I_MODW, I_MODB, I_NMIX, I_NFFN, I_WIN, I_WOUT, I_RGCW, I_RGCB, I_RGGW, I_RGGB, I_RGLAM, I_SCW, I_POOLW, I_POOLB, I_POOLS, I_DALAM, I_DANORM,
       I_GRPW, I_GRPB, I_EXPW, I_EXPB, I_UP, I_DOWN, I_NFINAL };

__device__ __forceinline__ void transpose_item(const float* W, int K, int N, bf16* WT, int k0, int n0, int n0_out, LAS float* scr, int lane) {
    float v[32];
#pragma unroll
    for (int i = 0; i < 32; ++i) { const int kk = 2 * i + (lane >> 5); v[i] = W[(size_t)(k0 + kk) * N + n0 + (lane & 31)]; }
#pragma unroll
    for (int i = 0; i < 32; ++i) { const int kk = 2 * i + (lane >> 5); scr[kk * 33 + (lane & 31)] = v[i]; }
    LDS_WAIT(); asm volatile("" ::: "memory");
    const int c = lane & 7;
#pragma unroll
    for (int j = 0; j < 4; ++j) { const int n = (lane >> 3) + 8 * j; const LAS float* s = scr + (8 * c) * 33 + n;
        v4u o; o.x = pk2_hw(s[0 * 33], s[1 * 33]); o.y = pk2_hw(s[2 * 33], s[3 * 33]); o.z = pk2_hw(s[4 * 33], s[5 * 33]); o.w = pk2_hw(s[6 * 33], s[7 * 33]);
        *(GAS v4u*)(WT + (size_t)(n0_out + n) * K + k0 + 8 * c) = o; }
    LDS_WAIT(); asm volatile("" ::: "memory");
}
__device__ __forceinline__ void p0_prologue(Frame& F) {
    const int gw = F.vcu * NWAVES + F.wave, NGW = F.G * NWAVES;
    LAS float* S = (LAS float*)(F.lds);
    for (int i = F.tid; i < 3 * DM; i += NWAVES * 64) { const int r = i / DM, k = i % DM; const float c = r < 2 ? F.in[I_C][r * DM + k] : F.in[I_CCTX][k]; S[i] = siluf_(c); }
    __syncthreads();
    {
        float* MODP = (float*)(F.ws + WS_MODP);
        for (int it = gw; it < DEPTH * 48 * KSPLIT; it += NGW) {
            const int kc = it % KSPLIT, nch = (it / KSPLIT) % 48, l = it / (KSPLIT * 48);
            const float* W = F.in[I_MODW] + ((size_t)l * DM + kc * 128) * NMODC + 4 * (nch * 64 + F.lane);
            f32x4 a0 = {0.f, 0.f, 0.f, 0.f}, a1 = a0, a2 = a0;
            for (int k0 = 0; k0 < 128; k0 += 32) {
                f32x4 wv[32];
#pragma unroll
                for (int k = 0; k < 32; ++k) wv[k] = __builtin_nontemporal_load((const GAS f32x4*)(W + (size_t)(k0 + k) * NMODC));
                __builtin_amdgcn_sched_barrier(0);
#pragma unroll
                for (int k = 0; k < 32; ++k) { const int kk = kc * 128 + k0 + k; a0 += wv[k] * S[kk]; a1 += wv[k] * S[DM + kk]; a2 += wv[k] * S[2 * DM + kk]; }
            }
            float* o = MODP + ((size_t)(l * KSPLIT + kc) * 3) * NMODC + 4 * (nch * 64 + F.lane);
            *(f32x4*)o = a0; *(f32x4*)(o + NMODC) = a1; *(f32x4*)(o + 2 * NMODC) = a2;
        }
    }
    __syncthreads();
    {
        LAS float* scr = (LAS float*)(F.lds + F.wave * 16384);
        constexpr int I_IN = 32 * 144, I_OUT = 32 * 64;
        constexpr int PER_L = I_IN + I_OUT;
        for (int it = gw; it < DEPTH * PER_L; it += NGW) {
            const int l = it / PER_L; int r = it % PER_L;
            if (r < I_IN) { const int kb = r / 144, nb = r % 144; transpose_item(F.in[I_WIN] + (size_t)l * DM * PIN, DM, PIN, (bf16*)(F.ws + WS_WIN) + (size_t)l * PIN * DM, 64 * kb, 32 * nb, 32 * nb, scr, F.lane); continue; } r -= I_IN;
            { const int kb = r / 64, nb = r % 64; transpose_item(F.in[I_WOUT] + (size_t)l * DM * DM, DM, DM, (bf16*)(F.ws + WS_WOUT) + (size_t)l * DM * DM, 64 * kb, 32 * nb, 32 * nb, scr, F.lane); }
        }
    }
    {
        const int gt = F.vcu * NWAVES * 64 + F.tid, NGT = F.G * NWAVES * 64;
        bf16* AUXB = (bf16*)(F.ws + WS_AUXB);
        for (int idx0 = gt; idx0 < DEPTH * 12 * 256 * 128; idx0 += 6 * NGT) {
            float vv[6];
#pragma unroll
            for (int u = 0; u < 6; ++u) { const int idx = idx0 + u * NGT; vv[u] = 0.f;
                if (idx < DEPTH * 12 * 256 * 128) { const int k = idx & 127, rr = (idx >> 7) & 255, q = (idx >> 15) % 12, l = idx / (12 * 256 * 128);
                    if (q < 8) { const int blk = q >> 1, dir = q & 1, gate = rr >> 7, e = rr & 127; vv[u] = F.in[I_RGGW][((((size_t)(l * 2 + dir) * 2 + gate) * 4 + blk) * 128 + k) * 128 + e]; }
                    else { const int g = q - 8; vv[u] = rr < 128 ? F.in[I_POOLW][(((size_t)l * 4 + g) * 128 + k) * 128 + rr] * F.in[I_POOLS][l * 512 + g * 128 + rr] : 0.f; } } }
#pragma unroll
            for (int u = 0; u < 6; ++u) { const int idx = idx0 + u * NGT; if (idx < DEPTH * 12 * 256 * 128) AUXB[idx] = (bf16)f2bf(vv[u]); }
        }
        float* SP8 = (float*)(F.ws + WS_WRT) + DEPTH * NROUTE * DM;
        for (int idx = gt; idx < DEPTH * 2 * 512; idx += NGT) SP8[idx] = 8.0f * 1.4426950408889634f * log1pf(__expf(-F.in[I_RGLAM][idx]));
        float* WRT = (float*)(F.ws + WS_WRT);
        for (int idx = gt; idx < DEPTH * NROUTE * DM; idx += NGT) {
            const int k = idx % DM, n = (idx / DM) % NROUTE, l = idx / (DM * NROUTE);
            WRT[idx] = n < 4 ? F.in[I_GRPW][((size_t)l * DM + k) * 4 + n] : F.in[I_EXPW][((size_t)l * DM + k) * 32 + (n - 4)];
        }
    }
}
struct CvtItem { const float* W; bf16* WT; int K, N, k0, n0, n0_out; };
constexpr int CVT_UPE = 32 * 8, CVT_DNE = 8 * 16;
constexpr int CVT_L = NEXP * (CVT_UPE + CVT_DNE);
__device__ __forceinline__ CvtItem moe_item(Frame& F, int it) {
    const int l = it / CVT_L; int r = it % CVT_L; CvtItem c;
    if (r < NEXP * CVT_UPE) { const int e = r / CVT_UPE, q = r % CVT_UPE, kb = q / 8, nb = q % 8; const int n0 = 128 * nb, half = n0 >> 9, jj = (n0 & 511) >> 7;
        c.W = F.in[I_UP] + ((size_t)l * NEXP + e) * DM * 1024; c.WT = (bf16*)(F.ws + WS_UP) + ((size_t)l * NEXP + e) * 1024 * DM; c.K = DM; c.N = 1024; c.k0 = 64 * kb; c.n0 = n0; c.n0_out = jj * 256 + half * 128; }
    else { r -= NEXP * CVT_UPE; const int e = r / CVT_DNE, q = r % CVT_DNE, kb = q / 16, nb = q % 16;
        c.W = F.in[I_DOWN] + ((size_t)l * NEXP + e) * DEXP * DM; c.WT = (bf16*)(F.ws + WS_DOWN) + ((size_t)l * NEXP + e) * DM * DEXP; c.K = DEXP; c.N = DM; c.k0 = 64 * kb; c.n0 = 128 * nb; c.n0_out = 128 * nb; }
    return c;
}
__device__ __forceinline__ void cvt_load(const CvtItem& c, v2u (&v)[32], int lane) {
    const float* p = c.W + (size_t)(c.k0 + (lane >> 5)) * c.N + c.n0 + 4 * (lane & 31); const size_t step = (size_t)2 * c.N;
    f32x4 t[32];
#pragma unroll
    for (int i = 0; i < 32; ++i) { t[i] = __builtin_nontemporal_load((const GAS f32x4*)p); p += step; asm volatile("" : "+v"(p)); }
#pragma unroll
    for (int i = 0; i < 32; ++i) { v[i].x = pk2_hw(t[i].x, t[i].y); v[i].y = pk2_hw(t[i].z, t[i].w); }
}
__device__ __forceinline__ void cvt_finish(const CvtItem& c, const v2u (&v)[32], LAS unsigned char* scr, int lane) {
    constexpr int PT = 264;
#pragma unroll
    for (int i = 0; i < 32; ++i) *(LAS v2u*)(scr + (2 * i + (lane >> 5)) * PT + 8 * (lane & 31)) = v[i];
    LDS_WAIT(); asm volatile("" ::: "memory");
#pragma unroll 4
    for (int q = 0; q < 16; ++q) { const int ci = lane + 64 * q, n = ci >> 3, cq = ci & 7; const LAS unsigned char* s = scr + (8 * cq) * PT + 2 * n;
        v4u o; o.x = (unsigned)*(const LAS unsigned short*)(s) | ((unsigned)*(const LAS unsigned short*)(s + PT) << 16); o.y = (unsigned)*(const LAS unsigned short*)(s + 2 * PT) | ((unsigned)*(const LAS unsigned short*)(s + 3 * PT) << 16);
        o.z = (unsigned)*(const LAS unsigned short*)(s + 4 * PT) | ((unsigned)*(const LAS unsigned short*)(s + 5 * PT) << 16); o.w = (unsigned)*(const LAS unsigned short*)(s + 6 * PT) | ((unsigned)*(const LAS unsigned short*)(s + 7 * PT) << 16);
        __builtin_nontemporal_store(o, (GAS v4u*)(c.WT + (size_t)(c.n0_out + n) * c.K + c.k0 + 8 * cq)); }
    LDS_WAIT(); asm volatile("" ::: "memory");
}
__device__ __forceinline__ void moe_convert_range(Frame& F, int lo, int hi, int rank, int nrank) {
    const int step = nrank * NWAVES;
    LAS unsigned char* scr = F.lds + F.wave * 16896;
    for (int it = lo + rank * NWAVES + F.wave; it < hi; it += step) {
        v2u va[32]; const CvtItem ca = moe_item(F, it); cvt_load(ca, va, F.lane); cvt_finish(ca, va, scr, F.lane);
    }
}
__device__ __forceinline__ void p0b_modreduce(Frame& F) {
    const int gt = F.vcu * NWAVES * 64 + F.tid, NGT = F.G * NWAVES * 64;
    const float* MODP = (const float*)(F.ws + WS_MODP); float* MOD = (float*)(F.ws + WS_MOD);
    for (int idx = gt; idx < DEPTH * 3 * NMODC; idx += NGT) {
        const int n = idx % NMODC, r = (idx / NMODC) % 3, l = idx / (3 * NMODC);
        float s = F.in[I_MODB][l * NMODC + n];
#pragma unroll
        for (int kc = 0; kc < KSPLIT; ++kc) s += MODP[((size_t)(l * KSPLIT + kc) * 3 + r) * NMODC + n];
        MOD[idx] = s;
    }
}
template <int MODE> __device__ __forceinline__ void phase_norm1(Frame& F, int l, float* out) {
    const int gw = F.vcu * NWAVES + F.wave, NGW = F.G * NWAVES;
    bf16* X = (bf16*)(F.ws + WS_X); bf16* H = (bf16*)(F.ws + WS_H); const bf16* YS = (const bf16*)(F.ws + WS_YS);
    const float* MOD = (const float*)(F.ws + WS_MOD); const int* slot = (const int*)(F.ws + WS_ROUTE) + RT_SLOT;
    for (int r = gw; r < T; r += NGW) {
        const int b = r / SEGB, i = r - b * SEGB; const bool isctx = i < NCTX; const int mrow = isctx ? 2 : b;
        if (MODE == 2 && isctx) continue;
        f32x4 v[8];
        if (MODE == 0) {
            const float* src = isctx ? F.in[I_CTX] + ((size_t)b * NCTX + i) * DM : F.in[I_X] + ((size_t)b * LSEQ + (i - NCTX)) * DM;
#pragma unroll
            for (int j = 0; j < 4; ++j) { const int c = 8 * (F.lane + 64 * j); v[2 * j] = *(const GAS f32x4*)(src + c); v[2 * j + 1] = *(const GAS f32x4*)(src + c + 4); }
        } else {
            const int lp = (MODE == 2) ? DEPTH - 1 : l - 1;
            const float* m5 = MOD + ((size_t)lp * 3 + mrow) * NMODC + 5 * DM;
            const int s1 = slot[2 * r], s2 = slot[2 * r + 1];
            const bf16* y1 = YS + (size_t)s1 * DM, *y2 = YS + (size_t)s2 * DM;
#pragma unroll
            for (int j = 0; j < 4; ++j) { const int c = 8 * (F.lane + 64 * j);
                const v4u xw = *(const GAS v4u*)(X + (size_t)r * DM + c), a = *(const GAS v4u*)(y1 + c), bb = *(const GAS v4u*)(y2 + c);
                const f32x4 g0 = *(const GAS f32x4*)(m5 + c), g1 = *(const GAS f32x4*)(m5 + c + 4);
                f32x4 x0, x1, ys0, ys1;
                x0.x = bflo(xw.x); x0.y = bfhi(xw.x); x0.z = bflo(xw.y); x0.w = bfhi(xw.y); x1.x = bflo(xw.z); x1.y = bfhi(xw.z); x1.z = bflo(xw.w); x1.w = bfhi(xw.w);
                ys0.x = bflo(a.x) + bflo(bb.x); ys0.y = bfhi(a.x) + bfhi(bb.x); ys0.z = bflo(a.y) + bflo(bb.y); ys0.w = bfhi(a.y) + bfhi(bb.y);
                ys1.x = bflo(a.z) + bflo(bb.z); ys1.y = bfhi(a.z) + bfhi(bb.z); ys1.z = bflo(a.w) + bflo(bb.w); ys1.w = bfhi(a.w) + bfhi(bb.w);
                v[2 * j] = x0 + g0 * ys0; v[2 * j + 1] = x1 + g1 * ys1; }
        }
        float ss = 0.f;
#pragma unroll
        for (int j = 0; j < 8; ++j) ss += (v[j].x * v[j].x + v[j].y * v[j].y) + (v[j].z * v[j].z + v[j].w * v[j].w);
        const float rstd = 1.0f / sqrtf(wave_sum(ss) * (1.0f / DM) + EPS);
        if (MODE == 2) {
            float* o = out + ((size_t)b * LSEQ + (i - NCTX)) * DM; const float* g = F.in[I_NFINAL];
#pragma unroll
            for (int j = 0; j < 4; ++j) { const int c = 8 * (F.lane + 64 * j); v[2 * j] = v[2 * j] * rstd * *(const GAS f32x4*)(g + c); v[2 * j + 1] = v[2 * j + 1] * rstd * *(const GAS f32x4*)(g + c + 4); }
#pragma unroll
            for (int j = 0; j < 4; ++j) { const int c = 8 * (F.lane + 64 * j); *(GAS f32x4*)(o + c) = v[2 * j]; *(GAS f32x4*)(o + c + 4) = v[2 * j + 1]; }
        } else {
            const float* g = F.in[I_NMIX] + (size_t)l * DM; const float* sh = MOD + ((size_t)l * 3 + mrow) * NMODC, *sc = sh + DM;
            v4u hw[4];
            f32x4 gg[8], cc[8], ss[8];
#pragma unroll
            for (int j = 0; j < 4; ++j) { const int c = 8 * (F.lane + 64 * j);
                gg[2 * j] = *(const GAS f32x4*)(g + c); gg[2 * j + 1] = *(const GAS f32x4*)(g + c + 4); cc[2 * j] = *(const GAS f32x4*)(sc + c); cc[2 * j + 1] = *(const GAS f32x4*)(sc + c + 4);
                ss[2 * j] = *(const GAS f32x4*)(sh + c); ss[2 * j + 1] = *(const GAS f32x4*)(sh + c + 4); }
            asm volatile("" : "+v"(gg[0]), "+v"(gg[7]), "+v"(cc[0]), "+v"(cc[7]), "+v"(ss[0]), "+v"(ss[7]));
#pragma unroll
            for (int j = 0; j < 4; ++j) {
                const f32x4 h0 = v[2 * j] * rstd * gg[2 * j] * (cc[2 * j] + 1.0f) + ss[2 * j];
                const f32x4 h1 = v[2 * j + 1] * rstd * gg[2 * j + 1] * (cc[2 * j + 1] + 1.0f) + ss[2 * j + 1];
                hw[j].x = pk2(h0.x, h0.y); hw[j].y = pk2(h0.z, h0.w); hw[j].z = pk2(h1.x, h1.y); hw[j].w = pk2(h1.z, h1.w); }
#pragma unroll
            for (int j = 0; j < 4; ++j) { const int c = 8 * (F.lane + 64 * j);
                if (MODE != 0) { v4u xw; xw.x = pk2(v[2 * j].x, v[2 * j].y); xw.y = pk2(v[2 * j].z, v[2 * j].w); xw.z = pk2(v[2 * j + 1].x, v[2 * j + 1].y); xw.w = pk2(v[2 * j + 1].z, v[2 * j + 1].w);
                    *(GAS v4u*)(X + (size_t)r * DM + c) = xw; }
                *(GAS v4u*)(H + (size_t)r * DM + c) = hw[j]; }
        }
    }
}
__device__ __forceinline__ void unpack8(const v4u w, float (&f)[8]) { f[0] = bflo(w.x); f[1] = bfhi(w.x); f[2] = bflo(w.y); f[3] = bfhi(w.y); f[4] = bflo(w.z); f[5] = bfhi(w.z); f[6] = bflo(w.w); f[7] = bfhi(w.w); }
__device__ __forceinline__ v4u pack8f(const float (&f)[8]) { v4u w; w.x = pk2(f[0], f[1]); w.y = pk2(f[2], f[3]); w.z = pk2(f[4], f[5]); w.w = pk2(f[6], f[7]); return w; }
__device__ __forceinline__ void phase_prep(Frame& F, int l) {
    const bf16* P = (const bf16*)(F.ws + WS_P); bf16* AUXA = (bf16*)(F.ws + WS_AUXA); bf16* YB = (bf16*)(F.ws + WS_YB);
    bf16* QP = (bf16*)(F.ws + WS_QP); bf16* KP = (bf16*)(F.ws + WS_KP); bf16* VT = (bf16*)(F.ws + WS_VT);
    const int tid = F.tid, lane = F.lane, cg = tid & 63, tw = tid >> 6;
    LAS unsigned char* vl = F.lds;
    constexpr int VP = 1040;
    for (int it = F.vcu; it < NBATCH * CH64 * 5; it += F.G) {
        const int u = it / 5, st = it - 5 * u;
        const int b = u / CH64, cj = u % CH64; const bool isctx = cj < 4;
        const int seg0 = b * SEGB + (isctx ? 0 : NCTX), seglen = isctx ? NCTX : LSEQ, s0 = (isctx ? cj : cj - 4) * 64;
        const int r0 = seg0 + s0;
        const v4u zero4 = {0u, 0u, 0u, 0u};
#define LDV(s, col) (((s) >= 0 && (s) < seglen) ? *(const GAS v4u*)(P + (size_t)(seg0 + (s)) * PIN + (col)) : zero4)
        if (st == 0) {
            const int c0 = 8 * cg, t0 = s0 + 8 * tw; float w0[8], w1[8], w2[8], w3[8], bs[8];
            const float* cw = F.in[I_RGCW] + (size_t)l * 4 * 512 + c0;
#pragma unroll
            for (int i = 0; i < 8; ++i) { w0[i] = cw[i]; w1[i] = cw[512 + i]; w2[i] = cw[1024 + i]; w3[i] = cw[1536 + i]; bs[i] = F.in[I_RGCB][l * 512 + c0 + i]; }
            float xa[8], xb[8], xc[8], xd[8]; v4u raw[11];
#pragma unroll
            for (int t = 0; t < 11; ++t) raw[t] = LDV(t0 - 2 + t, c0);
            unpack8(raw[0], xa); unpack8(raw[1], xb); unpack8(raw[2], xc);
            bf16* o = AUXA + ((size_t)(cg >> 4) * T + (r0 + 8 * tw)) * 128 + (cg & 15) * 8;
#pragma unroll
            for (int t = 0; t < 8; ++t) { unpack8(raw[t + 3], xd); float y[8];
#pragma unroll
                for (int i = 0; i < 8; ++i) { y[i] = bs[i] + w0[i] * xa[i] + w1[i] * xb[i] + w2[i] * xc[i] + w3[i] * xd[i]; xa[i] = xb[i]; xb[i] = xc[i]; xc[i] = xd[i]; }
                *(GAS v4u*)(o + (size_t)t * 128) = pack8f(y); }
        }
        if (st == 1) {
            const int c0 = 8 * cg; float w0[8], w1[8], w2[8];
            const float* sw = F.in[I_SCW] + (size_t)l * 3 * 512 + c0;
#pragma unroll
            for (int i = 0; i < 8; ++i) { w0[i] = sw[i]; w1[i] = sw[512 + i]; w2[i] = sw[1024 + i]; }
#pragma unroll 1
            for (int hf = 0; hf < 2; ++hf) {
                const int t0 = s0 + 8 * tw + 4 * hf; float za[8], zb[8], zc[8], p1[8], p2[8]; v4u rc[6], rx[6], rb[4];
#pragma unroll
                for (int t = 0; t < 6; ++t) { rc[t] = LDV(t0 - 1 + t, 1536 + c0); rx[t] = LDV(t0 - 1 + t, 2048 + c0); }
#pragma unroll
                for (int t = 0; t < 4; ++t) rb[t] = LDV(t0 + t, 1024 + c0);
                unpack8(rc[0], p1); unpack8(rx[0], p2);
#pragma unroll
                for (int i = 0; i < 8; ++i) za[i] = p1[i] * p2[i];
                unpack8(rc[1], p1); unpack8(rx[1], p2);
#pragma unroll
                for (int i = 0; i < 8; ++i) zb[i] = p1[i] * p2[i];
#pragma unroll
                for (int t = 0; t < 4; ++t) { unpack8(rc[t + 2], p1); unpack8(rx[t + 2], p2); float bb[8], y[8]; unpack8(rb[t], bb);
#pragma unroll
                    for (int i = 0; i < 8; ++i) { zc[i] = p1[i] * p2[i]; y[i] = bb[i] * (w0[i] * za[i] + w1[i] * zb[i] + w2[i] * zc[i]); za[i] = zb[i]; zb[i] = zc[i]; }
                    *(GAS v4u*)(YB + (size_t)(r0 + 8 * tw + 4 * hf + t) * DM + 512 + c0) = pack8f(y); }
            }
        }
        if (st == 2) {
            const int g = tw & 3, th = tw >> 2, hw = 1 << g, c0 = 2560 + g * 128 + 8 * (lane & 15), tl0 = 32 * th + 8 * (lane >> 4), t0 = s0 + tl0;
            float sum[8], xv[8];
#pragma unroll
            for (int i = 0; i < 8; ++i) sum[i] = 0.f;
            { v4u wv[16];
#pragma unroll
              for (int k = 0; k < 16; ++k) wv[k] = (k < 2 * hw) ? LDV(t0 - hw + k, c0) : zero4;
#pragma unroll
              for (int k = 0; k < 16; ++k) { unpack8(wv[k], xv);
#pragma unroll
                for (int i = 0; i < 8; ++i) sum[i] += xv[i]; } }
            bf16* o = AUXA + ((size_t)(4 + g) * T + (r0 + tl0)) * 128 + 8 * (lane & 15);
#pragma unroll 1
            for (int hf = 0; hf < 2; ++hf) {
            v4u rv[4], re[4], rl[4];
#pragma unroll
            for (int t = 0; t < 4; ++t) { rv[t] = LDV(t0 + 4 * hf + t, c0); re[t] = LDV(t0 + 4 * hf + t + hw, c0); rl[t] = LDV(t0 + 4 * hf + t - hw, c0); }
#pragma unroll
            for (int t = 0; t < 4; ++t) { const int s = t0 + 4 * hf + t; const int lo = s - hw < 0 ? 0 : s - hw, hi = s + hw > seglen ? seglen : s + hw; const float rc = 1.0f / (float)(hi - lo);
                float y[8], xe[8], xl[8]; unpack8(rv[t], xv); unpack8(re[t], xe); unpack8(rl[t], xl);
#pragma unroll
                for (int i = 0; i < 8; ++i) { y[i] = sum[i] * rc - xv[i]; sum[i] += xe[i] - xl[i]; }
                *(GAS v4u*)(o + (size_t)(4 * hf + t) * 128) = pack8f(y); }
            }
        }
        if (st == 3) {
            const int vec = tid & 127, tq = tid >> 7, which = vec >> 6, hc = (vec >> 3) & 7, dg = vec & 7, axis = dg >> 2, part = (dg >> 1) & 1, jj0 = (dg & 1) * 8;
            const int col = 3072 + 8 * vec, pcol = 3072 + 8 * (vec ^ 2);
            bf16* dst = (which ? KP : QP) + ((size_t)(b * 8 + hc) * SEGB + cj * 64 + 16 * tq) * 64 + 8 * dg;
            const float scl = which ? 1.0f : QSCALE; const float sgn = part ? 1.0f : -1.0f;
            float inv[8];
#pragma unroll
            for (int i = 0; i < 8; ++i) inv[i] = __builtin_amdgcn_exp2f(-(float)(jj0 + i) * (13.287712379549449f / 16.0f)) * 0.15915494309189535f;
            for (int tg = 0; tg < 16; tg += 8) {
            v4u ro[8], rp[8];
#pragma unroll
            for (int t = 0; t < 8; ++t) { ro[t] = *(const GAS v4u*)(P + (size_t)(r0 + 16 * tq + tg + t) * PIN + col); rp[t] = *(const GAS v4u*)(P + (size_t)(r0 + 16 * tq + tg + t) * PIN + pcol); }
#pragma unroll
            for (int t8 = 0; t8 < 8; ++t8) { const int t = tg + t8; const int tl = 16 * tq + t; float xo[8], xp[8], y[8];
                unpack8(ro[t8], xo); unpack8(rp[t8], xp);
                if (!isctx) { const float pos = (float)(axis ? ((s0 + tl) & 63) : ((s0 + tl) >> 6));
#pragma unroll
                    for (int i = 0; i < 8; ++i) { const float rev = pos * inv[i]; const float sn = __builtin_amdgcn_sinf(rev), cs = __builtin_amdgcn_cosf(rev); y[i] = (xo[i] * cs + sgn * xp[i] * sn) * scl; }
                } else {
#pragma unroll
                    for (int i = 0; i < 8; ++i) y[i] = xo[i] * scl;
                }
                *(GAS v4u*)(dst + (size_t)t * 64) = pack8f(y); }
            }
        }
        if (st == 4) {
            __syncthreads();
            v4u vr[8];
#pragma unroll
            for (int t = 0; t < 8; ++t) vr[t] = *(const GAS v4u*)(P + (size_t)(r0 + 8 * tw + t) * PIN + 4096 + 8 * cg);
#pragma unroll
            for (int t = 0; t < 8; ++t) *(LAS v4u*)(vl + (8 * tw + t) * VP + 16 * cg) = vr[t];
            __syncthreads();
            const int h = tid >> 7, e = tid & 127; unsigned w[32];
#pragma unroll
            for (int i = 0; i < 32; ++i) w[i] = 0u;
#pragma unroll
            for (int t = 0; t < 64; ++t) { const int q = t & 15, pq = (q & 3) | ((q & 4) << 1) | ((q & 8) >> 1); const int kvp = (t & 48) + pq;
                const unsigned v = *(const LAS unsigned short*)(vl + t * VP + 2 * tid); w[kvp >> 1] |= v << (16 * (kvp & 1)); }
            v4u* o = (v4u*)(VT + (((size_t)(b * 4 + h) * CH64 + cj) * 128 + e) * 64);
#pragma unroll
            for (int i = 0; i < 8; ++i) { v4u x; x.x = w[4 * i]; x.y = w[4 * i + 1]; x.z = w[4 * i + 2]; x.w = w[4 * i + 3]; o[i] = x; }
        }
#undef LDV
    }
    __syncthreads();
}
__device__ __forceinline__ void phase_scan1(Frame& F, int l) {
    const bf16* G = (const bf16*)(F.ws + WS_G); float* SUM = (float*)(F.ws + WS_SUM);
    const int ch = F.tid, blk = ch >> 7, e = ch & 127;
    for (int u = F.vcu; u < NBATCH * 2 * CH64; u += F.G) {
        const int cj = u % CH64, dir = (u / CH64) & 1, b = u / (2 * CH64); const int r0 = b * SEGB + cj * 64;
        const bf16* g = G + (size_t)r0 * DM + blk * 512 + dir * 256 + e;
        float h = 0.f, ls = 0.f;
        for (int tb = 0; tb < 64; tb += 32) {
            unsigned short ql[32], qx[32];
#pragma unroll
            for (int i = 0; i < 32; ++i) { const int tt = dir ? 63 - (tb + i) : tb + i; ql[i] = g[(size_t)tt * DM]; qx[i] = g[(size_t)tt * DM + 128]; }
#pragma unroll
            for (int i = 0; i < 32; ++i) { const float l2 = bf2f(ql[i]); h = __builtin_amdgcn_exp2f(l2) * h + bf2f(qx[i]); ls += l2; }
        }
        float* o = SUM + ((size_t)((b * 2 + dir) * CH64 + cj) * 2) * 512 + ch; o[0] = __builtin_amdgcn_exp2f(ls); o[512] = h;
    }
}
__device__ __forceinline__ void phase_scan2(Frame& F, int l) {
    { int* s2t = (int*)(F.ws + WS_ROUTE) + RT_S2T; for (int i = F.vcu * NWAVES * 64 + F.tid; i < SLOT_CAP; i += F.G * NWAVES * 64) s2t[i] = 0; }
    const bf16* G = (const bf16*)(F.ws + WS_G); const float* SUM = (const float*)(F.ws + WS_SUM);
    const bf16* P = (const bf16*)(F.ws + WS_P); bf16* YB = (bf16*)(F.ws + WS_YB);
    LAS float* HF = (LAS float*)F.lds;
    const int ch = F.tid, blk = ch >> 7, e = ch & 127;
    const bool skipctx = (l == DEPTH - 1);
    const int nun = skipctx ? NBATCH * (CH64 - 4) : NBATCH * CH64;
    for (int u = F.vcu; u < nun; u += F.G) {
        const int b = skipctx ? u / (CH64 - 4) : u / CH64, cj = skipctx ? 4 + u % (CH64 - 4) : u % CH64; const int r0 = b * SEGB + cj * 64;
        float hf = 0.f, hb = 0.f;
        { const float* S0 = SUM + ((size_t)((b * 2 + 0) * CH64) * 2) * 512 + ch; const float* S1 = SUM + ((size_t)((b * 2 + 1) * CH64) * 2) * 512 + ch;
          const int nf = cj, nb = cj < 4 ? 3 - cj : 135 - cj; const int nmax = nf > nb ? nf : nb;
          for (int p0 = 0; p0 < nmax; p0 += 32) {
              float fa[32], fb[32], ba[32], bb[32];
#pragma unroll
              for (int i = 0; i < 32; ++i) { const int pp = p0 + i; const bool vf = pp < nf, vb = pp < nb; const int p = pp < CH64 ? pp : CH64 - 1; const int cb = p < 4 ? 3 - p : 135 - p;
                  fa[i] = vf ? S0[(size_t)p * 1024] : 1.f; fb[i] = vf ? S0[(size_t)p * 1024 + 512] : 0.f;
                  ba[i] = vb ? S1[(size_t)cb * 1024] : 1.f; bb[i] = vb ? S1[(size_t)cb * 1024 + 512] : 0.f; }
#pragma unroll
              for (int i = 0; i < 32; ++i) { hf = fa[i] * hf + fb[i]; hb = ba[i] * hb + bb[i]; }
          } }
        __syncthreads();
        const bf16* gf = G + (size_t)r0 * DM + blk * 512 + e; const bf16* gb = gf + 256;
        for (int tb = 0; tb < 64; tb += 32) {
            unsigned short fl[32], fx[32];
#pragma unroll
            for (int i = 0; i < 32; ++i) { fl[i] = gf[(size_t)(tb + i) * DM]; fx[i] = gf[(size_t)(tb + i) * DM + 128]; }
#pragma unroll
            for (int i = 0; i < 32; ++i) { hf = __builtin_amdgcn_exp2f(bf2f(fl[i])) * hf + bf2f(fx[i]); HF[(tb + i) * 512 + ch] = hf; }
        }
        for (int tb = 32; tb >= 0; tb -= 32) {
            unsigned short ql[32], qb[32], qa[32];
#pragma unroll
            for (int i = 0; i < 32; ++i) { ql[i] = gb[(size_t)(tb + i) * DM]; qb[i] = gb[(size_t)(tb + i) * DM + 128]; qa[i] = P[(size_t)(r0 + tb + i) * PIN + 512 + ch]; }
#pragma unroll
            for (int i = 31; i >= 0; --i) { hb = __builtin_amdgcn_exp2f(bf2f(ql[i])) * hb + bf2f(qb[i]);
                YB[(size_t)(r0 + tb + i) * DM + ch] = (bf16)f2bf(gelu_tanh(bf2f(qa[i])) * (HF[(tb + i) * 512 + ch] + hb)); }
        }
    }
    __syncthreads();
}

namespace att {
#ifndef ATT_BIG
#define ATT_BIG 16777216.0f
#endif
constexpr int SLOT = 65536, K1_OFF = 16384, V_OFF = 32768;
static_assert(2 * SLOT <= RING_BYTES, "attention LDS");
__device__ __forceinline__ bf16x8 pack8(const f32x16& p, int o) {
    v4u w; w.x = pg8::cvt_pk_bf16(p[o], p[o + 1]); w.y = pg8::cvt_pk_bf16(p[o + 2], p[o + 3]); w.z = pg8::cvt_pk_bf16(p[o + 4], p[o + 5]); w.w = pg8::cvt_pk_bf16(p[o + 6], p[o + 7]);
    return __builtin_bit_cast(bf16x8, w);
}
__device__ __forceinline__ void glds16(const void* sbase, unsigned voff, unsigned lds_dst) { unsigned keep;
    asm volatile("s_mov_b32 %0, m0\n\ts_mov_b32 m0, %3\n\ts_nop 0\n\tglobal_load_lds_dwordx4 %1, %2\n\ts_mov_b32 m0, %0" : "=&s"(keep) : "v"(voff), "s"(sbase), "s"(lds_dst) : "memory"); }
__device__ __forceinline__ float fadd_s(float a, float b) { float r; asm("v_add_f32_e32 %0, %1, %2" : "=v"(r) : "v"(a), "v"(b)); return r; }
__device__ __forceinline__ float max3f(float a, float b, float c) { float r; asm("v_max3_f32 %0, %1, %2, %3" : "=v"(r) : "v"(a), "v"(b), "v"(c)); return r; }
__device__ __forceinline__ float xhalf_max(float m) { auto rr = __builtin_amdgcn_permlane32_swap(__float_as_uint(m), __float_as_uint(m), false, false); return fmaxf(__uint_as_float(rr[0]), __uint_as_float(rr[1])); }
__device__ __forceinline__ float xhalf_sum(float m) { auto rr = __builtin_amdgcn_permlane32_swap(__float_as_uint(m), __float_as_uint(m), false, false); return __uint_as_float(rr[0]) + __uint_as_float(rr[1]); }
__device__ __forceinline__ float max16(const f32x16& p) {
    float a = max3f(p[0], p[1], p[2]), b = max3f(p[3], p[4], p[5]), c = max3f(p[6], p[7], p[8]), d = max3f(p[9], p[10], p[11]);
    a = max3f(a, p[12], p[13]); b = max3f(b, p[14], p[15]); c = fmaxf(c, d); return max3f(a, b, c);
}
}
template <int AB> __device__ __forceinline__ void phase_attn(Frame& F, int l) {
    using namespace att;
    const bf16* QP = (const bf16*)(F.ws + WS_QP); const bf16* KP = (const bf16*)(F.ws + WS_KP); const bf16* VT = (const bf16*)(F.ws + WS_VT); bf16* YB = (bf16*)(F.ws + WS_YB);
    const int lane = F.lane, r32 = lane & 31, hi = lane >> 5, wave = F.wave, c = wave >> 2, g = wave & 3;
    const float lam_init = 0.8f - 0.6f * __expf(-0.3f * (float)l);
    float lam;
    { const float* lp = F.in[I_DALAM] + (size_t)l * 256; const float s01 = wave_sum(lp[lane] * lp[64 + lane]), s23 = wave_sum(lp[128 + lane] * lp[192 + lane]); lam = __expf(s01) - __expf(s23) + lam_init; }
    const float* dan = F.in[I_DANORM] + (size_t)l * 128;
    LAS unsigned char* lds = F.lds; const unsigned lds0 = (unsigned)(size_t)lds;
    int foff[4];
#pragma unroll
    for (int s = 0; s < 4; ++s) foff[s] = r32 * 128 + (((2 * s + hi) ^ ((r32 >> 1) & 7)) << 4);
    constexpr int NLAT = NBATCH * 4 * (LSEQ / 128);
    constexpr int NU = NLAT + NBATCH * 4 * 2;
    const int conv_slot = F.vcu % 3; bool conv_done = false;
    const int gsz = F.G;
    const int cv_lo0 = l * CVT_L;
    for (int it = 0;; ++it) {
        if (it == conv_slot) { __syncthreads(); moe_convert_range(F, cv_lo0, cv_lo0 + CVT_L, F.vcu, F.G); __syncthreads(); conv_done = true; }
        int bh, qb, i0, nt;
        if (gsz == 256) {
            if (it < 2) { bh = F.vcu >> 5; qb = (F.vcu & 31) + 32 * it; i0 = NCTX + qb * 128; nt = SEGB / 128; }
            else if (it == 2 && F.vcu < 16 && l < DEPTH - 1) { bh = F.vcu >> 1; qb = F.vcu & 1; i0 = qb * 128; nt = NCTX / 128; }
            else break;
        } else {
            const int u = it * gsz + F.vcu; if (u >= NU) break;
            if (u < NLAT) { bh = u >> 6; qb = u & 63; i0 = NCTX + qb * 128; nt = SEGB / 128; } else { const int v = u - NLAT; bh = v >> 1; qb = v & 1; i0 = qb * 128; nt = NCTX / 128; }
        }
        const int b = bh >> 2, h = bh & 3;
        bf16x8 qf[4];
        { const bf16* qrow = QP + ((size_t)(bh * 2 + c) * SEGB + i0 + g * 32 + r32) * 64 + 8 * hi;
#pragma unroll
          for (int s = 0; s < 4; ++s) qf[s] = *(const GAS bf16x8*)(qrow + 16 * s); }
        unsigned voff[8];
#pragma unroll
        for (int q = 0; q < 8; ++q) { const int pp = (wave * 8 + q) & 15; const int row = 8 * pp + (lane >> 3), ch = (lane & 7) ^ ((row >> 1) & 7); voff[q] = (unsigned)(row * 128 + ch * 16); }
        const char* kbase0 = (const char*)(KP + (size_t)(bh * 2) * SEGB * 64); const char* vbase0 = (const char*)(VT + (size_t)bh * CH64 * 8192);
        const int reg = wave >> 1;
        const char* rbase = reg >= 2 ? vbase0 + (reg - 2) * 16384 : kbase0 + (size_t)reg * SEGB * 128;
        const unsigned dst0 = lds0 + reg * 16384 + ((wave * 8) & 15) * 1024;
        const int rstride = reg >= 2 ? 32768 : 16384;
#define ATT_DMA(jt) do { const char* sb_ = rbase + (size_t)(jt) * rstride; const unsigned d_ = dst0 + ((jt) & 1) * SLOT; _Pragma("unroll") for (int q_ = 0; q_ < 8; ++q_) \
            glds16(sb_, voff[q_], (unsigned)__builtin_amdgcn_readfirstlane((int)(d_ + q_ * 1024))); } while (0)
        f32x16 o0 = {}, o1 = {}, o2 = {}, o3 = {}, negm = {};
        float mref = 0.f, lsum = 0.f;
        VM_WAIT();
        asm volatile("" : "+v"(qf[0]), "+v"(qf[1]), "+v"(qf[2]), "+v"(qf[3]));
        ATT_DMA(0);
#define ATT_PVH(oa, ob, base_, pa, pb, pc, pd) do { bf16x8 vf_[8]; __builtin_amdgcn_sched_barrier(0); \
            _Pragma("unroll") for (int i_ = 0; i_ < 8; ++i_) vf_[i_] = *(const LAS bf16x8*)((base_) + (i_ >> 2) * 4096 + foff[i_ & 3]);         \
            __builtin_amdgcn_sched_barrier(0); \
            oa = __builtin_amdgcn_mfma_f32_32x32x16_bf16(vf_[0], pa, oa, 0, 0, 0); ob = __builtin_amdgcn_mfma_f32_32x32x16_bf16(vf_[4], pa, ob, 0, 0, 0); \
            oa = __builtin_amdgcn_mfma_f32_32x32x16_bf16(vf_[1], pb, oa, 0, 0, 0); ob = __builtin_amdgcn_mfma_f32_32x32x16_bf16(vf_[5], pb, ob, 0, 0, 0); \
            oa = __builtin_amdgcn_mfma_f32_32x32x16_bf16(vf_[2], pc, oa, 0, 0, 0); ob = __builtin_amdgcn_mfma_f32_32x32x16_bf16(vf_[6], pc, ob, 0, 0, 0); \
            oa = __builtin_amdgcn_mfma_f32_32x32x16_bf16(vf_[3], pd, oa, 0, 0, 0); ob = __builtin_amdgcn_mfma_f32_32x32x16_bf16(vf_[7], pd, ob, 0, 0, 0); \
            __builtin_amdgcn_sched_barrier(0); } while (0)
        for (int j = 0; j < nt; ++j) {
            asm volatile("s_waitcnt vmcnt(0)" ::: "memory");
            __builtin_amdgcn_s_barrier(); asm volatile("" ::: "memory");
            if (j + 1 < nt) ATT_DMA(j + 1);
            if ((AB & 64) && c == 1) continue;
            const LAS unsigned char* st = lds + (j & 1) * SLOT;
            const LAS unsigned char* kb = st + c * K1_OFF;
            f32x16 p0, p1, p2, p3;
#define ATT_QK(pa, kbase_) do { bf16x8 ka[4]; __builtin_amdgcn_sched_barrier(0); \
              _Pragma("unroll") for (int s_ = 0; s_ < 4; ++s_) ka[s_] = *(const LAS bf16x8*)((kbase_) + foff[s_]); \
              __builtin_amdgcn_sched_barrier(0); \
              pa = negm; \
              _Pragma("unroll") for (int s_ = 0; s_ < 4; ++s_) pa = __builtin_amdgcn_mfma_f32_32x32x16_bf16(ka[s_], qf[s_], pa, 0, 0, 0); \
              __builtin_amdgcn_sched_barrier(0); } while (0)
#define ATT_QK4() do { ATT_QK(p0, kb); ATT_QK(p1, kb + 4096); ATT_QK(p2, kb + 8192); ATT_QK(p3, kb + 12288); } while (0)
#define ATT_RAISE(first) do { asm volatile("s_nop 15\n\ts_nop 7" : "+v"(p0), "+v"(p1), "+v"(p2), "+v"(p3));     \
              const float mx_ = xhalf_max(fmaxf(fmaxf(max16(p0), max16(p1)), fmaxf(max16(p2), max16(p3)))); \
              const float dl_ = (first) ? mx_ : fmaxf(mx_, 0.f); mref += dl_; const float f_ = (first) ? 0.f : __builtin_amdgcn_exp2f(-dl_); lsum *= f_; \
              _Pragma("unroll") for (int r_ = 0; r_ < 16; ++r_) { p0[r_] -= dl_; p1[r_] -= dl_; p2[r_] -= dl_; p3[r_] -= dl_; o0[r_] *= f_; o1[r_] *= f_; o2[r_] *= f_; o3[r_] *= f_; negm[r_] = -mref; } } while (0)
#define ATT_EXPSUM() do {   \
              _Pragma("unroll") for (int r_ = 0; r_ < 16; ++r_) p0[r_] = __builtin_amdgcn_exp2f(p0[r_]); __builtin_amdgcn_sched_barrier(0); \
              _Pragma("unroll") for (int r_ = 0; r_ < 16; ++r_) p1[r_] = __builtin_amdgcn_exp2f(p1[r_]); __builtin_amdgcn_sched_barrier(0); \
              _Pragma("unroll") for (int r_ = 0; r_ < 16; ++r_) p2[r_] = __builtin_amdgcn_exp2f(p2[r_]); __builtin_amdgcn_sched_barrier(0); \
              _Pragma("unroll") for (int r_ = 0; r_ < 16; ++r_) p3[r_] = __builtin_amdgcn_exp2f(p3[r_]); \
              __builtin_amdgcn_sched_barrier(0); asm volatile("s_nop 0"); __builtin_amdgcn_sched_barrier(0);       \
              float sa_ = p0[0], sb_ = p1[0], sc_ = p2[0], sd_ = p3[0];         \
              _Pragma("unroll") for (int r_ = 1; r_ < 16; ++r_) { sa_ = fadd_s(sa_, p0[r_]); sb_ = fadd_s(sb_, p1[r_]); sc_ = fadd_s(sc_, p2[r_]); sd_ = fadd_s(sd_, p3[r_]); } \
              ts = fadd_s(fadd_s(sa_, sb_), fadd_s(sc_, sd_)); } while (0)
            ATT_QK4();
            float ts;
            if (j == 0) ATT_RAISE(true);
            ATT_EXPSUM();
            if (__any(!(ts < ATT_BIG))) { ATT_QK4(); ATT_RAISE(false); ATT_EXPSUM(); }
            lsum += ts;
#undef ATT_QK4
#undef ATT_RAISE
#undef ATT_EXPSUM
#undef ATT_QK
            const bf16x8 pa0 = pack8(p0, 0), pa1 = pack8(p0, 8), pa2 = pack8(p1, 0), pa3 = pack8(p1, 8), pb0 = pack8(p2, 0), pb1 = pack8(p2, 8), pb2 = pack8(p3, 0), pb3 = pack8(p3, 8);
            const LAS unsigned char* vb = st + V_OFF;
            ATT_PVH(o0, o1, vb, pa0, pa1, pa2, pa3); ATT_PVH(o2, o3, vb + 8192, pa0, pa1, pa2, pa3);
            ATT_PVH(o0, o1, vb + 16384, pb0, pb1, pb2, pb3); ATT_PVH(o2, o3, vb + 16384 + 8192, pb0, pb1, pb2, pb3);
        }
#undef ATT_PVH
#undef ATT_DMA
        LDS_WAIT(); __builtin_amdgcn_s_barrier(); asm volatile("" ::: "memory");
        lsum = xhalf_sum(lsum);
        const float inv = 1.0f / lsum;
        LAS float* xch = (LAS float*)lds + g * 4096 + lane;
        if (c == 1) {
            const float f = inv * lam;
#pragma unroll
            for (int r = 0; r < 16; ++r) { xch[(0 * 16 + r) * 64] = o0[r] * f; xch[(1 * 16 + r) * 64] = o1[r] * f; xch[(2 * 16 + r) * 64] = o2[r] * f; xch[(3 * 16 + r) * 64] = o3[r] * f; }
        }
        __syncthreads();
        if (c == 0) {
            float ss = 0.f;
#pragma unroll
            for (int r = 0; r < 16; ++r) { o0[r] = o0[r] * inv - xch[(0 * 16 + r) * 64]; o1[r] = o1[r] * inv - xch[(1 * 16 + r) * 64]; o2[r] = o2[r] * inv - xch[(2 * 16 + r) * 64]; o3[r] = o3[r] * inv - xch[(3 * 16 + r) * 64];
                ss += (o0[r] * o0[r] + o1[r] * o1[r]) + (o2[r] * o2[r] + o3[r] * o3[r]); }
            ss = xhalf_sum(ss);
            const float rs = (1.0f / sqrtf(ss * (1.0f / 128.0f) + EPS)) * (1.0f - lam_init);
            bf16* orow = YB + (size_t)(b * SEGB + i0 + g * 32 + r32) * DM + 1536 + h * 128 + 4 * hi;
            v2u ow[16];
#define ATT_ST(oacc, db) do { _Pragma("unroll") for (int rq = 0; rq < 4; ++rq) { const int d0 = (db) * 32 + 8 * rq + 4 * hi; const f32x4 nv = *(const GAS f32x4*)(dan + d0); \
                ow[(db) * 4 + rq].x = pk2(oacc[4 * rq] * rs * nv.x, oacc[4 * rq + 1] * rs * nv.y); ow[(db) * 4 + rq].y = pk2(oacc[4 * rq + 2] * rs * nv.z, oacc[4 * rq + 3] * rs * nv.w); } } while (0)
            ATT_ST(o0, 0); ATT_ST(o1, 1); ATT_ST(o2, 2); ATT_ST(o3, 3);
#undef ATT_ST
#pragma unroll
            for (int k = 0; k < 16; ++k) *(GAS v2u*)(orow + (k >> 2) * 32 + 8 * (k & 3)) = ow[k];
        }
        __syncthreads();
    }
    if (conv_slot >= 0 && !conv_done) { __syncthreads(); moe_convert_range(F, cv_lo0, cv_lo0 + CVT_L, F.vcu, F.G); __syncthreads(); }
}
constexpr size_t WQ_ELEMS = (size_t)DEPTH * 3 * 48 * DM;
__device__ __forceinline__ void router_tables(Frame& F) {
    bf16* WQH = (bf16*)(F.ws + WS_MODP); bf16* WQL = WQH + WQ_ELEMS; float* CC = (float*)(WQL + WQ_ELEMS);
    const float* MOD = (const float*)(F.ws + WS_MOD); const float* WRT = (const float*)(F.ws + WS_WRT);
    const int gt = F.vcu * NWAVES * 64 + F.tid, NGT = F.G * NWAVES * 64;
    for (int idx0 = gt; idx0 < (int)WQ_ELEMS; idx0 += 5 * NGT) {
        float wv[5];
#pragma unroll
        for (int q = 0; q < 5; ++q) { const int idx = idx0 + q * NGT; wv[q] = 0.f;
            if (idx < (int)WQ_ELEMS) { const int k = idx % DM, n = (idx / DM) % 48, mr = (idx / (DM * 48)) % 3, l = idx / (DM * 48 * 3);
                if (n < NROUTE) { const float a = F.in[I_NFFN][l * DM + k] * (1.0f + MOD[((size_t)l * 3 + mr) * NMODC + 4 * DM + k]); wv[q] = a * WRT[((size_t)l * NROUTE + n) * DM + k]; } } }
#pragma unroll
        for (int q = 0; q < 5; ++q) { const int idx = idx0 + q * NGT;
            if (idx < (int)WQ_ELEMS) { const float w = wv[q]; const unsigned h = f2bf(w); const float rem = w - bf2f(h); WQH[idx] = (bf16)h; WQL[idx] = (bf16)f2bf(rem); } }
    }
    const int gw = F.vcu * NWAVES + F.wave, NGW = F.G * NWAVES;
    for (int it = gw; it < DEPTH * 3 * NROUTE; it += NGW) {
        const int n = it % NROUTE, mr = (it / NROUTE) % 3, l = it / (NROUTE * 3); float sacc = 0.f;
        { float ma[32], wa[32];
#pragma unroll
          for (int q = 0; q < 32; ++q) { const int k = F.lane + 64 * q; ma[q] = MOD[((size_t)l * 3 + mr) * NMODC + 3 * DM + k]; wa[q] = WRT[((size_t)l * NROUTE + n) * DM + k]; }
#pragma unroll
          for (int q = 0; q < 32; ++q) sacc += ma[q] * wa[q]; }
        sacc = wave_sum(sacc);
        if (F.lane == 0) CC[it] = sacc + (n < 4 ? F.in[I_GRPB][l * 4 + n] : F.in[I_EXPB][l * 32 + n - 4]);
    }
}
__device__ __forceinline__ void phase_norm2_router(Frame& F, int l, int part, int dummy = 0) {
    typedef float f32x4_ __attribute__((ext_vector_type(4)));
    const bf16* X = (const bf16*)(F.ws + WS_X); const float* MOD = (const float*)(F.ws + WS_MOD);
    const bf16* WQH = (const bf16*)(F.ws + WS_MODP); const bf16* WQL = WQH + WQ_ELEMS; const float* CC = (const float*)(WQL + WQ_ELEMS);
    int* RT = (int*)(F.ws + WS_ROUTE) + (dummy ? RT_WSLOT + SLOT_CAP : 0); unsigned* cnt = (unsigned*)(F.ws + WS_CTL) + CW_CNT + l * 64 + (dummy ? 4096 : 0);
    LAS float* PART = (LAS float*)F.lds;
    LAS float* SSQ = PART + 8 * 12 * 64;
    LAS float* LGT = SSQ + 8 * 16;
    LAS float* RSTD = LGT + 16 * 40;
    LAS int* SLT = (LAS int*)(RSTD + 16);
    bf16* HS = (bf16*)(F.ws + WS_HS); unsigned* moe = (unsigned*)(F.ws + WS_CTL) + CW_MOE + l * CW_MOE_L + (dummy ? 2048 : 0);
    const float* gn = F.in[I_NFFN] + (size_t)l * DM;
    const int lane = F.lane, wave = F.wave, m16 = lane & 15, kg = lane >> 4;
    const int ntile = part == 0 ? T / 16 : part == 2 ? NBATCH * NCTX / 16 : NBATCH * LSEQ / 16;
    const int cu = (part == 1 || part == 2) ? F.vcu - 16 : F.vcu, ncu = part == 1 ? F.G - 16 : part == 2 ? 32 : F.G;
    int t0 = (int)(((long)ntile * cu) / ncu), t1 = (int)(((long)ntile * (cu + 1)) / ncu);
    if (part == 1 && ncu > 32 && ntile > 128) {
        if (cu < 32) { t0 = 4 * cu; t1 = t0 + 4; } else { const int rest = ntile - 128, nc = ncu - 32; t0 = 128 + (int)(((long)rest * (cu - 32)) / nc); t1 = 128 + (int)(((long)rest * (cu - 31)) / nc); } }
#define RT_SYNC() do { LDS_WAIT(); __builtin_amdgcn_s_barrier(); asm volatile("" ::: "memory"); } while (0)
#define RT_ROW0(tl_) (part == 0 ? (tl_) * 16 : part == 2 ? ((tl_) / (NCTX / 16)) * SEGB + ((tl_) % (NCTX / 16)) * 16 : ((tl_) / (LSEQ / 16)) * SEGB + NCTX + ((tl_) % (LSEQ / 16)) * 16)
#define RT_LOAD(xx, hh, ll, kb, xr_, wh_, wl_) do { _Pragma("unroll") for (int s_ = 0; s_ < 2; ++s_) { xx[s_] = *(const GAS bf16x8*)((xr_) + 32 * ((kb) * 2 + s_)); \
            _Pragma("unroll") for (int nt_ = 0; nt_ < 3; ++nt_) { hh[3 * s_ + nt_] = *(const GAS bf16x8*)((wh_) + (size_t)nt_ * 16 * DM + 32 * ((kb) * 2 + s_)); ll[3 * s_ + nt_] = *(const GAS bf16x8*)((wl_) + (size_t)nt_ * 16 * DM + 32 * ((kb) * 2 + s_)); } } } while (0)
#define RT_MMA(xx, hh, ll) do { _Pragma("unroll") for (int s_ = 0; s_ < 2; ++s_) { const bf16x8 xh_ = xx[s_]; const v4u xw_ = __builtin_bit_cast(v4u, xh_); \
            ssq += (bflo(xw_.x) * bflo(xw_.x) + bfhi(xw_.x) * bfhi(xw_.x)) + (bflo(xw_.y) * bflo(xw_.y) + bfhi(xw_.y) * bfhi(xw_.y)) + (bflo(xw_.z) * bflo(xw_.z) + bfhi(xw_.z) * bfhi(xw_.z)) + (bflo(xw_.w) * bflo(xw_.w) + bfhi(xw_.w) * bfhi(xw_.w)); \
            acc0 = __builtin_amdgcn_mfma_f32_16x16x32_bf16(xh_, hh[3 * s_], acc0, 0, 0, 0); acc1 = __builtin_amdgcn_mfma_f32_16x16x32_bf16(xh_, hh[3 * s_ + 1], acc1, 0, 0, 0); acc2 = __builtin_amdgcn_mfma_f32_16x16x32_bf16(xh_, hh[3 * s_ + 2], acc2, 0, 0, 0); \
            acc0 = __builtin_amdgcn_mfma_f32_16x16x32_bf16(xh_, ll[3 * s_], acc0, 0, 0, 0); acc1 = __builtin_amdgcn_mfma_f32_16x16x32_bf16(xh_, ll[3 * s_ + 1], acc1, 0, 0, 0); acc2 = __builtin_amdgcn_mfma_f32_16x16x32_bf16(xh_, ll[3 * s_ + 2], acc2, 0, 0, 0); } } while (0)
    bf16x8 xa[2], xb[2]; bf16x8 ha[6], la[6], hb[6], lb[6];
    const bf16* xr = X, *wh = WQH, *wl = WQL;
    if (t0 < t1) { const int r0_ = RT_ROW0(t0), mr_ = mod_row(r0_);
        xr = X + (size_t)(r0_ + m16) * DM + 256 * wave + 8 * kg; wh = WQH + ((size_t)(l * 3 + mr_) * 48 + m16) * DM + 256 * wave + 8 * kg; wl = WQL + ((size_t)(l * 3 + mr_) * 48 + m16) * DM + 256 * wave + 8 * kg;
        RT_LOAD(xa, ha, la, 0, xr, wh, wl); RT_LOAD(xb, hb, lb, 1, xr, wh, wl); }
    for (int tl = t0; tl < t1; ++tl) {
        const int r0 = RT_ROW0(tl);
        const int mrow = mod_row(r0);
        f32x4_ acc0 = {0.f, 0.f, 0.f, 0.f}, acc1 = acc0, acc2 = acc0; float ssq = 0.f;
        __builtin_amdgcn_sched_barrier(0);
        RT_MMA(xa, ha, la); __builtin_amdgcn_sched_barrier(0); RT_LOAD(xa, ha, la, 2, xr, wh, wl); __builtin_amdgcn_sched_barrier(0);
        RT_MMA(xb, hb, lb); __builtin_amdgcn_sched_barrier(0); RT_LOAD(xb, hb, lb, 3, xr, wh, wl); __builtin_amdgcn_sched_barrier(0);
        RT_MMA(xa, ha, la); __builtin_amdgcn_sched_barrier(0);
        RT_MMA(xb, hb, lb); __builtin_amdgcn_sched_barrier(0);
        if (tl + 1 < t1) { const int r0_ = RT_ROW0(tl + 1), mr_ = mod_row(r0_);
            xr = X + (size_t)(r0_ + m16) * DM + 256 * wave + 8 * kg; wh = WQH + ((size_t)(l * 3 + mr_) * 48 + m16) * DM + 256 * wave + 8 * kg; wl = WQL + ((size_t)(l * 3 + mr_) * 48 + m16) * DM + 256 * wave + 8 * kg;
            RT_LOAD(xa, ha, la, 0, xr, wh, wl); RT_LOAD(xb, hb, lb, 1, xr, wh, wl); }
        __builtin_amdgcn_sched_barrier(0);
        { const int ln_ = fresh_lane(); ssq += __builtin_bit_cast(float, __builtin_amdgcn_ds_bpermute((ln_ ^ 16) << 2, __builtin_bit_cast(int, ssq))); ssq += __builtin_bit_cast(float, __builtin_amdgcn_ds_bpermute((ln_ ^ 32) << 2, __builtin_bit_cast(int, ssq))); }
        RT_SYNC();
#pragma unroll
        for (int r = 0; r < 4; ++r) { PART[(wave * 12 + 0 + r) * 64 + lane] = acc0[r]; PART[(wave * 12 + 4 + r) * 64 + lane] = acc1[r]; PART[(wave * 12 + 8 + r) * 64 + lane] = acc2[r]; }
        if (kg == 0) SSQ[wave * 16 + m16] = ssq;
        RT_SYNC();
        if (F.tid < 16) { float s = 0.f;
#pragma unroll
            for (int w = 0; w < 8; ++w) s += SSQ[w * 16 + F.tid];
            RSTD[F.tid] = 1.0f / sqrtf(s * (1.0f / DM) + EPS); }
        RT_SYNC();
        for (int e = F.tid; e < 16 * NROUTE; e += NWAVES * 64) { const int row = e / NROUTE, n = e % NROUTE; const int nt = n >> 4, col = n & 15, ln = col + 16 * (row >> 2), rg = row & 3; float s = 0.f;
#pragma unroll
            for (int w = 0; w < 8; ++w) s += PART[(w * 12 + nt * 4 + rg) * 64 + ln];
            LGT[row * 40 + n] = s * RSTD[row] + CC[(l * 3 + mrow) * NROUTE + n]; }
        RT_SYNC();
        if (F.tid < 16) { const int r = r0 + F.tid; const LAS float* lgp = LGT + F.tid * 40;
            float lg[4];
#pragma unroll
            for (int n = 0; n < 4; ++n) lg[n] = lgp[n];
            int gi = 0; float gm = lg[0];
#pragma unroll
            for (int n = 1; n < 4; ++n) if (lg[n] > gm) { gm = lg[n]; gi = n; }
            float den = 0.f;
#pragma unroll
            for (int n = 0; n < 4; ++n) den += __expf(lg[n] - gm);
            const float gw = 1.0f / den;
            float el[8];
#pragma unroll
            for (int j = 0; j < 8; ++j) el[j] = lgp[4 + gi * 8 + j];
            int i1 = 0; float v1 = el[0];
#pragma unroll
            for (int j = 1; j < 8; ++j) if (el[j] > v1) { v1 = el[j]; i1 = j; }
            int i2 = -1; float v2 = -3.0e38f;
#pragma unroll
            for (int j = 0; j < 8; ++j) if (j != i1 && el[j] > v2) { v2 = el[j]; i2 = j; }
            if (i2 < 0) i2 = (i1 + 1) & 7;
            const float ex = __expf(v2 - v1), w1 = gw / (1.0f + ex), w2 = gw * ex / (1.0f + ex);
            const int e1 = gi * 8 + i1, e2 = gi * 8 + i2;
            const unsigned p1 = __hip_atomic_fetch_add(cnt + e1, 1u, RLX_AGENT), p2 = __hip_atomic_fetch_add(cnt + e2, 1u, RLX_AGENT);
            if ((p1 & 255u) == 0u) { const unsigned t = __hip_atomic_fetch_add(moe + MOE_NT, 1u, RLX_AGENT); __hip_atomic_store(moe + MOE_TILE_E + t, (unsigned)e1, RLX_AGENT); __hip_atomic_store(moe + MOE_TMAP + e1 * TMAP_STRIDE + (p1 >> 8), t + 1u, RLX_AGENT); }
            if ((p2 & 255u) == 0u) { const unsigned t = __hip_atomic_fetch_add(moe + MOE_NT, 1u, RLX_AGENT); __hip_atomic_store(moe + MOE_TILE_E + t, (unsigned)e2, RLX_AGENT); __hip_atomic_store(moe + MOE_TMAP + e2 * TMAP_STRIDE + (p2 >> 8), t + 1u, RLX_AGENT); }
            unsigned t1 = 0u, t2 = 0u;
            for (unsigned sp = 0; sp < (1u << 22); ++sp) { if (!t1) t1 = __hip_atomic_load(moe + MOE_TMAP + e1 * TMAP_STRIDE + (p1 >> 8), RLX_AGENT); if (!t2) t2 = __hip_atomic_load(moe + MOE_TMAP + e2 * TMAP_STRIDE + (p2 >> 8), RLX_AGENT); if (t1 && t2) break; __builtin_amdgcn_s_sleep(1); }
            if (!t1) t1 = 1u; if (!t2) t2 = 1u;
            const int s1 = (int)((t1 - 1u) * 256u + (p1 & 255u)), s2 = (int)((t2 - 1u) * 256u + (p2 & 255u));
            RT[RT_SLOT + 2 * r] = s1; RT[RT_SLOT + 2 * r + 1] = s2; ((float*)RT)[RT_WSLOT + s1] = w1; ((float*)RT)[RT_WSLOT + s2] = w2; RT[RT_S2T + s1] = r; RT[RT_S2T + s2] = r;
            SLT[2 * F.tid] = s1; SLT[2 * F.tid + 1] = s2; }
        RT_SYNC();
        { const float* sh = MOD + ((size_t)l * 3 + mrow) * NMODC + 3 * DM, *sc = sh + DM;
          const int c = (F.tid & 255) * 8, rw0 = F.tid >> 8;
          v4u xw[8];
#pragma unroll
          for (int q = 0; q < 8; ++q) xw[q] = *(const GAS v4u*)(X + (size_t)(r0 + rw0 + 2 * q) * DM + c);
          const f32x4 a0 = *(const GAS f32x4*)(gn + c) * (*(const GAS f32x4*)(sc + c) + 1.0f), a1 = *(const GAS f32x4*)(gn + c + 4) * (*(const GAS f32x4*)(sc + c + 4) + 1.0f);
          const f32x4 b0 = *(const GAS f32x4*)(sh + c), b1 = *(const GAS f32x4*)(sh + c + 4);
#pragma unroll
          for (int q = 0; q < 8; ++q) { const int row = rw0 + 2 * q; const float rs = RSTD[row]; f32x4 x0, x1;
              x0.x = bflo(xw[q].x); x0.y = bfhi(xw[q].x); x0.z = bflo(xw[q].y); x0.w = bfhi(xw[q].y); x1.x = bflo(xw[q].z); x1.y = bfhi(xw[q].z); x1.z = bflo(xw[q].w); x1.w = bfhi(xw[q].w);
              const f32x4 h0 = x0 * rs * a0 + b0, h1 = x1 * rs * a1 + b1;
              v4u w; w.x = pk2(h0.x, h0.y); w.y = pk2(h0.z, h0.w); w.z = pk2(h1.x, h1.y); w.w = pk2(h1.z, h1.w);
              *(GAS v4u*)(HS + (size_t)(r0 + row) * DM + c) = w; } }
    }
    __syncthreads();
#undef RT_SYNC
#undef RT_LOAD
#undef RT_MMA
#undef RT_ROW0
}
__device__ __forceinline__ void moe_fill_rows(Frame& F, const LAS int* perm, int first, int stride, int lim) {
    const int* s2t = (const int*)(F.ws + WS_ROUTE) + RT_S2T; LAS int* gt = (LAS int*)(F.lds + GT_OFF);
    const int nu = perm[0] * 4;
    for (int e = F.tid; e < 4 * 256; e += NWAVES * 64) { const int ui = e >> 8, r = e & 255; const int L = first + ui * stride;
        if (L < nu && L < lim) { const int pm = perm[1 + (L >> 2)] & 0xffff; gt[e] = s2t[pm * 256 + r]; } }
    __syncthreads();
}
constexpr int PERM_OFF = MISC_OFF + 1024;
static_assert(PERM_OFF + 4 * (176 + 176) <= LDS_BYTES, "perm");
__device__ __forceinline__ void moe_sort_tiles(Frame& F, int l) {
    const unsigned* moe = (const unsigned*)(F.ws + WS_CTL) + CW_MOE + l * CW_MOE_L;
    LAS int* perm = (LAS int*)(F.lds + PERM_OFF); LAS int* etab = perm + 176;
    int nt = (int)moe[MOE_NT]; if (nt > SLOT_CAP / 256) nt = SLOT_CAP / 256;
    if (F.tid < 176) etab[F.tid] = F.tid < nt ? (int)(moe[MOE_TILE_E + F.tid] & 31) : 255;
    __syncthreads();
    if (F.tid < nt) { const int e = etab[F.tid]; int pos = 0;
#pragma unroll
        for (int t0 = 0; t0 < 176; t0 += 16) { int ev[16];
#pragma unroll
            for (int q = 0; q < 16; ++q) ev[q] = etab[t0 + q];
#pragma unroll
            for (int q = 0; q < 16; ++q) pos += (ev[q] < e || (ev[q] == e && t0 + q < F.tid)) ? 1 : 0; }
        perm[1 + pos] = F.tid | (e << 16); }
    if (F.tid == 0) perm[0] = nt;
    __syncthreads();
}

constexpr int PH_PER_LAYER = 11, N_PHASES = 2 + DEPTH * PH_PER_LAYER + 1;
struct Args { const float* in[28]; float* out; unsigned char* ws; int ph_lo, ph_hi; };
static_assert(sizeof(Args) == 28 * 8 + 8 + 8 + 8, "Args has no padding");

__global__ void __launch_bounds__(NWAVES * 64, 2) hymba_fwd(Args args) {
    extern __shared__ __attribute__((aligned(16))) unsigned char lds_raw[];
    Frame F;
    F.lds = (LAS unsigned char*)lds_raw; F.ws = args.ws; F.in = args.in;
    F.tid = threadIdx.x; F.lane = F.tid & 63; F.wave = __builtin_amdgcn_readfirstlane(F.tid >> 6);
    F.G = gridDim.x; { const int bx = blockIdx.x; F.vcu = (F.G % 8 == 0) ? (bx % 8) * (F.G / 8) + bx / 8 : bx; }
    volatile LAS unsigned* MISC = (volatile LAS unsigned*)(F.lds + MISC_OFF);
    if (F.tid < 32) MISC[F.tid] = 0u;
    const int wave0 = F.wave, vcu0 = F.vcu, g0 = F.G;
    __syncthreads();
    unsigned* ctl = (unsigned*)(F.ws + WS_CTL);
#if MK_SPLIT
#define GRID_BAR() do { } while (0)
#else
    XcdBarrier bar = xcd_barrier_post(ctl + CW_BAR, MISC + 8);
#define GRID_BAR() xcd_barrier(bar)
#endif
    const int lo = args.ph_lo, hi = args.ph_hi;
#ifndef PH_MASK
#define PH_MASK 0x3fff
#endif
#define PHON(x) (((PH_MASK) >> (x)) & 1)
#ifndef REP_MASK
#define REP_MASK 0
#endif
#define NREP(x) ((((REP_MASK) >> (x)) & 1) ? 2 : 1)
#define REFRESH() do { const int ln_ = fresh_lane(); F.tid = (wave0 << 6) | ln_; F.lane = ln_; F.wave = wave0; int v_ = vcu0, g_ = g0; asm volatile("" : "+s"(v_), "+s"(g_)); F.vcu = v_; F.G = g_; } while (0)
#define IN(k) (lo <= (k) && (k) < hi)
#define SEAM(k) do { if (IN(k) && IN((k) + 1)) GRID_BAR(); } while (0)
    LAS unsigned char* ring = F.lds;
    const bool CTX_IN_E = (F.G == 256);

    if (PHON(0) && IN(0)) { for (int rep = 0; rep < NREP(0); ++rep) { REFRESH(); p0_prologue(F); __syncthreads(); } } SEAM(0);
    if (PHON(1) && IN(1)) { REFRESH(); p0b_modreduce(F); } SEAM(1);

    for (int l = 0; l < DEPTH; ++l) {
        const int pb = 2 + l * PH_PER_LAYER;
        if (PHON(2) && IN(pb + 0)) { for (int rep = 0; rep < (l == 0 ? NREP(2) : 1); ++rep) { REFRESH(); if (l == 0) { router_tables(F); phase_norm1<0>(F, l, nullptr); } else phase_norm1<1>(F, l, nullptr); } } SEAM(pb + 0);
        if (PHON(3) && IN(pb + 1)) { REFRESH();
            pg8::Gemm g{(const bf16*)(F.ws + WS_H), (const bf16*)(F.ws + WS_WIN) + (size_t)l * PIN * DM, T, PIN, DM}; pg8::StaticOrder S; S.init(T, PIN, F.G, (int)blockIdx.x);
            EpiStoreBf16 E{(bf16*)(F.ws + WS_P), PIN};
            for (int rep = 0; rep < NREP(3); ++rep) pg8::gemm_phase<EpiStoreBf16, pg8::StaticOrder, true, true>(ring, g, S, E, F.tid);
        } SEAM(pb + 1);
        if (PHON(4) && IN(pb + 2)) { for (int rep = 0; rep < NREP(4); ++rep) { REFRESH(); phase_prep(F, l); } } SEAM(pb + 2);
        if (PHON(5) && IN(pb + 3)) { REFRESH();
            int kaux = 128; asm volatile("" : "+s"(kaux));
            pg8::Gemm g{(const bf16*)(F.ws + WS_AUXA), (const bf16*)(F.ws + WS_AUXB) + (size_t)l * 12 * 256 * 128, 8 * T, 12 * 256, kaux}; AuxSched S{F.G, F.vcu};
            EpiAux E{(bf16*)(F.ws + WS_G), (bf16*)(F.ws + WS_YB), (const bf16*)(F.ws + WS_AUXA), F.in[I_RGGB] + (size_t)l * 2 * 2 * 4 * 128, (const float*)(F.ws + WS_WRT) + DEPTH * NROUTE * DM + (size_t)l * 1024, F.in[I_POOLB] + (size_t)l * 512, F.in[I_POOLS] + (size_t)l * 512};
            for (int rep = 0; rep < NREP(5); ++rep) pg8::gemm_phase<EpiAux, AuxSched, true, true>(ring, g, S, E, F.tid);
        } SEAM(pb + 3);
        if (PHON(6) && IN(pb + 4)) { for (int rep = 0; rep < NREP(6); ++rep) { REFRESH(); phase_scan1(F, l); __syncthreads(); phase_attn<0>(F, l); } } SEAM(pb + 4);
        if (PHON(7) && IN(pb + 5)) { for (int rep = 0; rep < NREP(7); ++rep) { REFRESH(); phase_scan2(F, l); } } SEAM(pb + 5);
        if (PHON(8) && IN(pb + 6)) { REFRESH();
            pg8::Gemm g{(const bf16*)(F.ws + WS_YB), (const bf16*)(F.ws + WS_WOUT) + (size_t)l * DM * DM, T, DM, DM};
            RowOrder S; S.latent_only = (l == DEPTH - 1) || CTX_IN_E; S.S.init(S.latent_only ? NBATCH * LSEQ : T, DM, F.G, (int)blockIdx.x);
            EpiResid E{(bf16*)(F.ws + WS_X), (const float*)(F.ws + WS_MOD) + (size_t)l * 3 * NMODC, l == 0 ? F.in[I_X] : nullptr, F.in[I_CTX]};
            pg8::gemm_phase<EpiResid, RowOrder, true, true>(ring, g, S, E, F.tid);
        } SEAM(pb + 6);
        if (PHON(9) && IN(pb + 7)) {
            if (l == DEPTH - 1) { for (int rep = NREP(9) - 1; rep >= 0; --rep) { REFRESH(); phase_norm2_router(F, l, 3, rep); } }
            else if (!CTX_IN_E) { for (int rep = NREP(9) - 1; rep >= 0; --rep) { REFRESH(); phase_norm2_router(F, l, 0, rep); } }
            else if (F.vcu >= 16) { REFRESH(); phase_norm2_router(F, l, 1);
                if (F.vcu < 48) {
                    if (F.tid == 0) { unsigned* cw = ctl + CW_CTXD + l;
                        for (unsigned sp = 0; sp < (1u << 26) && __hip_atomic_load(cw, __ATOMIC_ACQUIRE, __HIP_MEMORY_SCOPE_AGENT) < 16u; ++sp) __builtin_amdgcn_s_sleep(2); }
                    __syncthreads();
                    REFRESH(); phase_norm2_router(F, l, 2); } }
            else { REFRESH();
                pg8::Gemm g{(const bf16*)(F.ws + WS_YB), (const bf16*)(F.ws + WS_WOUT) + (size_t)l * DM * DM, T, DM, DM};
                OneUnit S{(F.vcu >> 3) * TPB, F.vcu & 7};
                EpiResid E{(bf16*)(F.ws + WS_X), (const float*)(F.ws + WS_MOD) + (size_t)l * 3 * NMODC, l == 0 ? F.in[I_X] : nullptr, F.in[I_CTX]};
                pg8::gemm_phase<EpiResid, OneUnit, true, true>(ring, g, S, E, F.tid);
                __syncthreads();
                if (F.tid == 0) __hip_atomic_fetch_add(ctl + CW_CTXD + l, 1u, __ATOMIC_RELEASE, __HIP_MEMORY_SCOPE_AGENT);
            }
        } SEAM(pb + 7);
        if (PHON(11) && IN(pb + 9)) { REFRESH();
            moe_sort_tiles(F, l);
            const LAS int* perm = (const LAS int*)(F.lds + PERM_OFF); const int nF = perm[0] * 4, rf = nF / F.G, R = nF - rf * F.G;
            pg8::Gemm g{(const bf16*)(F.ws + WS_HS), (const bf16*)(F.ws + WS_UP) + (size_t)l * NEXP * 1024 * DM, SLOT_CAP, NEXP * 1024, DM}; MoeSched S{perm, 4, F.G, F.vcu, (R > 0 && rf > 0) ? rf * F.G : 0x7fffffff, (const LAS int*)(F.lds + GT_OFF)};
            moe_fill_rows(F, perm, F.vcu, F.G, S.lim);
            EpiSwiGLU E{(bf16*)(F.ws + WS_HM), (const float*)(F.ws + WS_ROUTE) + RT_WSLOT};
            for (int rep = 0; rep < NREP(11); ++rep) pg8::gemm_phase<EpiSwiGLU, MoeSched, true, true, true>(ring, g, S, E, F.tid);
        } SEAM(pb + 9);
        if (PHON(12) && IN(pb + 10)) { REFRESH();
            moe_sort_tiles(F, l);
            const LAS int* perm = (const LAS int*)(F.lds + PERM_OFF); const int nF = perm[0] * 4, rf = nF / F.G; int R = nF - rf * F.G; if (rf == 0) R = 0;
            unsigned* fov = ctl + CW_FOV + l * 256;
            if (F.vcu < R) {
                pg8::Gemm g{(const bf16*)(F.ws + WS_HS), (const bf16*)(F.ws + WS_UP) + (size_t)l * NEXP * 1024 * DM, SLOT_CAP, NEXP * 1024, DM}; MoeOneUp S{perm, rf * F.G + F.vcu, (const LAS int*)(F.lds + GT_OFF)};
                moe_fill_rows(F, perm, rf * F.G + F.vcu, 0x10000000, 0x7fffffff);
                EpiSwiGLU E{(bf16*)(F.ws + WS_HM), (const float*)(F.ws + WS_ROUTE) + RT_WSLOT};
                pg8::gemm_phase<EpiSwiGLU, MoeOneUp, true, true, true>(ring, g, S, E, F.tid);
                __syncthreads();
                if (F.tid == 0) __hip_atomic_fetch_add(fov + ((rf * F.G + F.vcu) >> 2), 1u, __ATOMIC_RELEASE, __HIP_MEMORY_SCOPE_AGENT);
                REFRESH();
            }
            pg8::Gemm g{(const bf16*)(F.ws + WS_HM), (const bf16*)(F.ws + WS_DOWN) + (size_t)l * NEXP * DM * DEXP, SLOT_CAP, NEXP * DM, DEXP}; MoeDownSched S{perm, F.G, F.vcu, R, (rf * F.G) >> 2, fov};
            EpiDown E{(bf16*)(F.ws + WS_YS)};
            for (int rep = 0; rep < NREP(12); ++rep) pg8::gemm_phase<EpiDown, MoeDownSched, true, true>(ring, g, S, E, F.tid);
        } SEAM(pb + 10);
    }
    if (PHON(13) && IN(N_PHASES - 1)) { for (int rep = 0; rep < NREP(13); ++rep) { REFRESH(); phase_norm1<2>(F, DEPTH, args.out); } }
#undef IN
#undef SEAM
}

extern "C" void kernel_launch(void* const* d_in, const int* in_sizes, int n_in, void* d_out, int out_size, void* d_ws, size_t ws_size, hipStream_t stream) {
    static int grid = 0;
    if (grid == 0) {
        if (n_in != 28 || in_sizes[0] != NBATCH * LSEQ * DM || out_size != NBATCH * LSEQ * DM || ws_size < WS_END) {
            fprintf(stderr, "kernel_launch: unexpected shapes (n_in %d, in0 %d, out %d, ws %zu need %zu); nothing launched\n", n_in, n_in > 0 ? in_sizes[0] : -1, out_size, ws_size, (size_t)WS_END); grid = -1; return; }
        int dev = 0, cus = 0, per_cu = 0;
        if (hipGetDevice(&dev) != hipSuccess || hipDeviceGetAttribute(&cus, hipDeviceAttributeMultiprocessorCount, dev) != hipSuccess) { fprintf(stderr, "kernel_launch: device query failed\n"); grid = -1; return; }
        if (hipFuncSetAttribute((const void*)hymba_fwd, hipFuncAttributeMaxDynamicSharedMemorySize, LDS_BYTES) != hipSuccess) { fprintf(stderr, "kernel_launch: hipFuncSetAttribute failed\n"); grid = -1; return; }
        if (hipOccupancyMaxActiveBlocksPerMultiprocessor(&per_cu, (const void*)hymba_fwd, NWAVES * 64, LDS_BYTES) != hipSuccess || per_cu < 1)
            fprintf(stderr, "kernel_launch: note: occupancy query reports %d workgroups per CU\n", per_cu);
        (void)hipGetLastError();
        grid = cus;
    }
    if (grid < 0) return;
    if (hipMemsetAsync((char*)d_ws + WS_CTL, 0, CTL_ZERO_BYTES, stream) != hipSuccess) { fprintf(stderr, "kernel_launch: memset failed\n"); return; }
    Args a{};
    for (int i = 0; i < 28; ++i) a.in[i] = (const float*)d_in[i];
    a.out = (float*)d_out; a.ws = (unsigned char*)d_ws;
#if MK_SPLIT
    for (int p = 0; p < N_PHASES; ++p) { a.ph_lo = p; a.ph_hi = p + 1; hipLaunchKernelGGL(hymba_fwd, dim3(grid), dim3(NWAVES * 64), LDS_BYTES, stream, a); }
#else
    a.ph_lo = 0; a.ph_hi = N_PHASES;
    hipLaunchKernelGGL(hymba_fwd, dim3(grid), dim3(NWAVES * 64), LDS_BYTES, stream, a);
#endif
    const hipError_t le = hipPeekAtLastError();
    if (le != hipSuccess) fprintf(stderr, "kernel_launch: launch failed: %s\n", hipGetErrorName(le));
}
```

```cpp
#include <hip/hip_runtime.h>
#include <cstdio>
#include <cstdint>
#ifndef MK_SPLIT
#define MK_SPLIT 0
#endif

constexpr int DM = 2048, NBATCH = 2, LSEQ = 8192, NCTX = 256, SEGB = NCTX + LSEQ, T = NBATCH * SEGB;
constexpr int DEPTH = 2, PIN = 4608, NEXP = 32, DEXP = 512, NROUTE = 36, NMODC = 6 * DM;
constexpr int NTM = T / 256;
constexpr int TPB = SEGB / 256;
constexpr int CH64 = SEGB / 64;
constexpr int SLOT_CAP = 42240;
constexpr int KSPLIT = 16;
constexpr float EPS = 1e-6f;
constexpr float QSCALE = 0.125f * 1.4426950408889634f;
constexpr int NWAVES = 8;

constexpr size_t MiB = 1u << 20;
constexpr size_t WS_CTL = 0, CTL_ZERO_BYTES = 1 * MiB;
constexpr size_t WS_MODP = 1 * MiB, WS_MOD = 6 * MiB, WS_WRT = 7 * MiB, WS_AUXB = 8 * MiB;
constexpr size_t WS_WIN = 10 * MiB, WS_WOUT = 46 * MiB, WS_UP = 62 * MiB, WS_DOWN = 318 * MiB;
constexpr size_t WS_X = 446 * MiB, WS_H = 578 * MiB, WS_P = 644 * MiB, WS_QP = 793 * MiB, WS_KP = 810 * MiB, WS_VT = 827 * MiB;
constexpr size_t WS_AUXA = 844 * MiB, WS_G = 877 * MiB, WS_YB = 943 * MiB, WS_SUM = 1009 * MiB, WS_ROUTE = 1012 * MiB;
constexpr size_t WS_HS = 1013 * MiB, WS_HM = 1178 * MiB, WS_YS = 1220 * MiB, WS_END = 1385 * MiB;
static_assert(WS_MODP + (size_t)DEPTH * KSPLIT * 3 * NMODC * 4 <= WS_MOD, "modp");
static_assert(WS_WIN + (size_t)DEPTH * PIN * DM * 2 <= WS_WOUT && WS_WOUT + (size_t)DEPTH * DM * DM * 2 <= WS_UP, "w");
static_assert(WS_UP + (size_t)DEPTH * NEXP * 1024 * DM * 2 <= WS_DOWN && WS_DOWN + (size_t)DEPTH * NEXP * DM * DEXP * 2 <= WS_X, "w2");
static_assert(WS_X + (size_t)T * DM * 4 <= WS_H && WS_H + (size_t)T * DM * 2 <= WS_P && WS_P + (size_t)T * PIN * 2 <= WS_QP, "act");
static_assert(WS_QP + (size_t)T * 512 * 2 <= WS_KP && WS_VT + (size_t)T * 512 * 2 <= WS_AUXA && WS_AUXA + (size_t)8 * T * 128 * 2 <= WS_G, "act2");
static_assert(WS_G + (size_t)T * DM * 2 <= WS_YB && WS_YB + (size_t)T * DM * 2 <= WS_SUM, "act3");
static_assert(WS_HS + (size_t)SLOT_CAP * DM * 2 <= WS_HM && WS_HM + (size_t)SLOT_CAP * DEXP * 2 <= WS_YS && WS_YS + (size_t)SLOT_CAP * DM * 2 <= WS_END, "moe");
constexpr int RT_TOKE = 0, RT_POS = T, RT_W = 3 * T, RT_SLOT = 5 * T, RT_WSLOT = 7 * T;
constexpr int RT_S2T = RT_WSLOT + SLOT_CAP;
static_assert((size_t)(RT_S2T + SLOT_CAP) * 4 <= 1 * MiB, "route");
constexpr int CW_TMO = 0, CW_CTXD = 64  , CW_AUXD = 72  , CW_FOV = 512  , CW_BAR = 4096, CW_CNT = 16384;
constexpr int CW_MOE = 32768, CW_MOE_L = 4096, MOE_NT = 0, MOE_TILE_E = 64, MOE_TMAP = 256, TMAP_STRIDE = 68;
static_assert(MOE_TMAP + 32 * TMAP_STRIDE <= CW_MOE_L && (CW_MOE + DEPTH * CW_MOE_L) * 4 <= (int)CTL_ZERO_BYTES, "moe ctl");

constexpr int RING_BYTES = 131072;
constexpr int MISC_OFF = 139264 + 320;
constexpr int TP_OFF = MISC_OFF + 128;
constexpr int GT_OFF = RING_BYTES;
constexpr int LDS_BYTES = 147456;
static_assert(TP_OFF + 33 * 4 + 64 <= LDS_BYTES && 8 * 16896 <= 139264 && GT_OFF + 4 * 256 * 4 <= 139264, "lds");

#define GAS __attribute__((address_space(1)))
#define LAS __attribute__((address_space(3)))
typedef unsigned short bf16;
typedef unsigned v4u __attribute__((ext_vector_type(4)));
typedef unsigned v2u __attribute__((ext_vector_type(2)));
typedef float f32x4 __attribute__((ext_vector_type(4)));
typedef float f32x16 __attribute__((ext_vector_type(16)));
typedef short bf16x8 __attribute__((ext_vector_type(8)));
typedef GAS unsigned gu32;
#define RLX_AGENT __ATOMIC_RELAXED, __HIP_MEMORY_SCOPE_AGENT
#define LDS_WAIT() asm volatile("s_waitcnt lgkmcnt(0)" ::: "memory")
#define VM_WAIT() asm volatile("s_waitcnt vmcnt(0)" ::: "memory")
__device__ __forceinline__ unsigned f2bf(float f) { unsigned u = __builtin_bit_cast(unsigned, f); return (u + 0x7fffu + ((u >> 16) & 1u)) >> 16; }
__device__ __forceinline__ unsigned pk2(float lo, float hi) { return f2bf(lo) | (f2bf(hi) << 16); }
__device__ __forceinline__ unsigned pk2_hw(float lo, float hi) { unsigned r; asm("v_cvt_pk_bf16_f32 %0, %1, %2" : "=v"(r) : "v"(lo), "v"(hi)); return r; }
__device__ __forceinline__ float bf2f(unsigned u16) { return __builtin_bit_cast(float, u16 << 16); }
__device__ __forceinline__ float bflo(unsigned w) { return __builtin_bit_cast(float, w << 16); }
__device__ __forceinline__ float bfhi(unsigned w) { return __builtin_bit_cast(float, w & 0xffff0000u); }
__device__ __forceinline__ int fresh_lane() { int ln; asm volatile("v_mbcnt_lo_u32_b32 %0, -1, 0\n\tv_mbcnt_hi_u32_b32 %0, -1, %0" : "=v"(ln)); return ln; }
template <int PAT> __device__ __forceinline__ float swz_xor(float v) { return __builtin_bit_cast(float, __builtin_amdgcn_ds_swizzle(__builtin_bit_cast(int, v), PAT)); }
__device__ __forceinline__ float half_swap_sum(float v) { auto rr = __builtin_amdgcn_permlane32_swap(__builtin_bit_cast(unsigned, v), __builtin_bit_cast(unsigned, v), false, false); return __builtin_bit_cast(float, rr[0]) + __builtin_bit_cast(float, rr[1]); }
__device__ __forceinline__ float wave_sum(float v) {
    const int ln = fresh_lane();
#pragma unroll
    for (int o = 1; o < 64; o <<= 1) v += __builtin_bit_cast(float, __builtin_amdgcn_ds_bpermute((ln ^ o) << 2, __builtin_bit_cast(int, v)));
    return v;
}
__device__ __forceinline__ float sigmoidf_(float x) { return 1.0f / (1.0f + __expf(-x)); }
__device__ __forceinline__ float siluf_(float x) { return x / (1.0f + __expf(-x)); }
__device__ __forceinline__ float gelu_tanh(float x) { const float z = 0.7978845608028654f * (x + 0.044715f * x * x * x); const float e = __expf(2.0f * z); return 0.5f * x * (2.0f - 2.0f / (e + 1.0f)); }
__device__ __forceinline__ int mod_row(int r) { const int b = r / SEGB; return (r - b * SEGB) < NCTX ? 2 : b; }

namespace pg8 {
#define PG8_LAS __attribute__((address_space(3)))
typedef unsigned short bf16_t;
typedef short bf16x8 __attribute__((ext_vector_type(8)));
typedef float f32x4 __attribute__((ext_vector_type(4)));
typedef unsigned u32x4 __attribute__((ext_vector_type(4)));
constexpr int BM = 256, BK = 64, HALF = 128, HTB = HALF * BK * 2  , STAGE_BYTES = 8 * HTB, NXCD = 8, WGM = 8;

__host__ __device__ __forceinline__ int lds_byte(int r, int c) { const int st = (r >> 4) * 2 + (c >> 5), rr = r & 15, cc = c & 31, ob = rr * 64 + cc * 2; return st * 1024 + (ob ^ (((ob >> 9) & 1) << 5)); }
__host__ __device__ __forceinline__ void stage_rc(int b, int& R, int& C) { const int st = b / 1024, sb = b % 1024, swz = sb ^ (((sb >> 9) & 1) << 5); R = (st >> 1) * 16 + swz / 64; C = (st & 1) * 32 + (swz % 64) / 2; }
__host__ __device__ __forceinline__ int perm32(int rho) { const int n = rho >> 4, i = rho & 15; return 8 * (i >> 2) + 4 * n + (i & 3); }

struct Unit { int pm, pn, aux; };
struct Gemm { const bf16_t* A; const bf16_t* Bt; int M, N, K; };

struct StaticOrder {
    int nM, nN, nwg, G, c;
    __host__ __device__ void init(int M, int N, int G_, int c_) { nM = M / BM; nN = N / BM; nwg = nM * nN; G = G_; c = c_; }
    __host__ __device__ bool next(int i, Unit& u) const {
        const long L = (long)i * G + c; if (L >= nwg) return false;
        int wgid = (int)L; { const int q = nwg / NXCD, r = nwg % NXCD, xcd = wgid % NXCD, off = wgid / NXCD; wgid = (xcd < r ? xcd * (q + 1) : r * (q + 1) + (xcd - r) * q) + off; }
        const int nig = WGM * nN, gid = wgid / nig, fm = gid * WGM, gsz = (nM - fm) < WGM ? (nM - fm) : WGM;
        u.pm = fm + ((wgid % nig) % gsz); u.pn = (wgid % nig) / gsz; return true;
    }
    __device__ __forceinline__ void a_ready(const Unit&) const {}
    __device__ __forceinline__ void done(const Unit&) const {}
};
__device__ __forceinline__ unsigned cvt_pk_bf16(float lo, float hi) { unsigned r; asm volatile("v_cvt_pk_bf16_f32 %0, %1, %2" : "=v"(r) : "v"(lo), "v"(hi)); return r; }
typedef float f32x2 __attribute__((ext_vector_type(2)));
template <class Epi, class Sched, bool ALIGN_EPI = false, bool SP2 = false, bool GATHER = false>
__device__ __forceinline__ void gemm_phase(PG8_LAS unsigned char* lds, const Gemm g, const Sched& S, const Epi& E, const int tid_in) {
    int tid_ = tid_in;
    const int tid = tid_, wid = __builtin_amdgcn_readfirstlane(tid >> 6), lane = tid & 63, wr = wid >> 2, wc = wid & 3, fr = lane & 15, fq = lane >> 4;
    const int K = g.K, nt = K / BK;
    unsigned voffA[2], voffB[2];
#pragma unroll
    for (int i = 0; i < 2; ++i) { int R, C; stage_rc(tid * 16 + i * 8192, R, C); const int Rb = Epi::PERM ? ((R & ~31) + perm32(R & 31)) : R;
        voffA[i] = (unsigned)(R * K + C) * 2u; voffB[i] = (unsigned)(Rb * K + C) * 2u; }
    static_assert(!GATHER || SP2, "GATHER is written for the SP2 loop");
    unsigned vC[2][2] = {}, vN[2][2] = {};
    int gR0 = 0, gC0 = 0; if constexpr (GATHER) stage_rc(tid * 16, gR0, gC0);
#define PG8_GOFF(v, ui_) do { _Pragma("unroll") for (int h_ = 0; h_ < 2; ++h_) _Pragma("unroll") for (int i_ = 0; i_ < 2; ++i_) v[h_][i_] = (unsigned)(S.row((ui_), h_ * 128 + gR0 + 64 * i_) * K + gC0) * 2u; } while (0)
    const size_t kstep = (size_t)(BK * 2);
    const size_t hstep = (size_t)HALF * K * 2;
    const size_t tstep = 2 * hstep;
    const unsigned ldsw = (unsigned)wid * 1024u;
    const int aoff = lds_byte(wr * 64 + fr, fq * 8), boff = lds_byte(wc * 32 + fr, fq * 8);
#define PG8_SA(b, h) (((b) * 2 + (h)) * HTB)
#define PG8_SB(b, h) ((4 + (b) * 2 + (h)) * HTB)
#define PG8_STAGE(bufoff, gbase, voff) do { _Pragma("unroll") for (int _i = 0; _i < 2; ++_i) \
        __builtin_amdgcn_global_load_lds((const unsigned*)((const char*)(gbase) + (voff)[_i]), (PG8_LAS unsigned*)(lds + (bufoff) + ldsw + _i * 8192), 16, 0, 0); } while (0)
#define PG8_LDA(dst, b, h) do { _Pragma("unroll") for (int m = 0; m < 4; ++m) _Pragma("unroll") for (int k = 0; k < 2; ++k) dst[m][k] = *(const PG8_LAS bf16x8*)(lds + PG8_SA(b, h) + aoff + m * 2048 + k * 1024); } while (0)
#define PG8_LDB(dst, b, h) do { _Pragma("unroll") for (int n = 0; n < 2; ++n) _Pragma("unroll") for (int k = 0; k < 2; ++k) dst[n][k] = *(const PG8_LAS bf16x8*)(lds + PG8_SB(b, h) + boff + n * 2048 + k * 1024); } while (0)
#define PG8_MMA(ai, bj, At, Bt) do { __builtin_amdgcn_s_setprio(1); _Pragma("unroll") for (int m = 0; m < 4; ++m) _Pragma("unroll") for (int n = 0; n < 2; ++n) _Pragma("unroll") for (int k = 0; k < 2; ++k) \
        acc[ai][bj][m][n] = __builtin_amdgcn_mfma_f32_16x16x32_bf16(Bt[n][k], At[m][k], acc[ai][bj][m][n], 0, 0, 0); __builtin_amdgcn_s_setprio(0); } while (0)
#define PG8_WAIT_V(n) asm volatile("s_waitcnt vmcnt(" #n ")" ::: "memory")
#define PG8_WAIT_L(n) asm volatile("s_waitcnt lgkmcnt(" #n ")" ::: "memory")
#define PG8_BAR __builtin_amdgcn_s_barrier()
#define PG8_SCHED __builtin_amdgcn_sched_barrier(0)
    Unit cur, nxt; int ui = 0;
    if (!S.next(0, cur)) return;
    f32x4 acc[2][2][4][2];
#pragma unroll
    for (int a = 0; a < 2; ++a)
#pragma unroll
        for (int b = 0; b < 2; ++b)
#pragma unroll
            for (int m = 0; m < 4; ++m)
#pragma unroll
                for (int n = 0; n < 2; ++n) acc[a][b][m][n] = (f32x4){0.f, 0.f, 0.f, 0.f};
    bf16x8 At[4][2], B0[2][2], B1[2][2];
    const char* cA = GATHER ? (const char*)g.A : (const char*)g.A + (size_t)cur.pm * tstep; const char* cB = (const char*)g.Bt + (size_t)cur.pn * tstep;
    const size_t ahstep = GATHER ? 0 : hstep;
    if constexpr (GATHER) PG8_GOFF(vC, 0);
#define PG8_VA(sel_next, h) (GATHER ? vC[h] : voffA)
    S.a_ready(cur);
    if constexpr (SP2) {
        PG8_STAGE(PG8_SB(0, 0), cB, voffB); PG8_STAGE(PG8_SB(0, 1), cB + hstep, voffB); PG8_STAGE(PG8_SA(0, 0), cA, PG8_VA(false, 0)); PG8_STAGE(PG8_SA(0, 1), cA + ahstep, PG8_VA(false, 1));
        if (wr == 1) PG8_BAR;
        PG8_WAIT_V(2); PG8_BAR;
        PG8_STAGE(PG8_SB(1, 0), cB + kstep, voffB); PG8_STAGE(PG8_SA(1, 0), cA + kstep, PG8_VA(false, 0)); PG8_STAGE(PG8_SB(1, 1), cB + hstep + kstep, voffB);
        PG8_WAIT_V(6); PG8_BAR;
    } else {
        PG8_STAGE(PG8_SB(0, 0), cB, voffB); PG8_STAGE(PG8_SA(0, 0), cA, voffA); PG8_STAGE(PG8_SB(0, 1), cB + hstep, voffB); PG8_STAGE(PG8_SA(0, 1), cA + hstep, voffA);
        if (wr == 1) PG8_BAR;
        PG8_WAIT_V(4); PG8_BAR;
        PG8_STAGE(PG8_SB(1, 0), cB + kstep, voffB); PG8_STAGE(PG8_SA(1, 0), cA + kstep, voffA); PG8_STAGE(PG8_SB(1, 1), cB + hstep + kstep, voffB);
        PG8_WAIT_V(6); PG8_BAR;
    }
    for (;;) {
        const bool has_next = S.next(ui + 1, nxt);
        const char* nA = (has_next && !GATHER) ? (const char*)g.A + (size_t)nxt.pm * tstep : cA; const char* nB = has_next ? (const char*)g.Bt + (size_t)nxt.pn * tstep : cB;
        if constexpr (GATHER) { if (has_next) PG8_GOFF(vN, ui + 1); else { _Pragma("unroll") for (int h_ = 0; h_ < 2; ++h_) _Pragma("unroll") for (int i_ = 0; i_ < 2; ++i_) vN[h_][i_] = vC[h_][i_]; } }
        for (int t = 0; t < nt; t += 2) {
            const bool last = (t == nt - 2);
            const char* a1 = cA + (size_t)(t + 1) * kstep;
            const char* a2 = last ? nA : cA + (size_t)(t + 2) * kstep; const char* b2 = last ? nB : cB + (size_t)(t + 2) * kstep;
            const char* a3 = a2 + kstep; const char* b3 = b2 + kstep;
            if (last && has_next) S.a_ready(nxt);
            unsigned vs0[2], vs1[2];
            _Pragma("unroll") for (int i_ = 0; i_ < 2; ++i_) { vs0[i_] = GATHER ? (last ? vN[0][i_] : vC[0][i_]) : voffA[i_]; vs1[i_] = GATHER ? (last ? vN[1][i_] : vC[1][i_]) : voffA[i_]; }
            if constexpr (SP2) {
            PG8_LDB(B0, 0, 0); PG8_LDB(B1, 0, 1); PG8_SCHED; PG8_LDA(At, 0, 0); PG8_STAGE(PG8_SA(1, 1), a1 + ahstep, PG8_VA(false, 1));
            PG8_WAIT_V(8); PG8_WAIT_L(0); PG8_BAR; PG8_MMA(0, 0, At, B0); PG8_MMA(0, 1, At, B1); PG8_BAR; PG8_SCHED;
            PG8_LDA(At, 0, 1); PG8_STAGE(PG8_SB(0, 0), b2, voffB); PG8_STAGE(PG8_SB(0, 1), b2 + hstep, voffB); PG8_STAGE(PG8_SA(0, 0), a2, vs0);
            PG8_WAIT_V(8); PG8_WAIT_L(0); PG8_BAR; PG8_MMA(1, 0, At, B0); PG8_MMA(1, 1, At, B1); PG8_BAR; PG8_SCHED;
            PG8_LDB(B0, 1, 0); PG8_LDB(B1, 1, 1); PG8_SCHED; PG8_LDA(At, 1, 0); PG8_STAGE(PG8_SA(0, 1), a2 + ahstep, vs1);
            PG8_WAIT_V(8); PG8_WAIT_L(0); PG8_BAR; PG8_MMA(0, 0, At, B0); PG8_MMA(0, 1, At, B1); PG8_BAR; PG8_SCHED;
            PG8_LDA(At, 1, 1); PG8_STAGE(PG8_SB(1, 0), b3, voffB); PG8_STAGE(PG8_SB(1, 1), b3 + hstep, voffB); PG8_STAGE(PG8_SA(1, 0), a3, vs0);
            PG8_WAIT_V(8); PG8_WAIT_L(0); PG8_BAR; PG8_MMA(1, 0, At, B0); PG8_MMA(1, 1, At, B1); PG8_BAR; PG8_SCHED;
            } else {
            PG8_LDB(B0, 0, 0); PG8_SCHED; PG8_LDA(At, 0, 0); PG8_STAGE(PG8_SA(1, 1), a1 + hstep, voffA);
            PG8_WAIT_L(8); PG8_BAR; PG8_WAIT_L(0); PG8_MMA(0, 0, At, B0); PG8_BAR; PG8_SCHED;
            PG8_LDB(B1, 0, 1); PG8_STAGE(PG8_SB(0, 0), b2, voffB);
            PG8_BAR; PG8_WAIT_L(0); PG8_MMA(0, 1, At, B1); PG8_BAR;
            PG8_LDA(At, 0, 1); PG8_STAGE(PG8_SA(0, 0), a2, voffA);
            PG8_BAR; PG8_WAIT_L(0); PG8_MMA(1, 0, At, B0); PG8_BAR; PG8_SCHED;
            PG8_STAGE(PG8_SB(0, 1), b2 + hstep, voffB);
            PG8_WAIT_V(6); PG8_BAR; PG8_MMA(1, 1, At, B1); PG8_BAR;
            PG8_LDB(B0, 1, 0); PG8_SCHED; PG8_LDA(At, 1, 0); PG8_STAGE(PG8_SA(0, 1), a2 + hstep, voffA);
            PG8_WAIT_L(8); PG8_BAR; PG8_WAIT_L(0); PG8_MMA(0, 0, At, B0); PG8_BAR; PG8_SCHED;
            PG8_LDB(B1, 1, 1); PG8_STAGE(PG8_SB(1, 0), b3, voffB);
            PG8_BAR; PG8_WAIT_L(0); PG8_MMA(0, 1, At, B1); PG8_BAR;
            PG8_LDA(At, 1, 1); PG8_STAGE(PG8_SA(1, 0), a3, voffA);
            PG8_BAR; PG8_WAIT_L(0); PG8_MMA(1, 0, At, B0); PG8_BAR; PG8_SCHED;
            PG8_STAGE(PG8_SB(1, 1), b3 + hstep, voffB);
            PG8_WAIT_V(6); PG8_BAR; PG8_MMA(1, 1, At, B1); PG8_BAR;
            }
        }
        if constexpr (ALIGN_EPI) { if (wr == 0) PG8_BAR; }
        if constexpr (!Epi::AFTER_DRAIN) { E(acc, cur, wr, wc, fr, fq); S.done(cur); }
        if (!has_next) break;
#pragma unroll
        for (int a = 0; a < 2; ++a)
#pragma unroll
            for (int b = 0; b < 2; ++b)
#pragma unroll
                for (int m = 0; m < 4; ++m)
#pragma unroll
                    for (int n = 0; n < 2; ++n) acc[a][b][m][n] = (f32x4){0.f, 0.f, 0.f, 0.f};
        cur = nxt; cA = nA; cB = nB; ++ui;
        if constexpr (GATHER) { _Pragma("unroll") for (int h_ = 0; h_ < 2; ++h_) _Pragma("unroll") for (int i_ = 0; i_ < 2; ++i_) vC[h_][i_] = vN[h_][i_]; }
        if constexpr (ALIGN_EPI) { if (wr == 1) PG8_BAR; }
    }
    PG8_WAIT_V(0);
    if constexpr (!ALIGN_EPI) { if (wr == 0) PG8_BAR; }
    PG8_BAR;
    if constexpr (Epi::AFTER_DRAIN) { E.fused(acc, cur, wr, wc, fr, fq, lds, wid, lane); S.done(cur); }
#undef PG8_SA
#undef PG8_GOFF
#undef PG8_VA
#undef PG8_SB
#undef PG8_STAGE
#undef PG8_LDA
#undef PG8_LDB
#undef PG8_MMA
#undef PG8_WAIT_V
#undef PG8_WAIT_L
#undef PG8_BAR
#undef PG8_SCHED
}
}
#define XB_TMO      128
#define XB_XCNT(j)  (256  + 64 * (j))
#define XB_XSUB(j)  (1280 + 64 * (j))
#define XB_XGEN(j)  (2304 + 64 * (j))
#define XB_TOP      3328
#define XB_TOPGEN   3392
#define XCD_BAR_WORDS 3456
#define XB_SPIN_CAP (1u << 18)

__device__ __forceinline__ unsigned xb_ld(unsigned* p)              { return __hip_atomic_load(p, __ATOMIC_RELAXED, __HIP_MEMORY_SCOPE_AGENT); }
__device__ __forceinline__ unsigned xb_add(unsigned* p, unsigned v) { return __hip_atomic_fetch_add(p, v, __ATOMIC_RELAXED, __HIP_MEMORY_SCOPE_AGENT); }
__device__ __forceinline__ unsigned xb_xcc_id() { return (unsigned)__builtin_amdgcn_s_getreg((3 << 11) | 20) & 0xFu; }
#define XB_SPIN(cond, bar) do { unsigned _sp = 0; while (cond) { __builtin_amdgcn_s_sleep(1); \
    if ((++_sp & 255u) == 0u) { if (xb_ld(&(bar)[XB_TMO])) break; if (_sp > XB_SPIN_CAP) { atomicAdd(&(bar)[XB_TMO], 1u); break; } } } } while (0)

struct XcdBarrier {
    unsigned* bar; unsigned x;
    volatile LAS unsigned* st;
};

__device__ __forceinline__ XcdBarrier xcd_barrier_post(unsigned* bar, volatile LAS unsigned* st) {
    XcdBarrier b; b.bar = bar; b.x = xb_xcc_id(); b.st = st;
    if (threadIdx.x == 0) (void)xb_add(&bar[XB_XCNT(b.x)], 1u);
    return b;
}
__device__ __forceinline__ void xcd_barrier_complete(unsigned* bar, unsigned x, unsigned& nloc, unsigned& nx) {
    const unsigned G = gridDim.x * gridDim.y * gridDim.z;
    unsigned sum, cnt, mine, sp = 0u;
    for (;;) {
        sum = 0u; cnt = 0u; mine = 0u;
#pragma unroll
        for (unsigned j = 0; j < 16; ++j) { const unsigned c = xb_ld(&bar[XB_XCNT(j)]); sum += c; cnt += (c > 0u) ? 1u : 0u; mine = (j == x) ? c : mine; }
        if (sum == G) break;
        __builtin_amdgcn_s_sleep(1);
        if ((++sp & 255u) == 0u) { if (xb_ld(&bar[XB_TMO])) break; if (sp > XB_SPIN_CAP) { atomicAdd(&bar[XB_TMO], 1u); break; } }
    }
    nloc = mine > 0u ? mine : 1u; nx = cnt > 0u ? cnt : 1u;
}

__device__ __forceinline__ void xcd_barrier(const XcdBarrier& b) {
    asm volatile("s_waitcnt vmcnt(0)" ::: "memory");
    __syncthreads();
    if (threadIdx.x == 0) {
        unsigned* bar = b.bar;
        __builtin_amdgcn_s_waitcnt(0);
        unsigned nloc = b.st[0], nx = b.st[1];
        if (nloc == 0u) { xcd_barrier_complete(bar, b.x, nloc, nx); b.st[0] = nloc; b.st[1] = nx; }
        const unsigned old = xb_add(&bar[XB_XSUB(b.x)], 1u);
        const unsigned gen = old / nloc;
        if (old + 1u == (gen + 1u) * nloc) {
            __builtin_amdgcn_fence(__ATOMIC_RELEASE, "agent");
            asm volatile("s_waitcnt vmcnt(0)" ::: "memory");
            const unsigned og = xb_add(&bar[XB_TOP], 1u);
            const unsigned tg = og / nx;
            if (og + 1u == (tg + 1u) * nx) xb_add(&bar[XB_TOPGEN], 1u);
            else XB_SPIN(xb_ld(&bar[XB_TOPGEN]) == tg, bar);
            __builtin_amdgcn_fence(__ATOMIC_ACQUIRE, "agent");
            xb_add(&bar[XB_XGEN(b.x)], 1u);
            asm volatile("s_waitcnt vmcnt(0)" ::: "memory");
        } else {
            XB_SPIN(xb_ld(&bar[XB_XGEN(b.x)]) == gen, bar);
            __builtin_amdgcn_fence(__ATOMIC_ACQUIRE, "agent");
            asm volatile("s_waitcnt vmcnt(0)" ::: "memory");
        }
    }
    __syncthreads();
}

using pg8::Unit;
struct EpiStoreBf16 {
    static constexpr bool PERM = true, AFTER_DRAIN = false;
    bf16* O; int ldc;
    __device__ __forceinline__ void operator()(const pg8::f32x4 (&acc)[2][2][4][2], const Unit& u, int wr, int wc, int fr, int fq) const {
        const int row0 = u.pm * 256 + wr * 64 + fr, col0 = u.pn * 256 + wc * 32 + 8 * fq;
#pragma unroll
        for (int ai = 0; ai < 2; ++ai)
#pragma unroll
            for (int m = 0; m < 4; ++m) { bf16* rowp = O + (size_t)(row0 + ai * 128 + m * 16) * ldc + col0;
#pragma unroll
                for (int bj = 0; bj < 2; ++bj) { const pg8::f32x4 v0 = acc[ai][bj][m][0], v1 = acc[ai][bj][m][1];
                    v4u w; w.x = pg8::cvt_pk_bf16(v0[0], v0[1]); w.y = pg8::cvt_pk_bf16(v0[2], v0[3]); w.z = pg8::cvt_pk_bf16(v1[0], v1[1]); w.w = pg8::cvt_pk_bf16(v1[2], v1[3]);
                    *(v4u*)(rowp + bj * 128) = w; } }
    }
};
__device__ __forceinline__ float fast_sigmoid(float x) { return __builtin_amdgcn_rcpf(1.0f + __builtin_amdgcn_exp2f(-1.4426950408889634f * x)); }
struct EpiAux {
    static constexpr bool PERM = true, AFTER_DRAIN = false;
    bf16* G; bf16* YB; const bf16* AUXA; const float* gate_b  ; const float* sp8l2  ; const float* pool_b  ; const float* pool_scale  ;
    __device__ __forceinline__ void operator()(const pg8::f32x4 (&acc)[2][2][4][2], const Unit& u, int wr, int wc, int fr, int fq) const {
        const int q = u.pn, pmrow = u.pm % NTM; const int row0 = pmrow * 256 + wr * 64 + fr; const int c0 = wc * 32 + 8 * fq;
        if (q < 8) {
            const int blk = q >> 1, dir = q & 1;
            float br[8], bi[8], sp[8];
            { const float* p0 = gate_b + ((dir * 2 + 0) * 4 + blk) * 128 + c0, *p1 = gate_b + ((dir * 2 + 1) * 4 + blk) * 128 + c0, *p2 = sp8l2 + dir * 512 + blk * 128 + c0;
#pragma unroll
              for (int i = 0; i < 8; ++i) { br[i] = p0[i]; bi[i] = p1[i]; sp[i] = p2[i]; } }
            bf16* obase = G + (size_t)row0 * DM + q * 256 + c0; const bf16* ubase = AUXA + ((size_t)blk * T + row0) * 128 + c0;
#pragma unroll
            for (int ai = 0; ai < 2; ++ai) { v4u uq[4];
#pragma unroll
                for (int m = 0; m < 4; ++m) uq[m] = *(const v4u*)(ubase + (size_t)(ai * 128 + m * 16) * 128);
#pragma unroll
                for (int m = 0; m < 4; ++m) { const int ro = ai * 128 + m * 16;
                    const v4u uw = uq[m]; const float uu[8] = {bflo(uw.x), bfhi(uw.x), bflo(uw.y), bfhi(uw.y), bflo(uw.z), bfhi(uw.z), bflo(uw.w), bfhi(uw.w)};
                    float la[8], bx[8];
#pragma unroll
                    for (int i = 0; i < 8; ++i) { const float gr = acc[ai][0][m][i >> 2][i & 3] + br[i], gi = acc[ai][1][m][i >> 2][i & 3] + bi[i];
                        const float r = fast_sigmoid(gr), ig = fast_sigmoid(gi); const float l2 = -sp[i] * r;
                        const float x = -1.3862943611198906f * l2;
                        const float em = 1.0f - __builtin_amdgcn_exp2f(2.0f * l2);
                        const float sr = x * (1.0f + x * (-0.5f + x * (0.16666667f - 0.041666668f * x)));
                        const float om = x < 0.125f ? sr : em;
                        la[i] = l2; bx[i] = __builtin_amdgcn_sqrtf(om) * (ig * uu[i]); }
                    v4u w; w.x = pg8::cvt_pk_bf16(la[0], la[1]); w.y = pg8::cvt_pk_bf16(la[2], la[3]); w.z = pg8::cvt_pk_bf16(la[4], la[5]); w.w = pg8::cvt_pk_bf16(la[6], la[7]);
                    *(v4u*)(obase + (size_t)ro * DM) = w;
                    w.x = pg8::cvt_pk_bf16(bx[0], bx[1]); w.y = pg8::cvt_pk_bf16(bx[2], bx[3]); w.z = pg8::cvt_pk_bf16(bx[4], bx[5]); w.w = pg8::cvt_pk_bf16(bx[6], bx[7]);
                    *(v4u*)(obase + (size_t)ro * DM + 128) = w; } }
        } else {
            const int g = q - 8;
            const pg8::f32x4 b0 = *(const pg8::f32x4*)(pool_b + g * 128 + c0) * *(const pg8::f32x4*)(pool_scale + g * 128 + c0), b1 = *(const pg8::f32x4*)(pool_b + g * 128 + c0 + 4) * *(const pg8::f32x4*)(pool_scale + g * 128 + c0 + 4);
            bf16* obase = YB + (size_t)row0 * DM + 1024 + g * 128 + c0;
#pragma unroll
            for (int ai = 0; ai < 2; ++ai)
#pragma unroll
                for (int m = 0; m < 4; ++m) { const pg8::f32x4 v0 = acc[ai][0][m][0] + b0, v1 = acc[ai][0][m][1] + b1;
                    v4u w; w.x = pg8::cvt_pk_bf16(v0[0], v0[1]); w.y = pg8::cvt_pk_bf16(v0[2], v0[3]); w.z = pg8::cvt_pk_bf16(v1[0], v1[1]); w.w = pg8::cvt_pk_bf16(v1[2], v1[3]);
                    *(v4u*)(obase + (size_t)(ai * 128 + m * 16) * DM) = w; }
        }
    }
};
struct AuxSched {
    int G, c;
    __device__ __forceinline__ bool next(int i, Unit& u) const { const int L = i * G + c; if (L >= NTM * 12) return false; const int pmrow = L / 12, q = L % 12; u.pn = q; u.pm = (q < 8 ? (q >> 1) : (q - 4)) * NTM + pmrow; return true; }
    __device__ __forceinline__ void a_ready(const Unit&) const {}
    __device__ __forceinline__ void done(const Unit&) const {}
};
struct EpiResid {
    static constexpr bool PERM = true, AFTER_DRAIN = false;
    bf16* X; const float* mod  ; const float* in_x; const float* in_ctx;
    __device__ __forceinline__ void operator()(const pg8::f32x4 (&acc)[2][2][4][2], const Unit& u, int wr, int wc, int fr, int fq) const {
        const int b = u.pm / TPB, tb = u.pm - b * TPB; const int mrow = (tb == 0) ? 2 : b;
        const float* rin = !in_x ? nullptr : (tb == 0 ? in_ctx + (size_t)b * NCTX * DM : in_x + ((size_t)b * LSEQ + (size_t)(tb - 1) * 256) * DM);
        bf16* xb = X + (size_t)u.pm * 256 * DM;
        const int col0 = u.pn * 256 + wc * 32 + 8 * fq; const float* m2 = mod + (size_t)mrow * NMODC + 2 * DM + col0;
#pragma unroll
        for (int bj = 0; bj < 2; ++bj) { const pg8::f32x4 g0 = *(const pg8::f32x4*)(m2 + bj * 128), g1 = *(const pg8::f32x4*)(m2 + bj * 128 + 4);
#pragma unroll
            for (int ai = 0; ai < 2; ++ai) { pg8::f32x4 r0[4], r1[4];
                if (rin) {
#pragma unroll
                    for (int m = 0; m < 4; ++m) { const size_t ro = (size_t)(ai * 128 + wr * 64 + m * 16 + fr) * DM + col0 + bj * 128; r0[m] = *(const pg8::f32x4*)(rin + ro); r1[m] = *(const pg8::f32x4*)(rin + ro + 4); }
                } else { v4u w4[4];
#pragma unroll
                    for (int m = 0; m < 4; ++m) { const size_t ro = (size_t)(ai * 128 + wr * 64 + m * 16 + fr) * DM + col0 + bj * 128; w4[m] = *(const v4u*)(xb + ro); }
#pragma unroll
                    for (int m = 0; m < 4; ++m) { const v4u w = w4[m]; r0[m][0] = bflo(w.x); r0[m][1] = bfhi(w.x); r0[m][2] = bflo(w.y); r0[m][3] = bfhi(w.y); r1[m][0] = bflo(w.z); r1[m][1] = bfhi(w.z); r1[m][2] = bflo(w.w); r1[m][3] = bfhi(w.w); }
                }
#pragma unroll
                for (int m = 0; m < 4; ++m) { const size_t ro = (size_t)(ai * 128 + wr * 64 + m * 16 + fr) * DM + col0 + bj * 128;
                    const pg8::f32x4 o0 = r0[m] + g0 * acc[ai][bj][m][0], o1 = r1[m] + g1 * acc[ai][bj][m][1];
                    v4u w; w.x = pg8::cvt_pk_bf16(o0[0], o0[1]); w.y = pg8::cvt_pk_bf16(o0[2], o0[3]); w.z = pg8::cvt_pk_bf16(o1[0], o1[1]); w.w = pg8::cvt_pk_bf16(o1[2], o1[3]);
                    *(v4u*)(xb + ro) = w; } } }
    }
};
struct MoeSched {
    const LAS int* perm; int ncol, G, c, lim;
    const LAS int* gt;
    __device__ __forceinline__ int row(int ui, int r) const { return gt[ui * 256 + r]; }
    __device__ __forceinline__ bool next(int i, Unit& u) const {
        const int L = i * G + c; const int nt = perm[0]; if (L >= nt * ncol || L >= lim) return false;
        const int q = L / ncol, j = L - q * ncol; const int pe = perm[1 + q];
        u.pm = pe & 0xffff; u.pn = (pe >> 16) * ncol + j; u.aux = q; return true;
    }
    __device__ __forceinline__ void a_ready(const Unit&) const {}
    __device__ __forceinline__ void done(const Unit&) const {}
};
struct MoeOneUp {
    const LAS int* perm; int L; const LAS int* gt;
    __device__ __forceinline__ int row(int, int r) const { return gt[r]; }
    __device__ __forceinline__ bool next(int i, Unit& u) const { if (i > 0) return false; const int q = L >> 2, j = L & 3; const int pe = perm[1 + q]; u.pm = pe & 0xffff; u.pn = (pe >> 16) * 4 + j; u.aux = q; return true; }
    __device__ __forceinline__ void a_ready(const Unit&) const {}
    __device__ __forceinline__ void done(const Unit&) const {}
};
struct MoeDownSched {
    const LAS int* perm; int G, c, R, qov; const unsigned* cnt;
    __device__ __forceinline__ bool next(int i, Unit& u) const {
        int L;
        if (R == 0) L = i * G + c;
        else { const int vi = c < R ? i + 2 : i; L = vi < 2 ? vi * (G - R) + (c - R) : 2 * (G - R) + (vi - 2) * G + c; }
        const int nt = perm[0]; if (L >= nt * 8) return false;
        const int q = L >> 3, j = L & 7; const int pe = perm[1 + q];
        u.pm = pe & 0xffff; u.pn = (pe >> 16) * 8 + j; u.aux = q; return true;
    }
    __device__ __forceinline__ void a_ready(const Unit& u) const {
        if (R == 0 || u.aux < qov) return;
        const unsigned* w = cnt + u.aux;
        for (unsigned sp = 0; sp < (1u << 24); ++sp) { if ((unsigned)__builtin_amdgcn_readfirstlane((int)__hip_atomic_load(w, __ATOMIC_RELAXED, __HIP_MEMORY_SCOPE_AGENT)) >= 4u) break; __builtin_amdgcn_s_sleep(2); }
        __builtin_amdgcn_fence(__ATOMIC_ACQUIRE, "agent");
    }
    __device__ __forceinline__ void done(const Unit&) const {}
};
struct EpiSwiGLU {
    static constexpr bool PERM = true, AFTER_DRAIN = false;
    bf16* HM; const float* wslot;
    __device__ __forceinline__ void operator()(const pg8::f32x4 (&acc)[2][2][4][2], const Unit& u, int wr, int wc, int fr, int fq) const {
        const int j = u.pn & 3; const int row0 = u.pm * 256 + wr * 64 + fr, col0 = j * 128 + wc * 32 + 8 * fq;
        float ws[8];
#pragma unroll
        for (int i = 0; i < 8; ++i) ws[i] = wslot[row0 + (i >> 2) * 128 + (i & 3) * 16];
#pragma unroll
        for (int ai = 0; ai < 2; ++ai)
#pragma unroll
            for (int m = 0; m < 4; ++m) { float h[8];
#pragma unroll
                for (int n = 0; n < 2; ++n)
#pragma unroll
                    for (int x = 0; x < 4; ++x) h[n * 4 + x] = ws[ai * 4 + m] * siluf_(acc[ai][0][m][n][x]) * acc[ai][1][m][n][x];
                v4u w; w.x = pg8::cvt_pk_bf16(h[0], h[1]); w.y = pg8::cvt_pk_bf16(h[2], h[3]); w.z = pg8::cvt_pk_bf16(h[4], h[5]); w.w = pg8::cvt_pk_bf16(h[6], h[7]);
                *(v4u*)(HM + (size_t)(row0 + ai * 128 + m * 16) * DEXP + col0) = w; }
    }
};
struct EpiDown {
    static constexpr bool PERM = true, AFTER_DRAIN = false;
    bf16* YS;
    __device__ __forceinline__ void operator()(const pg8::f32x4 (&acc)[2][2][4][2], const Unit& u, int wr, int wc, int fr, int fq) const {
        const int j = u.pn & 7; const int row0 = u.pm * 256 + wr * 64 + fr, col0 = j * 256 + wc * 32 + 8 * fq;
#pragma unroll
        for (int ai = 0; ai < 2; ++ai)
#pragma unroll
            for (int m = 0; m < 4; ++m) { const int row = row0 + ai * 128 + m * 16;
#pragma unroll
                for (int bj = 0; bj < 2; ++bj) { const pg8::f32x4 v0 = acc[ai][bj][m][0], v1 = acc[ai][bj][m][1];
                    v4u w; w.x = pg8::cvt_pk_bf16(v0[0], v0[1]); w.y = pg8::cvt_pk_bf16(v0[2], v0[3]); w.z = pg8::cvt_pk_bf16(v1[0], v1[1]); w.w = pg8::cvt_pk_bf16(v1[2], v1[3]);
                    *(v4u*)(YS + (size_t)row * DM + col0 + bj * 128) = w; } }
    }
};
struct RowOrder {
    pg8::StaticOrder S; bool latent_only;
    __device__ __forceinline__ bool next(int i, Unit& u) const { if (!S.next(i, u)) return false; if (latent_only) u.pm = u.pm + 1 + (u.pm >= TPB - 1 ? 1 : 0); return true; }
    __device__ __forceinline__ void a_ready(const Unit&) const {}
    __device__ __forceinline__ void done(const Unit&) const {}
};
struct OneUnit {
    int pm, pn;
    __device__ __forceinline__ bool next(int i, Unit& u) const { if (i > 0) return false; u.pm = pm; u.pn = pn; return true; }
    __device__ __forceinline__ void a_ready(const Unit&) const {}
    __device__ __forceinline__ void done(const Unit&) const {}
};

struct Frame {
    LAS unsigned char* lds; unsigned char* ws; const float* const* in;
    int tid, lane, wave, vcu, G;
};
enum { I_X = 0, I_C, I_CTX, I_CCTX, I_MODW, I_MODB, I_NMIX, I_NFFN, I_WIN, I_WOUT, I_RGCW, I_RGCB, I_RGGW, I_RGGB, I_RGLAM, I_SCW, I_POOLW, I_POOLB, I_POOLS, I_DALAM, I_DANORM,
       I_GRPW, I_GRPB, I_EXPW, I_EXPB, I_UP, I_DOWN, I_NFINAL };

__device__ __forceinline__ void transpose_item(const float* W, int K, int N, bf16* WT, int k0, int n0, int n0_out, LAS float* scr, int lane) {
    float v[32];
#pragma unroll
    for (int i = 0; i < 32; ++i) { const int kk = 2 * i + (lane >> 5); v[i] = W[(size_t)(k0 + kk) * N + n0 + (lane & 31)]; }
#pragma unroll
    for (int i = 0; i < 32; ++i) { const int kk = 2 * i + (lane >> 5); scr[kk * 33 + (lane & 31)] = v[i]; }
    LDS_WAIT(); asm volatile("" ::: "memory");
    const int c = lane & 7;
#pragma unroll
    for (int j = 0; j < 4; ++j) { const int n = (lane >> 3) + 8 * j; const LAS float* s = scr + (8 * c) * 33 + n;
        v4u o; o.x = pk2_hw(s[0 * 33], s[1 * 33]); o.y = pk2_hw(s[2 * 33], s[3 * 33]); o.z = pk2_hw(s[4 * 33], s[5 * 33]); o.w = pk2_hw(s[6 * 33], s[7 * 33]);
        *(GAS v4u*)(WT + (size_t)(n0_out + n) * K + k0 + 8 * c) = o; }
    LDS_WAIT(); asm volatile("" ::: "memory");
}
__device__ __forceinline__ void p0_prologue(Frame& F) {
    const int gw = F.vcu * NWAVES + F.wave, NGW = F.G * NWAVES;
    LAS float* S = (LAS float*)(F.lds);
    for (int i = F.tid; i < 3 * DM; i += NWAVES * 64) { const int r = i / DM, k = i % DM; const float c = r < 2 ? F.in[I_C][r * DM + k] : F.in[I_CCTX][k]; S[i] = siluf_(c); }
    __syncthreads();
    {
        float* MODP = (float*)(F.ws + WS_MODP);
        for (int it = gw; it < DEPTH * 48 * KSPLIT; it += NGW) {
            const int kc = it % KSPLIT, nch = (it / KSPLIT) % 48, l = it / (KSPLIT * 48);
            const float* W = F.in[I_MODW] + ((size_t)l * DM + kc * 128) * NMODC + 4 * (nch * 64 + F.lane);
            f32x4 a0 = {0.f, 0.f, 0.f, 0.f}, a1 = a0, a2 = a0;
            for (int k0 = 0; k0 < 128; k0 += 32) {
                f32x4 wv[32];
#pragma unroll
                for (int k = 0; k < 32; ++k) wv[k] = __builtin_nontemporal_load((const GAS f32x4*)(W + (size_t)(k0 + k) * NMODC));
                __builtin_amdgcn_sched_barrier(0);
#pragma unroll
                for (int k = 0; k < 32; ++k) { const int kk = kc * 128 + k0 + k; a0 += wv[k] * S[kk]; a1 += wv[k] * S[DM + kk]; a2 += wv[k] * S[2 * DM + kk]; }
            }
            float* o = MODP + ((size_t)(l * KSPLIT + kc) * 3) * NMODC + 4 * (nch * 64 + F.lane);
            *(f32x4*)o = a0; *(f32x4*)(o + NMODC) = a1; *(f32x4*)(o + 2 * NMODC) = a2;
        }
    }
    __syncthreads();
    {
        LAS float* scr = (LAS float*)(F.lds + F.wave * 16384);
        constexpr int I_IN = 32 * 144, I_OUT = 32 * 64;
        constexpr int PER_L = I_IN + I_OUT;
        for (int it = gw; it < DEPTH * PER_L; it += NGW) {
            const int l = it / PER_L; int r = it % PER_L;
            if (r < I_IN) { const int kb = r / 144, nb = r % 144; transpose_item(F.in[I_WIN] + (size_t)l * DM * PIN, DM, PIN, (bf16*)(F.ws + WS_WIN) + (size_t)l * PIN * DM, 64 * kb, 32 * nb, 32 * nb, scr, F.lane); continue; } r -= I_IN;
            { const int kb = r / 64, nb = r % 64; transpose_item(F.in[I_WOUT] + (size_t)l * DM * DM, DM, DM, (bf16*)(F.ws + WS_WOUT) + (size_t)l * DM * DM, 64 * kb, 32 * nb, 32 * nb, scr, F.lane); }
        }
    }
    {
        const int gt = F.vcu * NWAVES * 64 + F.tid, NGT = F.G * NWAVES * 64;
        bf16* AUXB = (bf16*)(F.ws + WS_AUXB);
        for (int idx0 = gt; idx0 < DEPTH * 12 * 256 * 128; idx0 += 6 * NGT) {
            float vv[6];
#pragma unroll
            for (int u = 0; u < 6; ++u) { const int idx = idx0 + u * NGT; vv[u] = 0.f;
                if (idx < DEPTH * 12 * 256 * 128) { const int k = idx & 127, rr = (idx >> 7) & 255, q = (idx >> 15) % 12, l = idx / (12 * 256 * 128);
                    if (q < 8) { const int blk = q >> 1, dir = q & 1, gate = rr >> 7, e = rr & 127; vv[u] = F.in[I_RGGW][((((size_t)(l * 2 + dir) * 2 + gate) * 4 + blk) * 128 + k) * 128 + e]; }
                    else { const int g = q - 8; vv[u] = rr < 128 ? F.in[I_POOLW][(((size_t)l * 4 + g) * 128 + k) * 128 + rr] * F.in[I_POOLS][l * 512 + g * 128 + rr] : 0.f; } } }
#pragma unroll
            for (int u = 0; u < 6; ++u) { const int idx = idx0 + u * NGT; if (idx < DEPTH * 12 * 256 * 128) AUXB[idx] = (bf16)f2bf(vv[u]); }
        }
        float* SP8 = (float*)(F.ws + WS_WRT) + DEPTH * NROUTE * DM;
        for (int idx = gt; idx < DEPTH * 2 * 512; idx += NGT) SP8[idx] = 8.0f * 1.4426950408889634f * log1pf(__expf(-F.in[I_RGLAM][idx]));
        float* WRT = (float*)(F.ws + WS_WRT);
        for (int idx = gt; idx < DEPTH * NROUTE * DM; idx += NGT) {
            const int k = idx % DM, n = (idx / DM) % NROUTE, l = idx / (DM * NROUTE);
            WRT[idx] = n < 4 ? F.in[I_GRPW][((size_t)l * DM + k) * 4 + n] : F.in[I_EXPW][((size_t)l * DM + k) * 32 + (n - 4)];
        }
    }
}
struct CvtItem { const float* W; bf16* WT; int K, N, k0, n0, n0_out; };
constexpr int CVT_UPE = 32 * 8, CVT_DNE = 8 * 16;
constexpr int CVT_L = NEXP * (CVT_UPE + CVT_DNE);
__device__ __forceinline__ CvtItem moe_item(Frame& F, int it) {
    const int l = it / CVT_L; int r = it % CVT_L; CvtItem c;
    if (r < NEXP * CVT_UPE) { const int e = r / CVT_UPE, q = r % CVT_UPE, kb = q / 8, nb = q % 8; const int n0 = 128 * nb, half = n0 >> 9, jj = (n0 & 511) >> 7;
        c.W = F.in[I_UP] + ((size_t)l * NEXP + e) * DM * 1024; c.WT = (bf16*)(F.ws + WS_UP) + ((size_t)l * NEXP + e) * 1024 * DM; c.K = DM; c.N = 1024; c.k0 = 64 * kb; c.n0 = n0; c.n0_out = jj * 256 + half * 128; }
    else { r -= NEXP * CVT_UPE; const int e = r / CVT_DNE, q = r % CVT_DNE, kb = q / 16, nb = q % 16;
        c.W = F.in[I_DOWN] + ((size_t)l * NEXP + e) * DEXP * DM; c.WT = (bf16*)(F.ws + WS_DOWN) + ((size_t)l * NEXP + e) * DM * DEXP; c.K = DEXP; c.N = DM; c.k0 = 64 * kb; c.n0 = 128 * nb; c.n0_out = 128 * nb; }
    return c;
}
__device__ __forceinline__ void cvt_load(const CvtItem& c, v2u (&v)[32], int lane) {
    const float* p = c.W + (size_t)(c.k0 + (lane >> 5)) * c.N + c.n0 + 4 * (lane & 31); const size_t step = (size_t)2 * c.N;
    f32x4 t[32];
#pragma unroll
    for (int i = 0; i < 32; ++i) { t[i] = __builtin_nontemporal_load((const GAS f32x4*)p); p += step; asm volatile("" : "+v"(p)); }
#pragma unroll
    for (int i = 0; i < 32; ++i) { v[i].x = pk2_hw(t[i].x, t[i].y); v[i].y = pk2_hw(t[i].z, t[i].w); }
}
__device__ __forceinline__ void cvt_finish(const CvtItem& c, const v2u (&v)[32], LAS unsigned char* scr, int lane) {
    constexpr int PT = 264;
#pragma unroll
    for (int i = 0; i < 32; ++i) *(LAS v2u*)(scr + (2 * i + (lane >> 5)) * PT + 8 * (lane & 31)) = v[i];
    LDS_WAIT(); asm volatile("" ::: "memory");
#pragma unroll 4
    for (int q = 0; q < 16; ++q) { const int ci = lane + 64 * q, n = ci >> 3, cq = ci & 7; const LAS unsigned char* s = scr + (8 * cq) * PT + 2 * n;
        v4u o; o.x = (unsigned)*(const LAS unsigned short*)(s) | ((unsigned)*(const LAS unsigned short*)(s + PT) << 16); o.y = (unsigned)*(const LAS unsigned short*)(s + 2 * PT) | ((unsigned)*(const LAS unsigned short*)(s + 3 * PT) << 16);
        o.z = (unsigned)*(const LAS unsigned short*)(s + 4 * PT) | ((unsigned)*(const LAS unsigned short*)(s + 5 * PT) << 16); o.w = (unsigned)*(const LAS unsigned short*)(s + 6 * PT) | ((unsigned)*(const LAS unsigned short*)(s + 7 * PT) << 16);
        __builtin_nontemporal_store(o, (GAS v4u*)(c.WT + (size_t)(c.n0_out + n) * c.K + c.k0 + 8 * cq)); }
    LDS_WAIT(); asm volatile("" ::: "memory");
}
__device__ __forceinline__ void moe_convert_range(Frame& F, int lo, int hi, int rank, int nrank) {
    const int step = nrank * NWAVES;
    LAS unsigned char* scr = F.lds + F.wave * 16896;
    for (int it = lo + rank * NWAVES + F.wave; it < hi; it += step) {
        v2u va[32]; const CvtItem ca = moe_item(F, it); cvt_load(ca, va, F.lane); cvt_finish(ca, va, scr, F.lane);
    }
}
__device__ __forceinline__ void p0b_modreduce(Frame& F) {
    const int gt = F.vcu * NWAVES * 64 + F.tid, NGT = F.G * NWAVES * 64;
    const float* MODP = (const float*)(F.ws + WS_MODP); float* MOD = (float*)(F.ws + WS_MOD);
    for (int idx = gt; idx < DEPTH * 3 * NMODC; idx += NGT) {
        const int n = idx % NMODC, r = (idx / NMODC) % 3, l = idx / (3 * NMODC);
        float s = F.in[I_MODB][l * NMODC + n];
#pragma unroll
        for (int kc = 0; kc < KSPLIT; ++kc) s += MODP[((size_t)(l * KSPLIT + kc) * 3 + r) * NMODC + n];
        MOD[idx] = s;
    }
}
template <int MODE> __device__ __forceinline__ void phase_norm1(Frame& F, int l, float* out) {
    const int gw = F.vcu * NWAVES + F.wave, NGW = F.G * NWAVES;
    bf16* X = (bf16*)(F.ws + WS_X); bf16* H = (bf16*)(F.ws + WS_H); const bf16* YS = (const bf16*)(F.ws + WS_YS);
    const float* MOD = (const float*)(F.ws + WS_MOD); const int* slot = (const int*)(F.ws + WS_ROUTE) + RT_SLOT;
    for (int r = gw; r < T; r += NGW) {
        const int b = r / SEGB, i = r - b * SEGB; const bool isctx = i < NCTX; const int mrow = isctx ? 2 : b;
        if (MODE == 2 && isctx) continue;
        f32x4 v[8];
        if (MODE == 0) {
            const float* src = isctx ? F.in[I_CTX] + ((size_t)b * NCTX + i) * DM : F.in[I_X] + ((size_t)b * LSEQ + (i - NCTX)) * DM;
#pragma unroll
            for (int j = 0; j < 4; ++j) { const int c = 8 * (F.lane + 64 * j); v[2 * j] = *(const GAS f32x4*)(src + c); v[2 * j + 1] = *(const GAS f32x4*)(src + c + 4); }
        } else {
            const int lp = (MODE == 2) ? DEPTH - 1 : l - 1;
            const float* m5 = MOD + ((size_t)lp * 3 + mrow) * NMODC + 5 * DM;
            const int s1 = slot[2 * r], s2 = slot[2 * r + 1];
            const bf16* y1 = YS + (size_t)s1 * DM, *y2 = YS + (size_t)s2 * DM;
#pragma unroll
            for (int j = 0; j < 4; ++j) { const int c = 8 * (F.lane + 64 * j);
                const v4u xw = *(const GAS v4u*)(X + (size_t)r * DM + c), a = *(const GAS v4u*)(y1 + c), bb = *(const GAS v4u*)(y2 + c);
                const f32x4 g0 = *(const GAS f32x4*)(m5 + c), g1 = *(const GAS f32x4*)(m5 + c + 4);
                f32x4 x0, x1, ys0, ys1;
                x0.x = bflo(xw.x); x0.y = bfhi(xw.x); x0.z = bflo(xw.y); x0.w = bfhi(xw.y); x1.x = bflo(xw.z); x1.y = bfhi(xw.z); x1.z = bflo(xw.w); x1.w = bfhi(xw.w);
                ys0.x = bflo(a.x) + bflo(bb.x); ys0.y = bfhi(a.x) + bfhi(bb.x); ys0.z = bflo(a.y) + bflo(bb.y); ys0.w = bfhi(a.y) + bfhi(bb.y);
                ys1.x = bflo(a.z) + bflo(bb.z); ys1.y = bfhi(a.z) + bfhi(bb.z); ys1.z = bflo(a.w) + bflo(bb.w); ys1.w = bfhi(a.w) + bfhi(bb.w);
                v[2 * j] = x0 + g0 * ys0; v[2 * j + 1] = x1 + g1 * ys1; }
        }
        float ss = 0.f;
#pragma unroll
        for (int j = 0; j < 8; ++j) ss += (v[j].x * v[j].x + v[j].y * v[j].y) + (v[j].z * v[j].z + v[j].w * v[j].w);
        const float rstd = 1.0f / sqrtf(wave_sum(ss) * (1.0f / DM) + EPS);
        if (MODE == 2) {
            float* o = out + ((size_t)b * LSEQ + (i - NCTX)) * DM; const float* g = F.in[I_NFINAL];
#pragma unroll
            for (int j = 0; j < 4; ++j) { const int c = 8 * (F.lane + 64 * j); v[2 * j] = v[2 * j] * rstd * *(const GAS f32x4*)(g + c); v[2 * j + 1] = v[2 * j + 1] * rstd * *(const GAS f32x4*)(g + c + 4); }
#pragma unroll
            for (int j = 0; j < 4; ++j) { const int c = 8 * (F.lane + 64 * j); *(GAS f32x4*)(o + c) = v[2 * j]; *(GAS f32x4*)(o + c + 4) = v[2 * j + 1]; }
        } else {
            const float* g = F.in[I_NMIX] + (size_t)l * DM; const float* sh = MOD + ((size_t)l * 3 + mrow) * NMODC, *sc = sh + DM;
            v4u hw[4];
            f32x4 gg[8], cc[8], ss[8];
#pragma unroll
            for (int j = 0; j < 4; ++j) { const int c = 8 * (F.lane + 64 * j);
                gg[2 * j] = *(const GAS f32x4*)(g + c); gg[2 * j + 1] = *(const GAS f32x4*)(g + c + 4); cc[2 * j] = *(const GAS f32x4*)(sc + c); cc[2 * j + 1] = *(const GAS f32x4*)(sc + c + 4);
                ss[2 * j] = *(const GAS f32x4*)(sh + c); ss[2 * j + 1] = *(const GAS f32x4*)(sh + c + 4); }
            asm volatile("" : "+v"(gg[0]), "+v"(gg[7]), "+v"(cc[0]), "+v"(cc[7]), "+v"(ss[0]), "+v"(ss[7]));
#pragma unroll
            for (int j = 0; j < 4; ++j) {
                const f32x4 h0 = v[2 * j] * rstd * gg[2 * j] * (cc[2 * j] + 1.0f) + ss[2 * j];
                const f32x4 h1 = v[2 * j + 1] * rstd * gg[2 * j + 1] * (cc[2 * j + 1] + 1.0f) + ss[2 * j + 1];
                hw[j].x = pk2(h0.x, h0.y); hw[j].y = pk2(h0.z, h0.w); hw[j].z = pk2(h1.x, h1.y); hw[j].w = pk2(h1.z, h1.w); }
#pragma unroll
            for (int j = 0; j < 4; ++j) { const int c = 8 * (F.lane + 64 * j);
                if (MODE != 0) { v4u xw; xw.x = pk2(v[2 * j].x, v[2 * j].y); xw.y = pk2(v[2 * j].z, v[2 * j].w); xw.z = pk2(v[2 * j + 1].x, v[2 * j + 1].y); xw.w = pk2(v[2 * j + 1].z, v[2 * j + 1].w);
                    *(GAS v4u*)(X + (size_t)r * DM + c) = xw; }
                *(GAS v4u*)(H + (size_t)r * DM + c) = hw[j]; }
        }
    }
}
__device__ __forceinline__ void unpack8(const v4u w, float (&f)[8]) { f[0] = bflo(w.x); f[1] = bfhi(w.x); f[2] = bflo(w.y); f[3] = bfhi(w.y); f[4] = bflo(w.z); f[5] = bfhi(w.z); f[6] = bflo(w.w); f[7] = bfhi(w.w); }
__device__ __forceinline__ v4u pack8f(const float (&f)[8]) { v4u w; w.x = pk2(f[0], f[1]); w.y = pk2(f[2], f[3]); w.z = pk2(f[4], f[5]); w.w = pk2(f[6], f[7]); return w; }
__device__ __forceinline__ void phase_prep(Frame& F, int l) {
    const bf16* P = (const bf16*)(F.ws + WS_P); bf16* AUXA = (bf16*)(F.ws + WS_AUXA); bf16* YB = (bf16*)(F.ws + WS_YB);
    bf16* QP = (bf16*)(F.ws + WS_QP); bf16* KP = (bf16*)(F.ws + WS_KP); bf16* VT = (bf16*)(F.ws + WS_VT);
    const int tid = F.tid, lane = F.lane, cg = tid & 63, tw = tid >> 6;
    LAS unsigned char* vl = F.lds;
    constexpr int VP = 1040;
    for (int it = F.vcu; it < NBATCH * CH64 * 5; it += F.G) {
        const int u = it / 5, st = it - 5 * u;
        const int b = u / CH64, cj = u % CH64; const bool isctx = cj < 4;
        const int seg0 = b * SEGB + (isctx ? 0 : NCTX), seglen = isctx ? NCTX : LSEQ, s0 = (isctx ? cj : cj - 4) * 64;
        const int r0 = seg0 + s0;
        const v4u zero4 = {0u, 0u, 0u, 0u};
#define LDV(s, col) (((s) >= 0 && (s) < seglen) ? *(const GAS v4u*)(P + (size_t)(seg0 + (s)) * PIN + (col)) : zero4)
        if (st == 0) {
            const int c0 = 8 * cg, t0 = s0 + 8 * tw; float w0[8], w1[8], w2[8], w3[8], bs[8];
            const float* cw = F.in[I_RGCW] + (size_t)l * 4 * 512 + c0;
#pragma unroll
            for (int i = 0; i < 8; ++i) { w0[i] = cw[i]; w1[i] = cw[512 + i]; w2[i] = cw[1024 + i]; w3[i] = cw[1536 + i]; bs[i] = F.in[I_RGCB][l * 512 + c0 + i]; }
            float xa[8], xb[8], xc[8], xd[8]; v4u raw[11];
#pragma unroll
            for (int t = 0; t < 11; ++t) raw[t] = LDV(t0 - 2 + t, c0);
            unpack8(raw[0], xa); unpack8(raw[1], xb); unpack8(raw[2], xc);
            bf16* o = AUXA + ((size_t)(cg >> 4) * T + (r0 + 8 * tw)) * 128 + (cg & 15) * 8;
#pragma unroll
            for (int t = 0; t < 8; ++t) { unpack8(raw[t + 3], xd); float y[8];
#pragma unroll
                for (int i = 0; i < 8; ++i) { y[i] = bs[i] + w0[i] * xa[i] + w1[i] * xb[i] + w2[i] * xc[i] + w3[i] * xd[i]; xa[i] = xb[i]; xb[i] = xc[i]; xc[i] = xd[i]; }
                *(GAS v4u*)(o + (size_t)t * 128) = pack8f(y); }
        }
        if (st == 1) {
            const int c0 = 8 * cg; float w0[8], w1[8], w2[8];
            const float* sw = F.in[I_SCW] + (size_t)l * 3 * 512 + c0;
#pragma unroll
            for (int i = 0; i < 8; ++i) { w0[i] = sw[i]; w1[i] = sw[512 + i]; w2[i] = sw[1024 + i]; }
#pragma unroll 1
            for (int hf = 0; hf < 2; ++hf) {
                const int t0 = s0 + 8 * tw + 4 * hf; float za[8], zb[8], zc[8], p1[8], p2[8]; v4u rc[6], rx[6], rb[4];
#pragma unroll
                for (int t = 0; t < 6; ++t) { rc[t] = LDV(t0 - 1 + t, 1536 + c0); rx[t] = LDV(t0 - 1 + t, 2048 + c0); }
#pragma unroll
                for (int t = 0; t < 4; ++t) rb[t] = LDV(t0 + t, 1024 + c0);
                unpack8(rc[0], p1); unpack8(rx[0], p2);
#pragma unroll
                for (int i = 0; i < 8; ++i) za[i] = p1[i] * p2[i];
                unpack8(rc[1], p1); unpack8(rx[1], p2);
#pragma unroll
                for (int i = 0; i < 8; ++i) zb[i] = p1[i] * p2[i];
#pragma unroll
                for (int t = 0; t < 4; ++t) { unpack8(rc[t + 2], p1); unpack8(rx[t + 2], p2); float bb[8], y[8]; unpack8(rb[t], bb);
#pragma unroll
                    for (int i = 0; i < 8; ++i) { zc[i] = p1[i] * p2[i]; y[i] = bb[i] * (w0[i] * za[i] + w1[i] * zb[i] + w2[i] * zc[i]); za[i] = zb[i]; zb[i] = zc[i]; }
                    *(GAS v4u*)(YB + (size_t)(r0 + 8 * tw + 4 * hf + t) * DM + 512 + c0) = pack8f(y); }
            }
        }
        if (st == 2) {
            const int g = tw & 3, th = tw >> 2, hw = 1 << g, c0 = 2560 + g * 128 + 8 * (lane & 15), tl0 = 32 * th + 8 * (lane >> 4), t0 = s0 + tl0;
            float sum[8], xv[8];
#pragma unroll
            for (int i = 0; i < 8; ++i) sum[i] = 0.f;
            { v4u wv[16];
#pragma unroll
              for (int k = 0; k < 16; ++k) wv[k] = (k < 2 * hw) ? LDV(t0 - hw + k, c0) : zero4;
#pragma unroll
              for (int k = 0; k < 16; ++k) { unpack8(wv[k], xv);
#pragma unroll
                for (int i = 0; i < 8; ++i) sum[i] += xv[i]; } }
            bf16* o = AUXA + ((size_t)(4 + g) * T + (r0 + tl0)) * 128 + 8 * (lane & 15);
#pragma unroll 1
            for (int hf = 0; hf < 2; ++hf) {
            v4u rv[4], re[4], rl[4];
#pragma unroll
            for (int t = 0; t < 4; ++t) { rv[t] = LDV(t0 + 4 * hf + t, c0); re[t] = LDV(t0 + 4 * hf + t + hw, c0); rl[t] = LDV(t0 + 4 * hf + t - hw, c0); }
#pragma unroll
            for (int t = 0; t < 4; ++t) { const int s = t0 + 4 * hf + t; const int lo = s - hw < 0 ? 0 : s - hw, hi = s + hw > seglen ? seglen : s + hw; const float rc = 1.0f / (float)(hi - lo);
                float y[8], xe[8], xl[8]; unpack8(rv[t], xv); unpack8(re[t], xe); unpack8(rl[t], xl);
#pragma unroll
                for (int i = 0; i < 8; ++i) { y[i] = sum[i] * rc - xv[i]; sum[i] += xe[i] - xl[i]; }
                *(GAS v4u*)(o + (size_t)(4 * hf + t) * 128) = pack8f(y); }
            }
        }
        if (st == 3) {
            const int vec = tid & 127, tq = tid >> 7, which = vec >> 6, hc = (vec >> 3) & 7, dg = vec & 7, axis = dg >> 2, part = (dg >> 1) & 1, jj0 = (dg & 1) * 8;
            const int col = 3072 + 8 * vec, pcol = 3072 + 8 * (vec ^ 2);
            bf16* dst = (which ? KP : QP) + ((size_t)(b * 8 + hc) * SEGB + cj * 64 + 16 * tq) * 64 + 8 * dg;
            const float scl = which ? 1.0f : QSCALE; const float sgn = part ? 1.0f : -1.0f;
            float inv[8];
#pragma unroll
            for (int i = 0; i < 8; ++i) inv[i] = __builtin_amdgcn_exp2f(-(float)(jj0 + i) * (13.287712379549449f / 16.0f)) * 0.15915494309189535f;
            for (int tg = 0; tg < 16; tg += 8) {
            v4u ro[8], rp[8];
#pragma unroll
            for (int t = 0; t < 8; ++t) { ro[t] = *(const GAS v4u*)(P + (size_t)(r0 + 16 * tq + tg + t) * PIN + col); rp[t] = *(const GAS v4u*)(P + (size_t)(r0 + 16 * tq + tg + t) * PIN + pcol); }
#pragma unroll
            for (int t8 = 0; t8 < 8; ++t8) { const int t = tg + t8; const int tl = 16 * tq + t; float xo[8], xp[8], y[8];
                unpack8(ro[t8], xo); unpack8(rp[t8], xp);
                if (!isctx) { const float pos = (float)(axis ? ((s0 + tl) & 63) : ((s0 + tl) >> 6));
#pragma unroll
                    for (int i = 0; i < 8; ++i) { const float rev = pos * inv[i]; const float sn = __builtin_amdgcn_sinf(rev), cs = __builtin_amdgcn_cosf(rev); y[i] = (xo[i] * cs + sgn * xp[i] * sn) * scl; }
                } else {
#pragma unroll
                    for (int i = 0; i < 8; ++i) y[i] = xo[i] * scl;
                }
                *(GAS v4u*)(dst + (size_t)t * 64) = pack8f(y); }
            }
        }
        if (st == 4) {
            __syncthreads();
            v4u vr[8];
#pragma unroll
            for (int t = 0; t < 8; ++t) vr[t] = *(const GAS v4u*)(P + (size_t)(r0 + 8 * tw + t) * PIN + 4096 + 8 * cg);
#pragma unroll
            for (int t = 0; t < 8; ++t) *(LAS v4u*)(vl + (8 * tw + t) * VP + 16 * cg) = vr[t];
            __syncthreads();
            const int h = tid >> 7, e = tid & 127; unsigned w[32];
#pragma unroll
            for (int i = 0; i < 32; ++i) w[i] = 0u;
#pragma unroll
            for (int t = 0; t < 64; ++t) { const int q = t & 15, pq = (q & 3) | ((q & 4) << 1) | ((q & 8) >> 1); const int kvp = (t & 48) + pq;
                const unsigned v = *(const LAS unsigned short*)(vl + t * VP + 2 * tid); w[kvp >> 1] |= v << (16 * (kvp & 1)); }
            v4u* o = (v4u*)(VT + (((size_t)(b * 4 + h) * CH64 + cj) * 128 + e) * 64);
#pragma unroll
            for (int i = 0; i < 8; ++i) { v4u x; x.x = w[4 * i]; x.y = w[4 * i + 1]; x.z = w[4 * i + 2]; x.w = w[4 * i + 3]; o[i] = x; }
        }
#undef LDV
    }
    __syncthreads();
}
__device__ __forceinline__ void phase_scan1(Frame& F, int l) {
    const bf16* G = (const bf16*)(F.ws + WS_G); float* SUM = (float*)(F.ws + WS_SUM);
    const int ch = F.tid, blk = ch >> 7, e = ch & 127;
    for (int u = F.vcu; u < NBATCH * 2 * CH64; u += F.G) {
        const int cj = u % CH64, dir = (u / CH64) & 1, b = u / (2 * CH64); const int r0 = b * SEGB + cj * 64;
        const bf16* g = G + (size_t)r0 * DM + blk * 512 + dir * 256 + e;
        float h = 0.f, ls = 0.f;
        for (int tb = 0; tb < 64; tb += 32) {
            unsigned short ql[32], qx[32];
#pragma unroll
            for (int i = 0; i < 32; ++i) { const int tt = dir ? 63 - (tb + i) : tb + i; ql[i] = g[(size_t)tt * DM]; qx[i] = g[(size_t)tt * DM + 128]; }
#pragma unroll
            for (int i = 0; i < 32; ++i) { const float l2 = bf2f(ql[i]); h = __builtin_amdgcn_exp2f(l2) * h + bf2f(qx[i]); ls += l2; }
        }
        float* o = SUM + ((size_t)((b * 2 + dir) * CH64 + cj) * 2) * 512 + ch; o[0] = __builtin_amdgcn_exp2f(ls); o[512] = h;
    }
}
__device__ __forceinline__ void phase_scan2(Frame& F, int l) {
    { int* s2t = (int*)(F.ws + WS_ROUTE) + RT_S2T; for (int i = F.vcu * NWAVES * 64 + F.tid; i < SLOT_CAP; i += F.G * NWAVES * 64) s2t[i] = 0; }
    const bf16* G = (const bf16*)(F.ws + WS_G); const float* SUM = (const float*)(F.ws + WS_SUM);
    const bf16* P = (const bf16*)(F.ws + WS_P); bf16* YB = (bf16*)(F.ws + WS_YB);
    LAS float* HF = (LAS float*)F.lds;
    const int ch = F.tid, blk = ch >> 7, e = ch & 127;
    const bool skipctx = (l == DEPTH - 1);
    const int nun = skipctx ? NBATCH * (CH64 - 4) : NBATCH * CH64;
    for (int u = F.vcu; u < nun; u += F.G) {
        const int b = skipctx ? u / (CH64 - 4) : u / CH64, cj = skipctx ? 4 + u % (CH64 - 4) : u % CH64; const int r0 = b * SEGB + cj * 64;
        float hf = 0.f, hb = 0.f;
        { const float* S0 = SUM + ((size_t)((b * 2 + 0) * CH64) * 2) * 512 + ch; const float* S1 = SUM + ((size_t)((b * 2 + 1) * CH64) * 2) * 512 + ch;
          const int nf = cj, nb = cj < 4 ? 3 - cj : 135 - cj; const int nmax = nf > nb ? nf : nb;
          for (int p0 = 0; p0 < nmax; p0 += 32) {
              float fa[32], fb[32], ba[32], bb[32];
#pragma unroll
              for (int i = 0; i < 32; ++i) { const int pp = p0 + i; const bool vf = pp < nf, vb = pp < nb; const int p = pp < CH64 ? pp : CH64 - 1; const int cb = p < 4 ? 3 - p : 135 - p;
                  fa[i] = vf ? S0[(size_t)p * 1024] : 1.f; fb[i] = vf ? S0[(size_t)p * 1024 + 512] : 0.f;
                  ba[i] = vb ? S1[(size_t)cb * 1024] : 1.f; bb[i] = vb ? S1[(size_t)cb * 1024 + 512] : 0.f; }
#pragma unroll
              for (int i = 0; i < 32; ++i) { hf = fa[i] * hf + fb[i]; hb = ba[i] * hb + bb[i]; }
          } }
        __syncthreads();
        const bf16* gf = G + (size_t)r0 * DM + blk * 512 + e; const bf16* gb = gf + 256;
        for (int tb = 0; tb < 64; tb += 32) {
            unsigned short fl[32], fx[32];
#pragma unroll
            for (int i = 0; i < 32; ++i) { fl[i] = gf[(size_t)(tb + i) * DM]; fx[i] = gf[(size_t)(tb + i) * DM + 128]; }
#pragma unroll
            for (int i = 0; i < 32; ++i) { hf = __builtin_amdgcn_exp2f(bf2f(fl[i])) * hf + bf2f(fx[i]); HF[(tb + i) * 512 + ch] = hf; }
        }
        for (int tb = 32; tb >= 0; tb -= 32) {
            unsigned short ql[32], qb[32], qa[32];
#pragma unroll
            for (int i = 0; i < 32; ++i) { ql[i] = gb[(size_t)(tb + i) * DM]; qb[i] = gb[(size_t)(tb + i) * DM + 128]; qa[i] = P[(size_t)(r0 + tb + i) * PIN + 512 + ch]; }
#pragma unroll
            for (int i = 31; i >= 0; --i) { hb = __builtin_amdgcn_exp2f(bf2f(ql[i])) * hb + bf2f(qb[i]);
                YB[(size_t)(r0 + tb + i) * DM + ch] = (bf16)f2bf(gelu_tanh(bf2f(qa[i])) * (HF[(tb + i) * 512 + ch] + hb)); }
        }
    }
    __syncthreads();
}

namespace att {
#ifndef ATT_BIG
#define ATT_BIG 16777216.0f
#endif
constexpr int SLOT = 65536, K1_OFF = 16384, V_OFF = 32768;
static_assert(2 * SLOT <= RING_BYTES, "attention LDS");
__device__ __forceinline__ bf16x8 pack8(const f32x16& p, int o) {
    v4u w; w.x = pg8::cvt_pk_bf16(p[o], p[o + 1]); w.y = pg8::cvt_pk_bf16(p[o + 2], p[o + 3]); w.z = pg8::cvt_pk_bf16(p[o + 4], p[o + 5]); w.w = pg8::cvt_pk_bf16(p[o + 6], p[o + 7]);
    return __builtin_bit_cast(bf16x8, w);
}
__device__ __forceinline__ void glds16(const void* sbase, unsigned voff, unsigned lds_dst) { unsigned keep;
    asm volatile("s_mov_b32 %0, m0\n\ts_mov_b32 m0, %3\n\ts_nop 0\n\tglobal_load_lds_dwordx4 %1, %2\n\ts_mov_b32 m0, %0" : "=&s"(keep) : "v"(voff), "s"(sbase), "s"(lds_dst) : "memory"); }
__device__ __forceinline__ float fadd_s(float a, float b) { float r; asm("v_add_f32_e32 %0, %1, %2" : "=v"(r) : "v"(a), "v"(b)); return r; }
__device__ __forceinline__ float max3f(float a, float b, float c) { float r; asm("v_max3_f32 %0, %1, %2, %3" : "=v"(r) : "v"(a), "v"(b), "v"(c)); return r; }
__device__ __forceinline__ float xhalf_max(float m) { auto rr = __builtin_amdgcn_permlane32_swap(__float_as_uint(m), __float_as_uint(m), false, false); return fmaxf(__uint_as_float(rr[0]), __uint_as_float(rr[1])); }
__device__ __forceinline__ float xhalf_sum(float m) { auto rr = __builtin_amdgcn_permlane32_swap(__float_as_uint(m), __float_as_uint(m), false, false); return __uint_as_float(rr[0]) + __uint_as_float(rr[1]); }
__device__ __forceinline__ float max16(const f32x16& p) {
    float a = max3f(p[0], p[1], p[2]), b = max3f(p[3], p[4], p[5]), c = max3f(p[6], p[7], p[8]), d = max3f(p[9], p[10], p[11]);
    a = max3f(a, p[12], p[13]); b = max3f(b, p[14], p[15]); c = fmaxf(c, d); return max3f(a, b, c);
}
}
template <int AB> __device__ __forceinline__ void phase_attn(Frame& F, int l) {
    using namespace att;
    const bf16* QP = (const bf16*)(F.ws + WS_QP); const bf16* KP = (const bf16*)(F.ws + WS_KP); const bf16* VT = (const bf16*)(F.ws + WS_VT); bf16* YB = (bf16*)(F.ws + WS_YB);
    const int lane = F.lane, r32 = lane & 31, hi = lane >> 5, wave = F.wave, c = wave >> 2, g = wave & 3;
    const float lam_init = 0.8f - 0.6f * __expf(-0.3f * (float)l);
    float lam;
    { const float* lp = F.in[I_DALAM] + (size_t)l * 256; const float s01 = wave_sum(lp[lane] * lp[64 + lane]), s23 = wave_sum(lp[128 + lane] * lp[192 + lane]); lam = __expf(s01) - __expf(s23) + lam_init; }
    const float* dan = F.in[I_DANORM] + (size_t)l * 128;
    LAS unsigned char* lds = F.lds; const unsigned lds0 = (unsigned)(size_t)lds;
    int foff[4];
#pragma unroll
    for (int s = 0; s < 4; ++s) foff[s] = r32 * 128 + (((2 * s + hi) ^ ((r32 >> 1) & 7)) << 4);
    constexpr int NLAT = NBATCH * 4 * (LSEQ / 128);
    constexpr int NU = NLAT + NBATCH * 4 * 2;
    const int conv_slot = F.vcu % 3; bool conv_done = false;
    const int gsz = F.G;
    const int cv_lo0 = l * CVT_L;
    for (int it = 0;; ++it) {
        if (it == conv_slot) { __syncthreads(); moe_convert_range(F, cv_lo0, cv_lo0 + CVT_L, F.vcu, F.G); __syncthreads(); conv_done = true; }
        int bh, qb, i0, nt;
        if (gsz == 256) {
            if (it < 2) { bh = F.vcu >> 5; qb = (F.vcu & 31) + 32 * it; i0 = NCTX + qb * 128; nt = SEGB / 128; }
            else if (it == 2 && F.vcu < 16 && l < DEPTH - 1) { bh = F.vcu >> 1; qb = F.vcu & 1; i0 = qb * 128; nt = NCTX / 128; }
            else break;
        } else {
            const int u = it * gsz + F.vcu; if (u >= NU) break;
            if (u < NLAT) { bh = u >> 6; qb = u & 63; i0 = NCTX + qb * 128; nt = SEGB / 128; } else { const int v = u - NLAT; bh = v >> 1; qb = v & 1; i0 = qb * 128; nt = NCTX / 128; }
        }
        const int b = bh >> 2, h = bh & 3;
        bf16x8 qf[4];
        { const bf16* qrow = QP + ((size_t)(bh * 2 + c) * SEGB + i0 + g * 32 + r32) * 64 + 8 * hi;
#pragma unroll
          for (int s = 0; s < 4; ++s) qf[s] = *(const GAS bf16x8*)(qrow + 16 * s); }
        unsigned voff[8];
#pragma unroll
        for (int q = 0; q < 8; ++q) { const int pp = (wave * 8 + q) & 15; const int row = 8 * pp + (lane >> 3), ch = (lane & 7) ^ ((row >> 1) & 7); voff[q] = (unsigned)(row * 128 + ch * 16); }
        const char* kbase0 = (const char*)(KP + (size_t)(bh * 2) * SEGB * 64); const char* vbase0 = (const char*)(VT + (size_t)bh * CH64 * 8192);
        const int reg = wave >> 1;
        const char* rbase = reg >= 2 ? vbase0 + (reg - 2) * 16384 : kbase0 + (size_t)reg * SEGB * 128;
        const unsigned dst0 = lds0 + reg * 16384 + ((wave * 8) & 15) * 1024;
        const int rstride = reg >= 2 ? 32768 : 16384;
#define ATT_DMA(jt) do { const char* sb_ = rbase + (size_t)(jt) * rstride; const unsigned d_ = dst0 + ((jt) & 1) * SLOT; _Pragma("unroll") for (int q_ = 0; q_ < 8; ++q_) \
            glds16(sb_, voff[q_], (unsigned)__builtin_amdgcn_readfirstlane((int)(d_ + q_ * 1024))); } while (0)
        f32x16 o0 = {}, o1 = {}, o2 = {}, o3 = {}, negm = {};
        float mref = 0.f, lsum = 0.f;
        VM_WAIT();
        asm volatile("" : "+v"(qf[0]), "+v"(qf[1]), "+v"(qf[2]), "+v"(qf[3]));
        ATT_DMA(0);
#define ATT_PVH(oa, ob, base_, pa, pb, pc, pd) do { bf16x8 vf_[8]; __builtin_amdgcn_sched_barrier(0); \
            _Pragma("unroll") for (int i_ = 0; i_ < 8; ++i_) vf_[i_] = *(const LAS bf16x8*)((base_) + (i_ >> 2) * 4096 + foff[i_ & 3]);         \
            __builtin_amdgcn_sched_barrier(0); \
            oa = __builtin_amdgcn_mfma_f32_32x32x16_bf16(vf_[0], pa, oa, 0, 0, 0); ob = __builtin_amdgcn_mfma_f32_32x32x16_bf16(vf_[4], pa, ob, 0, 0, 0); \
            oa = __builtin_amdgcn_mfma_f32_32x32x16_bf16(vf_[1], pb, oa, 0, 0, 0); ob = __builtin_amdgcn_mfma_f32_32x32x16_bf16(vf_[5], pb, ob, 0, 0, 0); \
            oa = __builtin_amdgcn_mfma_f32_32x32x16_bf16(vf_[2], pc, oa, 0, 0, 0); ob = __builtin_amdgcn_mfma_f32_32x32x16_bf16(vf_[6], pc, ob, 0, 0, 0); \
            oa = __builtin_amdgcn_mfma_f32_32x32x16_bf16(vf_[3], pd, oa, 0, 0, 0); ob = __builtin_amdgcn_mfma_f32_32x32x16_bf16(vf_[7], pd, ob, 0, 0, 0); \
            __builtin_amdgcn_sched_barrier(0); } while (0)
        for (int j = 0; j < nt; ++j) {
            asm volatile("s_waitcnt vmcnt(0)" ::: "memory");
            __builtin_amdgcn_s_barrier(); asm volatile("" ::: "memory");
            if (j + 1 < nt) ATT_DMA(j + 1);
            if ((AB & 64) && c == 1) continue;
            const LAS unsigned char* st = lds + (j & 1) * SLOT;
            const LAS unsigned char* kb = st + c * K1_OFF;
            f32x16 p0, p1, p2, p3;
#define ATT_QK(pa, kbase_) do { bf16x8 ka[4]; __builtin_amdgcn_sched_barrier(0); \
              _Pragma("unroll") for (int s_ = 0; s_ < 4; ++s_) ka[s_] = *(const LAS bf16x8*)((kbase_) + foff[s_]); \
              __builtin_amdgcn_sched_barrier(0); \
              pa = negm; \
              _Pragma("unroll") for (int s_ = 0; s_ < 4; ++s_) pa = __builtin_amdgcn_mfma_f32_32x32x16_bf16(ka[s_], qf[s_], pa, 0, 0, 0); \
              __builtin_amdgcn_sched_barrier(0); } while (0)
#define ATT_QK4() do { ATT_QK(p0, kb); ATT_QK(p1, kb + 4096); ATT_QK(p2, kb + 8192); ATT_QK(p3, kb + 12288); } while (0)
#define ATT_RAISE(first) do { asm volatile("s_nop 15\n\ts_nop 7" : "+v"(p0), "+v"(p1), "+v"(p2), "+v"(p3));     \
              const float mx_ = xhalf_max(fmaxf(fmaxf(max16(p0), max16(p1)), fmaxf(max16(p2), max16(p3)))); \
              const float dl_ = (first) ? mx_ : fmaxf(mx_, 0.f); mref += dl_; const float f_ = (first) ? 0.f : __builtin_amdgcn_exp2f(-dl_); lsum *= f_; \
              _Pragma("unroll") for (int r_ = 0; r_ < 16; ++r_) { p0[r_] -= dl_; p1[r_] -= dl_; p2[r_] -= dl_; p3[r_] -= dl_; o0[r_] *= f_; o1[r_] *= f_; o2[r_] *= f_; o3[r_] *= f_; negm[r_] = -mref; } } while (0)
#define ATT_EXPSUM() do {   \
              _Pragma("unroll") for (int r_ = 0; r_ < 16; ++r_) p0[r_] = __builtin_amdgcn_exp2f(p0[r_]); __builtin_amdgcn_sched_barrier(0); \
              _Pragma("unroll") for (int r_ = 0; r_ < 16; ++r_) p1[r_] = __builtin_amdgcn_exp2f(p1[r_]); __builtin_amdgcn_sched_barrier(0); \
              _Pragma("unroll") for (int r_ = 0; r_ < 16; ++r_) p2[r_] = __builtin_amdgcn_exp2f(p2[r_]); __builtin_amdgcn_sched_barrier(0); \
              _Pragma("unroll") for (int r_ = 0; r_ < 16; ++r_) p3[r_] = __builtin_amdgcn_exp2f(p3[r_]); \
              __builtin_amdgcn_sched_barrier(0); asm volatile("s_nop 0"); __builtin_amdgcn_sched_barrier(0);       \
              float sa_ = p0[0], sb_ = p1[0], sc_ = p2[0], sd_ = p3[0];         \
              _Pragma("unroll") for (int r_ = 1; r_ < 16; ++r_) { sa_ = fadd_s(sa_, p0[r_]); sb_ = fadd_s(sb_, p1[r_]); sc_ = fadd_s(sc_, p2[r_]); sd_ = fadd_s(sd_, p3[r_]); } \
              ts = fadd_s(fadd_s(sa_, sb_), fadd_s(sc_, sd_)); } while (0)
            ATT_QK4();
            float ts;
            if (j == 0) ATT_RAISE(true);
            ATT_EXPSUM();
            if (__any(!(ts < ATT_BIG))) { ATT_QK4(); ATT_RAISE(false); ATT_EXPSUM(); }
            lsum += ts;
#undef ATT_QK4
#undef ATT_RAISE
#undef ATT_EXPSUM
#undef ATT_QK
            const bf16x8 pa0 = pack8(p0, 0), pa1 = pack8(p0, 8), pa2 = pack8(p1, 0), pa3 = pack8(p1, 8), pb0 = pack8(p2, 0), pb1 = pack8(p2, 8), pb2 = pack8(p3, 0), pb3 = pack8(p3, 8);
            const LAS unsigned char* vb = st + V_OFF;
            ATT_PVH(o0, o1, vb, pa0, pa1, pa2, pa3); ATT_PVH(o2, o3, vb + 8192, pa0, pa1, pa2, pa3);
            ATT_PVH(o0, o1, vb + 16384, pb0, pb1, pb2, pb3); ATT_PVH(o2, o3, vb + 16384 + 8192, pb0, pb1, pb2, pb3);
        }
#undef ATT_PVH
#undef ATT_DMA
        LDS_WAIT(); __builtin_amdgcn_s_barrier(); asm volatile("" ::: "memory");
        lsum = xhalf_sum(lsum);
        const float inv = 1.0f / lsum;
        LAS float* xch = (LAS float*)lds + g * 4096 + lane;
        if (c == 1) {
            const float f = inv * lam;
#pragma unroll
            for (int r = 0; r < 16; ++r) { xch[(0 * 16 + r) * 64] = o0[r] * f; xch[(1 * 16 + r) * 64] = o1[r] * f; xch[(2 * 16 + r) * 64] = o2[r] * f; xch[(3 * 16 + r) * 64] = o3[r] * f; }
        }
        __syncthreads();
        if (c == 0) {
            float ss = 0.f;
#pragma unroll
            for (int r = 0; r < 16; ++r) { o0[r] = o0[r] * inv - xch[(0 * 16 + r) * 64]; o1[r] = o1[r] * inv - xch[(1 * 16 + r) * 64]; o2[r] = o2[r] * inv - xch[(2 * 16 + r) * 64]; o3[r] = o3[r] * inv - xch[(3 * 16 + r) * 64];
                ss += (o0[r] * o0[r] + o1[r] * o1[r]) + (o2[r] * o2[r] + o3[r] * o3[r]); }
            ss = xhalf_sum(ss);
            const float rs = (1.0f / sqrtf(ss * (1.0f / 128.0f) + EPS)) * (1.0f - lam_init);
            bf16* orow = YB + (size_t)(b * SEGB + i0 + g * 32 + r32) * DM + 1536 + h * 128 + 4 * hi;
            v2u ow[16];
#define ATT_ST(oacc, db) do { _Pragma("unroll") for (int rq = 0; rq < 4; ++rq) { const int d0 = (db) * 32 + 8 * rq + 4 * hi; const f32x4 nv = *(const GAS f32x4*)(dan + d0); \
                ow[(db) * 4 + rq].x = pk2(oacc[4 * rq] * rs * nv.x, oacc[4 * rq + 1] * rs * nv.y); ow[(db) * 4 + rq].y = pk2(oacc[4 * rq + 2] * rs * nv.z, oacc[4 * rq + 3] * rs * nv.w); } } while (0)
            ATT_ST(o0, 0); ATT_ST(o1, 1); ATT_ST(o2, 2); ATT_ST(o3, 3);
#undef ATT_ST
#pragma unroll
            for (int k = 0; k < 16; ++k) *(GAS v2u*)(orow + (k >> 2) * 32 + 8 * (k & 3)) = ow[k];
        }
        __syncthreads();
    }
    if (conv_slot >= 0 && !conv_done) { __syncthreads(); moe_convert_range(F, cv_lo0, cv_lo0 + CVT_L, F.vcu, F.G); __syncthreads(); }
}
constexpr size_t WQ_ELEMS = (size_t)DEPTH * 3 * 48 * DM;
__device__ __forceinline__ void router_tables(Frame& F) {
    bf16* WQH = (bf16*)(F.ws + WS_MODP); bf16* WQL = WQH + WQ_ELEMS; float* CC = (float*)(WQL + WQ_ELEMS);
    const float* MOD = (const float*)(F.ws + WS_MOD); const float* WRT = (const float*)(F.ws + WS_WRT);
    const int gt = F.vcu * NWAVES * 64 + F.tid, NGT = F.G * NWAVES * 64;
    for (int idx0 = gt; idx0 < (int)WQ_ELEMS; idx0 += 5 * NGT) {
        float wv[5];
#pragma unroll
        for (int q = 0; q < 5; ++q) { const int idx = idx0 + q * NGT; wv[q] = 0.f;
            if (idx < (int)WQ_ELEMS) { const int k = idx % DM, n = (idx / DM) % 48, mr = (idx / (DM * 48)) % 3, l = idx / (DM * 48 * 3);
                if (n < NROUTE) { const float a = F.in[I_NFFN][l * DM + k] * (1.0f + MOD[((size_t)l * 3 + mr) * NMODC + 4 * DM + k]); wv[q] = a * WRT[((size_t)l * NROUTE + n) * DM + k]; } } }
#pragma unroll
        for (int q = 0; q < 5; ++q) { const int idx = idx0 + q * NGT;
            if (idx < (int)WQ_ELEMS) { const float w = wv[q]; const unsigned h = f2bf(w); const float rem = w - bf2f(h); WQH[idx] = (bf16)h; WQL[idx] = (bf16)f2bf(rem); } }
    }
    const int gw = F.vcu * NWAVES + F.wave, NGW = F.G * NWAVES;
    for (int it = gw; it < DEPTH * 3 * NROUTE; it += NGW) {
        const int n = it % NROUTE, mr = (it / NROUTE) % 3, l = it / (NROUTE * 3); float sacc = 0.f;
        { float ma[32], wa[32];
#pragma unroll
          for (int q = 0; q < 32; ++q) { const int k = F.lane + 64 * q; ma[q] = MOD[((size_t)l * 3 + mr) * NMODC + 3 * DM + k]; wa[q] = WRT[((size_t)l * NROUTE + n) * DM + k]; }
#pragma unroll
          for (int q = 0; q < 32; ++q) sacc += ma[q] * wa[q]; }
        sacc = wave_sum(sacc);
        if (F.lane == 0) CC[it] = sacc + (n < 4 ? F.in[I_GRPB][l * 4 + n] : F.in[I_EXPB][l * 32 + n - 4]);
    }
}
__device__ __forceinline__ void phase_norm2_router(Frame& F, int l, int part, int dummy = 0) {
    typedef float f32x4_ __attribute__((ext_vector_type(4)));
    const bf16* X = (const bf16*)(F.ws + WS_X); const float* MOD = (const float*)(F.ws + WS_MOD);
    const bf16* WQH = (const bf16*)(F.ws + WS_MODP); const bf16* WQL = WQH + WQ_ELEMS; const float* CC = (const float*)(WQL + WQ_ELEMS);
    int* RT = (int*)(F.ws + WS_ROUTE) + (dummy ? RT_WSLOT + SLOT_CAP : 0); unsigned* cnt = (unsigned*)(F.ws + WS_CTL) + CW_CNT + l * 64 + (dummy ? 4096 : 0);
    LAS float* PART = (LAS float*)F.lds;
    LAS float* SSQ = PART + 8 * 12 * 64;
    LAS float* LGT = SSQ + 8 * 16;
    LAS float* RSTD = LGT + 16 * 40;
    LAS int* SLT = (LAS int*)(RSTD + 16);
    bf16* HS = (bf16*)(F.ws + WS_HS); unsigned* moe = (unsigned*)(F.ws + WS_CTL) + CW_MOE + l * CW_MOE_L + (dummy ? 2048 : 0);
    const float* gn = F.in[I_NFFN] + (size_t)l * DM;
    const int lane = F.lane, wave = F.wave, m16 = lane & 15, kg = lane >> 4;
    const int ntile = part == 0 ? T / 16 : part == 2 ? NBATCH * NCTX / 16 : NBATCH * LSEQ / 16;
    const int cu = (part == 1 || part == 2) ? F.vcu - 16 : F.vcu, ncu = part == 1 ? F.G - 16 : part == 2 ? 32 : F.G;
    const int t0 = (int)(((long)ntile * cu) / ncu), t1 = (int)(((long)ntile * (cu + 1)) / ncu);
#define RT_SYNC() do { LDS_WAIT(); __builtin_amdgcn_s_barrier(); asm volatile("" ::: "memory"); } while (0)
#define RT_ROW0(tl_) (part == 0 ? (tl_) * 16 : part == 2 ? ((tl_) / (NCTX / 16)) * SEGB + ((tl_) % (NCTX / 16)) * 16 : ((tl_) / (LSEQ / 16)) * SEGB + NCTX + ((tl_) % (LSEQ / 16)) * 16)
#define RT_LOAD(xx, hh, ll, kb, xr_, wh_, wl_) do { _Pragma("unroll") for (int s_ = 0; s_ < 2; ++s_) { xx[s_] = *(const GAS bf16x8*)((xr_) + 32 * ((kb) * 2 + s_)); \
            _Pragma("unroll") for (int nt_ = 0; nt_ < 3; ++nt_) { hh[3 * s_ + nt_] = *(const GAS bf16x8*)((wh_) + (size_t)nt_ * 16 * DM + 32 * ((kb) * 2 + s_)); ll[3 * s_ + nt_] = *(const GAS bf16x8*)((wl_) + (size_t)nt_ * 16 * DM + 32 * ((kb) * 2 + s_)); } } } while (0)
#define RT_MMA(xx, hh, ll) do { _Pragma("unroll") for (int s_ = 0; s_ < 2; ++s_) { const bf16x8 xh_ = xx[s_]; const v4u xw_ = __builtin_bit_cast(v4u, xh_); \
            ssq += (bflo(xw_.x) * bflo(xw_.x) + bfhi(xw_.x) * bfhi(xw_.x)) + (bflo(xw_.y) * bflo(xw_.y) + bfhi(xw_.y) * bfhi(xw_.y)) + (bflo(xw_.z) * bflo(xw_.z) + bfhi(xw_.z) * bfhi(xw_.z)) + (bflo(xw_.w) * bflo(xw_.w) + bfhi(xw_.w) * bfhi(xw_.w)); \
            acc0 = __builtin_amdgcn_mfma_f32_16x16x32_bf16(xh_, hh[3 * s_], acc0, 0, 0, 0); acc1 = __builtin_amdgcn_mfma_f32_16x16x32_bf16(xh_, hh[3 * s_ + 1], acc1, 0, 0, 0); acc2 = __builtin_amdgcn_mfma_f32_16x16x32_bf16(xh_, hh[3 * s_ + 2], acc2, 0, 0, 0); \
            acc0 = __builtin_amdgcn_mfma_f32_16x16x32_bf16(xh_, ll[3 * s_], acc0, 0, 0, 0); acc1 = __builtin_amdgcn_mfma_f32_16x16x32_bf16(xh_, ll[3 * s_ + 1], acc1, 0, 0, 0); acc2 = __builtin_amdgcn_mfma_f32_16x16x32_bf16(xh_, ll[3 * s_ + 2], acc2, 0, 0, 0); } } while (0)
    bf16x8 xa[2], xb[2]; bf16x8 ha[6], la[6], hb[6], lb[6];
    const bf16* xr = X, *wh = WQH, *wl = WQL;
    if (t0 < t1) { const int r0_ = RT_ROW0(t0), mr_ = mod_row(r0_);
        xr = X + (size_t)(r0_ + m16) * DM + 256 * wave + 8 * kg; wh = WQH + ((size_t)(l * 3 + mr_) * 48 + m16) * DM + 256 * wave + 8 * kg; wl = WQL + ((size_t)(l * 3 + mr_) * 48 + m16) * DM + 256 * wave + 8 * kg;
        RT_LOAD(xa, ha, la, 0, xr, wh, wl); RT_LOAD(xb, hb, lb, 1, xr, wh, wl); }
    for (int tl = t0; tl < t1; ++tl) {
        const int r0 = RT_ROW0(tl);
        const int mrow = mod_row(r0);
        f32x4_ acc0 = {0.f, 0.f, 0.f, 0.f}, acc1 = acc0, acc2 = acc0; float ssq = 0.f;
        __builtin_amdgcn_sched_barrier(0);
        RT_MMA(xa, ha, la); __builtin_amdgcn_sched_barrier(0); RT_LOAD(xa, ha, la, 2, xr, wh, wl); __builtin_amdgcn_sched_barrier(0);
        RT_MMA(xb, hb, lb); __builtin_amdgcn_sched_barrier(0); RT_LOAD(xb, hb, lb, 3, xr, wh, wl); __builtin_amdgcn_sched_barrier(0);
        RT_MMA(xa, ha, la); __builtin_amdgcn_sched_barrier(0);
        RT_MMA(xb, hb, lb); __builtin_amdgcn_sched_barrier(0);
        if (tl + 1 < t1) { const int r0_ = RT_ROW0(tl + 1), mr_ = mod_row(r0_);
            xr = X + (size_t)(r0_ + m16) * DM + 256 * wave + 8 * kg; wh = WQH + ((size_t)(l * 3 + mr_) * 48 + m16) * DM + 256 * wave + 8 * kg; wl = WQL + ((size_t)(l * 3 + mr_) * 48 + m16) * DM + 256 * wave + 8 * kg;
            RT_LOAD(xa, ha, la, 0, xr, wh, wl); RT_LOAD(xb, hb, lb, 1, xr, wh, wl); }
        __builtin_amdgcn_sched_barrier(0);
        { const int ln_ = fresh_lane(); ssq += __builtin_bit_cast(float, __builtin_amdgcn_ds_bpermute((ln_ ^ 16) << 2, __builtin_bit_cast(int, ssq))); ssq += __builtin_bit_cast(float, __builtin_amdgcn_ds_bpermute((ln_ ^ 32) << 2, __builtin_bit_cast(int, ssq))); }
        RT_SYNC();
#pragma unroll
        for (int r = 0; r < 4; ++r) { PART[(wave * 12 + 0 + r) * 64 + lane] = acc0[r]; PART[(wave * 12 + 4 + r) * 64 + lane] = acc1[r]; PART[(wave * 12 + 8 + r) * 64 + lane] = acc2[r]; }
        if (kg == 0) SSQ[wave * 16 + m16] = ssq;
        RT_SYNC();
        if (F.tid < 16) { float s = 0.f;
#pragma unroll
            for (int w = 0; w < 8; ++w) s += SSQ[w * 16 + F.tid];
            RSTD[F.tid] = 1.0f / sqrtf(s * (1.0f / DM) + EPS); }
        RT_SYNC();
        for (int e = F.tid; e < 16 * NROUTE; e += NWAVES * 64) { const int row = e / NROUTE, n = e % NROUTE; const int nt = n >> 4, col = n & 15, ln = col + 16 * (row >> 2), rg = row & 3; float s = 0.f;
#pragma unroll
            for (int w = 0; w < 8; ++w) s += PART[(w * 12 + nt * 4 + rg) * 64 + ln];
            LGT[row * 40 + n] = s * RSTD[row] + CC[(l * 3 + mrow) * NROUTE + n]; }
        RT_SYNC();
        if (F.tid < 16) { const int r = r0 + F.tid; const LAS float* lgp = LGT + F.tid * 40;
            float lg[4];
#pragma unroll
            for (int n = 0; n < 4; ++n) lg[n] = lgp[n];
            int gi = 0; float gm = lg[0];
#pragma unroll
            for (int n = 1; n < 4; ++n) if (lg[n] > gm) { gm = lg[n]; gi = n; }
            float den = 0.f;
#pragma unroll
            for (int n = 0; n < 4; ++n) den += __expf(lg[n] - gm);
            const float gw = 1.0f / den;
            float el[8];
#pragma unroll
            for (int j = 0; j < 8; ++j) el[j] = lgp[4 + gi * 8 + j];
            int i1 = 0; float v1 = el[0];
#pragma unroll
            for (int j = 1; j < 8; ++j) if (el[j] > v1) { v1 = el[j]; i1 = j; }
            int i2 = -1; float v2 = -3.0e38f;
#pragma unroll
            for (int j = 0; j < 8; ++j) if (j != i1 && el[j] > v2) { v2 = el[j]; i2 = j; }
            if (i2 < 0) i2 = (i1 + 1) & 7;
            const float ex = __expf(v2 - v1), w1 = gw / (1.0f + ex), w2 = gw * ex / (1.0f + ex);
            const int e1 = gi * 8 + i1, e2 = gi * 8 + i2;
            const unsigned p1 = __hip_atomic_fetch_add(cnt + e1, 1u, RLX_AGENT), p2 = __hip_atomic_fetch_add(cnt + e2, 1u, RLX_AGENT);
            if ((p1 & 255u) == 0u) { const unsigned t = __hip_atomic_fetch_add(moe + MOE_NT, 1u, RLX_AGENT); __hip_atomic_store(moe + MOE_TILE_E + t, (unsigned)e1, RLX_AGENT); __hip_atomic_store(moe + MOE_TMAP + e1 * TMAP_STRIDE + (p1 >> 8), t + 1u, RLX_AGENT); }
            if ((p2 & 255u) == 0u) { const unsigned t = __hip_atomic_fetch_add(moe + MOE_NT, 1u, RLX_AGENT); __hip_atomic_store(moe + MOE_TILE_E + t, (unsigned)e2, RLX_AGENT); __hip_atomic_store(moe + MOE_TMAP + e2 * TMAP_STRIDE + (p2 >> 8), t + 1u, RLX_AGENT); }
            unsigned t1 = 0u, t2 = 0u;
            for (unsigned sp = 0; sp < (1u << 22); ++sp) { if (!t1) t1 = __hip_atomic_load(moe + MOE_TMAP + e1 * TMAP_STRIDE + (p1 >> 8), RLX_AGENT); if (!t2) t2 = __hip_atomic_load(moe + MOE_TMAP + e2 * TMAP_STRIDE + (p2 >> 8), RLX_AGENT); if (t1 && t2) break; __builtin_amdgcn_s_sleep(1); }
            if (!t1) t1 = 1u; if (!t2) t2 = 1u;
            const int s1 = (int)((t1 - 1u) * 256u + (p1 & 255u)), s2 = (int)((t2 - 1u) * 256u + (p2 & 255u));
            RT[RT_SLOT + 2 * r] = s1; RT[RT_SLOT + 2 * r + 1] = s2; ((float*)RT)[RT_WSLOT + s1] = w1; ((float*)RT)[RT_WSLOT + s2] = w2; RT[RT_S2T + s1] = r; RT[RT_S2T + s2] = r;
            SLT[2 * F.tid] = s1; SLT[2 * F.tid + 1] = s2; }
        RT_SYNC();
        { const float* sh = MOD + ((size_t)l * 3 + mrow) * NMODC + 3 * DM, *sc = sh + DM;
          const int c = (F.tid & 255) * 8, rw0 = F.tid >> 8;
          v4u xw[8];
#pragma unroll
          for (int q = 0; q < 8; ++q) xw[q] = *(const GAS v4u*)(X + (size_t)(r0 + rw0 + 2 * q) * DM + c);
          const f32x4 a0 = *(const GAS f32x4*)(gn + c) * (*(const GAS f32x4*)(sc + c) + 1.0f), a1 = *(const GAS f32x4*)(gn + c + 4) * (*(const GAS f32x4*)(sc + c + 4) + 1.0f);
          const f32x4 b0 = *(const GAS f32x4*)(sh + c), b1 = *(const GAS f32x4*)(sh + c + 4);
#pragma unroll
          for (int q = 0; q < 8; ++q) { const int row = rw0 + 2 * q; const float rs = RSTD[row]; f32x4 x0, x1;
              x0.x = bflo(xw[q].x); x0.y = bfhi(xw[q].x); x0.z = bflo(xw[q].y); x0.w = bfhi(xw[q].y); x1.x = bflo(xw[q].z); x1.y = bfhi(xw[q].z); x1.z = bflo(xw[q].w); x1.w = bfhi(xw[q].w);
              const f32x4 h0 = x0 * rs * a0 + b0, h1 = x1 * rs * a1 + b1;
              v4u w; w.x = pk2(h0.x, h0.y); w.y = pk2(h0.z, h0.w); w.z = pk2(h1.x, h1.y); w.w = pk2(h1.z, h1.w);
              *(GAS v4u*)(HS + (size_t)(r0 + row) * DM + c) = w; } }
    }
    __syncthreads();
#undef RT_SYNC
#undef RT_LOAD
#undef RT_MMA
#undef RT_ROW0
}
__device__ __forceinline__ void moe_fill_rows(Frame& F, const LAS int* perm, int first, int stride, int lim) {
    const int* s2t = (const int*)(F.ws + WS_ROUTE) + RT_S2T; LAS int* gt = (LAS int*)(F.lds + GT_OFF);
    const int nu = perm[0] * 4;
    for (int e = F.tid; e < 4 * 256; e += NWAVES * 64) { const int ui = e >> 8, r = e & 255; const int L = first + ui * stride;
        if (L < nu && L < lim) { const int pm = perm[1 + (L >> 2)] & 0xffff; gt[e] = s2t[pm * 256 + r]; } }
    __syncthreads();
}
constexpr int PERM_OFF = MISC_OFF + 1024;
static_assert(PERM_OFF + 4 * (176 + 176) <= LDS_BYTES, "perm");
__device__ __forceinline__ void moe_sort_tiles(Frame& F, int l) {
    const unsigned* moe = (const unsigned*)(F.ws + WS_CTL) + CW_MOE + l * CW_MOE_L;
    LAS int* perm = (LAS int*)(F.lds + PERM_OFF); LAS int* etab = perm + 176;
    int nt = (int)moe[MOE_NT]; if (nt > SLOT_CAP / 256) nt = SLOT_CAP / 256;
    if (F.tid < 176) etab[F.tid] = F.tid < nt ? (int)(moe[MOE_TILE_E + F.tid] & 31) : 255;
    __syncthreads();
    if (F.tid < nt) { const int e = etab[F.tid]; int pos = 0;
        for (int t = 0; t < nt; ++t) { const int e2 = etab[t]; pos += (e2 < e || (e2 == e && t < F.tid)) ? 1 : 0; }
        perm[1 + pos] = F.tid | (e << 16); }
    if (F.tid == 0) perm[0] = nt;
    __syncthreads();
}

constexpr int PH_PER_LAYER = 11, N_PHASES = 2 + DEPTH * PH_PER_LAYER + 1;
struct Args { const float* in[28]; float* out; unsigned char* ws; int ph_lo, ph_hi; };
static_assert(sizeof(Args) == 28 * 8 + 8 + 8 + 8, "Args has no padding");

__global__ void __launch_bounds__(NWAVES * 64, 2) hymba_fwd(Args args) {
    extern __shared__ __attribute__((aligned(16))) unsigned char lds_raw[];
    Frame F;
    F.lds = (LAS unsigned char*)lds_raw; F.ws = args.ws; F.in = args.in;
    F.tid = threadIdx.x; F.lane = F.tid & 63; F.wave = __builtin_amdgcn_readfirstlane(F.tid >> 6);
    F.G = gridDim.x; { const int bx = blockIdx.x; F.vcu = (F.G % 8 == 0) ? (bx % 8) * (F.G / 8) + bx / 8 : bx; }
    volatile LAS unsigned* MISC = (volatile LAS unsigned*)(F.lds + MISC_OFF);
    if (F.tid < 32) MISC[F.tid] = 0u;
    const int wave0 = F.wave, vcu0 = F.vcu, g0 = F.G;
    __syncthreads();
    unsigned* ctl = (unsigned*)(F.ws + WS_CTL);
#if MK_SPLIT
#define GRID_BAR() do { } while (0)
#else
    XcdBarrier bar = xcd_barrier_post(ctl + CW_BAR, MISC + 8);
#define GRID_BAR() xcd_barrier(bar)
#endif
    const int lo = args.ph_lo, hi = args.ph_hi;
#ifndef PH_MASK
#define PH_MASK 0x3fff
#endif
#define PHON(x) (((PH_MASK) >> (x)) & 1)
#ifndef REP_MASK
#define REP_MASK 0
#endif
#define NREP(x) ((((REP_MASK) >> (x)) & 1) ? 2 : 1)
#define REFRESH() do { const int ln_ = fresh_lane(); F.tid = (wave0 << 6) | ln_; F.lane = ln_; F.wave = wave0; int v_ = vcu0, g_ = g0; asm volatile("" : "+s"(v_), "+s"(g_)); F.vcu = v_; F.G = g_; } while (0)
#define IN(k) (lo <= (k) && (k) < hi)
#define SEAM(k) do { if (IN(k) && IN((k) + 1)) GRID_BAR(); } while (0)
    LAS unsigned char* ring = F.lds;
    const bool CTX_IN_E = (F.G == 256);

    if (PHON(0) && IN(0)) { for (int rep = 0; rep < NREP(0); ++rep) { REFRESH(); p0_prologue(F); __syncthreads(); } } SEAM(0);
    if (PHON(1) && IN(1)) { REFRESH(); p0b_modreduce(F); } SEAM(1);

    for (int l = 0; l < DEPTH; ++l) {
        const int pb = 2 + l * PH_PER_LAYER;
        if (PHON(2) && IN(pb + 0)) { for (int rep = 0; rep < (l == 0 ? NREP(2) : 1); ++rep) { REFRESH(); if (l == 0) { router_tables(F); phase_norm1<0>(F, l, nullptr); } else phase_norm1<1>(F, l, nullptr); } } SEAM(pb + 0);
        if (PHON(3) && IN(pb + 1)) { REFRESH();
            pg8::Gemm g{(const bf16*)(F.ws + WS_H), (const bf16*)(F.ws + WS_WIN) + (size_t)l * PIN * DM, T, PIN, DM}; pg8::StaticOrder S; S.init(T, PIN, F.G, (int)blockIdx.x);
            EpiStoreBf16 E{(bf16*)(F.ws + WS_P), PIN};
            for (int rep = 0; rep < NREP(3); ++rep) pg8::gemm_phase<EpiStoreBf16, pg8::StaticOrder, true, true>(ring, g, S, E, F.tid);
        } SEAM(pb + 1);
        if (PHON(4) && IN(pb + 2)) { for (int rep = 0; rep < NREP(4); ++rep) { REFRESH(); phase_prep(F, l); } } SEAM(pb + 2);
        if (PHON(5) && IN(pb + 3)) { REFRESH();
            int kaux = 128; asm volatile("" : "+s"(kaux));
            pg8::Gemm g{(const bf16*)(F.ws + WS_AUXA), (const bf16*)(F.ws + WS_AUXB) + (size_t)l * 12 * 256 * 128, 8 * T, 12 * 256, kaux}; AuxSched S{F.G, F.vcu};
            EpiAux E{(bf16*)(F.ws + WS_G), (bf16*)(F.ws + WS_YB), (const bf16*)(F.ws + WS_AUXA), F.in[I_RGGB] + (size_t)l * 2 * 2 * 4 * 128, (const float*)(F.ws + WS_WRT) + DEPTH * NROUTE * DM + (size_t)l * 1024, F.in[I_POOLB] + (size_t)l * 512, F.in[I_POOLS] + (size_t)l * 512};
            for (int rep = 0; rep < NREP(5); ++rep) pg8::gemm_phase<EpiAux, AuxSched, true, true>(ring, g, S, E, F.tid);
            __syncthreads();
            if (F.tid == 0) __hip_atomic_fetch_add(ctl + CW_AUXD + l, 1u, __ATOMIC_RELEASE, __HIP_MEMORY_SCOPE_AGENT);
        }
        if (PHON(6) && IN(pb + 4)) { for (int rep = 0; rep < NREP(6); ++rep) { REFRESH(); phase_attn<0>(F, l);
                if (F.tid == 0) { unsigned* cw = ctl + CW_AUXD + l; for (unsigned sp = 0; sp < (1u << 26) && __hip_atomic_load(cw, __ATOMIC_ACQUIRE, __HIP_MEMORY_SCOPE_AGENT) < (unsigned)F.G; ++sp) __builtin_amdgcn_s_sleep(2); }
                __syncthreads();
                REFRESH(); phase_scan1(F, l); __syncthreads(); } } SEAM(pb + 4);
        if (PHON(7) && IN(pb + 5)) { for (int rep = 0; rep < NREP(7); ++rep) { REFRESH(); phase_scan2(F, l); } } SEAM(pb + 5);
        if (PHON(8) && IN(pb + 6)) { REFRESH();
            pg8::Gemm g{(const bf16*)(F.ws + WS_YB), (const bf16*)(F.ws + WS_WOUT) + (size_t)l * DM * DM, T, DM, DM};
            RowOrder S; S.latent_only = (l == DEPTH - 1) || CTX_IN_E; S.S.init(S.latent_only ? NBATCH * LSEQ : T, DM, F.G, (int)blockIdx.x);
            EpiResid E{(bf16*)(F.ws + WS_X), (const float*)(F.ws + WS_MOD) + (size_t)l * 3 * NMODC, l == 0 ? F.in[I_X] : nullptr, F.in[I_CTX]};
            pg8::gemm_phase<EpiResid, RowOrder, true, true>(ring, g, S, E, F.tid);
        } SEAM(pb + 6);
        if (PHON(9) && IN(pb + 7)) {
            if (l == DEPTH - 1) { for (int rep = NREP(9) - 1; rep >= 0; --rep) { REFRESH(); phase_norm2_router(F, l, 3, rep); } }
            else if (!CTX_IN_E) { for (int rep = NREP(9) - 1; rep >= 0; --rep) { REFRESH(); phase_norm2_router(F, l, 0, rep); } }
            else if (F.vcu >= 16) { REFRESH(); phase_norm2_router(F, l, 1);
                if (F.vcu < 48) {
                    if (F.tid == 0) { unsigned* cw = ctl + CW_CTXD + l;
                        for (unsigned sp = 0; sp < (1u << 26) && __hip_atomic_load(cw, __ATOMIC_ACQUIRE, __HIP_MEMORY_SCOPE_AGENT) < 16u; ++sp) __builtin_amdgcn_s_sleep(2); }
                    __syncthreads();
                    REFRESH(); phase_norm2_router(F, l, 2); } }
            else { REFRESH();
                pg8::Gemm g{(const bf16*)(F.ws + WS_YB), (const bf16*)(F.ws + WS_WOUT) + (size_t)l * DM * DM, T, DM, DM};
                OneUnit S{(F.vcu >> 3) * TPB, F.vcu & 7};
                EpiResid E{(bf16*)(F.ws + WS_X), (const float*)(F.ws + WS_MOD) + (size_t)l * 3 * NMODC, l == 0 ? F.in[I_X] : nullptr, F.in[I_CTX]};
                pg8::gemm_phase<EpiResid, OneUnit, true, true>(ring, g, S, E, F.tid);
                __syncthreads();
                if (F.tid == 0) __hip_atomic_fetch_add(ctl + CW_CTXD + l, 1u, __ATOMIC_RELEASE, __HIP_MEMORY_SCOPE_AGENT);
            }
        } SEAM(pb + 7);
        if (PHON(11) && IN(pb + 9)) { REFRESH();
            moe_sort_tiles(F, l);
            const LAS int* perm = (const LAS int*)(F.lds + PERM_OFF); const int nF = perm[0] * 4, rf = nF / F.G, R = nF - rf * F.G;
            pg8::Gemm g{(const bf16*)(F.ws + WS_HS), (const bf16*)(F.ws + WS_UP) + (size_t)l * NEXP * 1024 * DM, SLOT_CAP, NEXP * 1024, DM}; MoeSched S{perm, 4, F.G, F.vcu, (R > 0 && rf > 0) ? rf * F.G : 0x7fffffff, (const LAS int*)(F.lds + GT_OFF)};
            moe_fill_rows(F, perm, F.vcu, F.G, S.lim);
            EpiSwiGLU E{(bf16*)(F.ws + WS_HM), (const float*)(F.ws + WS_ROUTE) + RT_WSLOT};
            for (int rep = 0; rep < NREP(11); ++rep) pg8::gemm_phase<EpiSwiGLU, MoeSched, true, true, true>(ring, g, S, E, F.tid);
        } SEAM(pb + 9);
        if (PHON(12) && IN(pb + 10)) { REFRESH();
            moe_sort_tiles(F, l);
            const LAS int* perm = (const LAS int*)(F.lds + PERM_OFF); const int nF = perm[0] * 4, rf = nF / F.G; int R = nF - rf * F.G; if (rf == 0) R = 0;
            unsigned* fov = ctl + CW_FOV + l * 256;
            if (F.vcu < R) {
                pg8::Gemm g{(const bf16*)(F.ws + WS_HS), (const bf16*)(F.ws + WS_UP) + (size_t)l * NEXP * 1024 * DM, SLOT_CAP, NEXP * 1024, DM}; MoeOneUp S{perm, rf * F.G + F.vcu, (const LAS int*)(F.lds + GT_OFF)};
                moe_fill_rows(F, perm, rf * F.G + F.vcu, 0x10000000, 0x7fffffff);
                EpiSwiGLU E{(bf16*)(F.ws + WS_HM), (const float*)(F.ws + WS_ROUTE) + RT_WSLOT};
                pg8::gemm_phase<EpiSwiGLU, MoeOneUp, true, true, true>(ring, g, S, E, F.tid);
                __syncthreads();
                if (F.tid == 0) __hip_atomic_fetch_add(fov + ((rf * F.G + F.vcu) >> 2), 1u, __ATOMIC_RELEASE, __HIP_MEMORY_SCOPE_AGENT);
                REFRESH();
            }
            pg8::Gemm g{(const bf16*)(F.ws + WS_HM), (const bf16*)(F.ws + WS_DOWN) + (size_t)l * NEXP * DM * DEXP, SLOT_CAP, NEXP * DM, DEXP}; MoeDownSched S{perm, F.G, F.vcu, R, (rf * F.G) >> 2, fov};
            EpiDown E{(bf16*)(F.ws + WS_YS)};
            for (int rep = 0; rep < NREP(12); ++rep) pg8::gemm_phase<EpiDown, MoeDownSched, true, true>(ring, g, S, E, F.tid);
        } SEAM(pb + 10);
    }
    if (PHON(13) && IN(N_PHASES - 1)) { for (int rep = 0; rep < NREP(13); ++rep) { REFRESH(); phase_norm1<2>(F, DEPTH, args.out); } }
#undef IN
#undef SEAM
}

extern "C" void kernel_launch(void* const* d_in, const int* in_sizes, int n_in, void* d_out, int out_size, void* d_ws, size_t ws_size, hipStream_t stream) {
    static int grid = 0;
    if (grid == 0) {
        if (n_in != 28 || in_sizes[0] != NBATCH * LSEQ * DM || out_size != NBATCH * LSEQ * DM || ws_size < WS_END) {
            fprintf(stderr, "kernel_launch: unexpected shapes (n_in %d, in0 %d, out %d, ws %zu need %zu); nothing launched\n", n_in, n_in > 0 ? in_sizes[0] : -1, out_size, ws_size, (size_t)WS_END); grid = -1; return; }
        int dev = 0, cus = 0, per_cu = 0;
        if (hipGetDevice(&dev) != hipSuccess || hipDeviceGetAttribute(&cus, hipDeviceAttributeMultiprocessorCount, dev) != hipSuccess) { fprintf(stderr, "kernel_launch: device query failed\n"); grid = -1; return; }
        if (hipFuncSetAttribute((const void*)hymba_fwd, hipFuncAttributeMaxDynamicSharedMemorySize, LDS_BYTES) != hipSuccess) { fprintf(stderr, "kernel_launch: hipFuncSetAttribute failed\n"); grid = -1; return; }
        if (hipOccupancyMaxActiveBlocksPerMultiprocessor(&per_cu, (const void*)hymba_fwd, NWAVES * 64, LDS_BYTES) != hipSuccess || per_cu < 1)
            fprintf(stderr, "kernel_launch: note: occupancy query reports %d workgroups per CU\n", per_cu);
        (void)hipGetLastError();
        grid = cus;
    }
    if (grid < 0) return;
    if (hipMemsetAsync((char*)d_ws + WS_CTL, 0, CTL_ZERO_BYTES, stream) != hipSuccess) { fprintf(stderr, "kernel_launch: memset failed\n"); return; }
    Args a{};
    for (int i = 0; i < 28; ++i) a.in[i] = (const float*)d_in[i];
    a.out = (float*)d_out; a.ws = (unsigned char*)d_ws;
#if MK_SPLIT
    for (int p = 0; p < N_PHASES; ++p) { a.ph_lo = p; a.ph_hi = p + 1; hipLaunchKernelGGL(hymba_fwd, dim3(grid), dim3(NWAVES * 64), LDS_BYTES, stream, a); }
#else
    a.ph_lo = 0; a.ph_hi = N_PHASES;
    hipLaunchKernelGGL(hymba_fwd, dim3(grid), dim3(NWAVES * 64), LDS_BYTES, stream, a);
#endif
    const hipError_t le = hipPeekAtLastError();
    if (le != hipSuccess) fprintf(stderr, "kernel_launch: launch failed: %s\n", hipGetErrorName(le));
}
```

```cpp
#include <hip/hip_runtime.h>
#include <cstdio>
#include <cstdint>
#ifndef MK_SPLIT
#define MK_SPLIT 0
#endif

constexpr int DM = 2048, NBATCH = 2, LSEQ = 8192, NCTX = 256, SEGB = NCTX + LSEQ, T = NBATCH * SEGB;
constexpr int DEPTH = 2, PIN = 4608, NEXP = 32, DEXP = 512, NROUTE = 36, NMODC = 6 * DM;
constexpr int NTM = T / 256;
constexpr int TPB = SEGB / 256;
constexpr int CH64 = SEGB / 64;
constexpr int SLOT_CAP = 42240;
constexpr int KSPLIT = 16;
constexpr float EPS = 1e-6f;
constexpr float QSCALE = 0.125f * 1.4426950408889634f;
constexpr int NWAVES = 8;

constexpr size_t MiB = 1u << 20;
constexpr size_t WS_CTL = 0, CTL_ZERO_BYTES = 1 * MiB;
constexpr size_t WS_MODP = 1 * MiB, WS_MOD = 6 * MiB, WS_WRT = 7 * MiB, WS_AUXB = 8 * MiB;
constexpr size_t WS_WIN = 10 * MiB, WS_WOUT = 46 * MiB, WS_UP = 62 * MiB, WS_DOWN = 318 * MiB;
constexpr size_t WS_X = 446 * MiB, WS_H = 578 * MiB, WS_P = 644 * MiB, WS_QP = 793 * MiB, WS_KP = 810 * MiB, WS_VT = 827 * MiB;
constexpr size_t WS_AUXA = 844 * MiB, WS_G = 877 * MiB, WS_YB = 943 * MiB, WS_SUM = 1009 * MiB, WS_ROUTE = 1012 * MiB;
constexpr size_t WS_HS = 1013 * MiB, WS_HM = 1178 * MiB, WS_YS = 1220 * MiB, WS_END = 1385 * MiB;
static_assert(WS_MODP + (size_t)DEPTH * KSPLIT * 3 * NMODC * 4 <= WS_MOD, "modp");
static_assert(WS_WIN + (size_t)DEPTH * PIN * DM * 2 <= WS_WOUT && WS_WOUT + (size_t)DEPTH * DM * DM * 2 <= WS_UP, "w");
static_assert(WS_UP + (size_t)DEPTH * NEXP * 1024 * DM * 2 <= WS_DOWN && WS_DOWN + (size_t)DEPTH * NEXP * DM * DEXP * 2 <= WS_X, "w2");
static_assert(WS_X + (size_t)T * DM * 4 <= WS_H && WS_H + (size_t)T * DM * 2 <= WS_P && WS_P + (size_t)T * PIN * 2 <= WS_QP, "act");
static_assert(WS_QP + (size_t)T * 512 * 2 <= WS_KP && WS_VT + (size_t)T * 512 * 2 <= WS_AUXA && WS_AUXA + (size_t)8 * T * 128 * 2 <= WS_G, "act2");
static_assert(WS_G + (size_t)T * DM * 2 <= WS_YB && WS_YB + (size_t)T * DM * 2 <= WS_SUM, "act3");
static_assert(WS_HS + (size_t)SLOT_CAP * DM * 2 <= WS_HM && WS_HM + (size_t)SLOT_CAP * DEXP * 2 <= WS_YS && WS_YS + (size_t)SLOT_CAP * DM * 2 <= WS_END, "moe");
constexpr int RT_TOKE = 0, RT_POS = T, RT_W = 3 * T, RT_SLOT = 5 * T, RT_WSLOT = 7 * T;
constexpr int RT_S2T = RT_WSLOT + SLOT_CAP;
static_assert((size_t)(RT_S2T + SLOT_CAP) * 4 <= 1 * MiB, "route");
constexpr int CW_TMO = 0, CW_CTXD = 64  , CW_AUXD = 72  , CW_FOV = 512  , CW_BAR = 4096, CW_CNT = 16384;
constexpr int CW_MOE = 32768, CW_MOE_L = 4096, MOE_NT = 0, MOE_TILE_E = 64, MOE_TMAP = 256, TMAP_STRIDE = 68;
static_assert(MOE_TMAP + 32 * TMAP_STRIDE <= CW_MOE_L && (CW_MOE + DEPTH * CW_MOE_L) * 4 <= (int)CTL_ZERO_BYTES, "moe ctl");

constexpr int RING_BYTES = 131072;
constexpr int MISC_OFF = 139264 + 320;
constexpr int TP_OFF = MISC_OFF + 128;
constexpr int GT_OFF = RING_BYTES;
constexpr int LDS_BYTES = 147456;
static_assert(TP_OFF + 33 * 4 + 64 <= LDS_BYTES && 8 * 16896 <= 139264 && GT_OFF + 4 * 256 * 4 <= 139264, "lds");

#define GAS __attribute__((address_space(1)))
#define LAS __attribute__((address_space(3)))
typedef unsigned short bf16;
typedef unsigned v4u __attribute__((ext_vector_type(4)));
typedef unsigned v2u __attribute__((ext_vector_type(2)));
typedef float f32x4 __attribute__((ext_vector_type(4)));
typedef float f32x16 __attribute__((ext_vector_type(16)));
typedef short bf16x8 __attribute__((ext_vector_type(8)));
typedef GAS unsigned gu32;
#define RLX_AGENT __ATOMIC_RELAXED, __HIP_MEMORY_SCOPE_AGENT
#define LDS_WAIT() asm volatile("s_waitcnt lgkmcnt(0)" ::: "memory")
#define VM_WAIT() asm volatile("s_waitcnt vmcnt(0)" ::: "memory")
__device__ __forceinline__ unsigned f2bf(float f) { unsigned u = __builtin_bit_cast(unsigned, f); return (u + 0x7fffu + ((u >> 16) & 1u)) >> 16; }
__device__ __forceinline__ unsigned pk2(float lo, float hi) { return f2bf(lo) | (f2bf(hi) << 16); }
__device__ __forceinline__ unsigned pk2_hw(float lo, float hi) { unsigned r; asm("v_cvt_pk_bf16_f32 %0, %1, %2" : "=v"(r) : "v"(lo), "v"(hi)); return r; }
__device__ __forceinline__ float bf2f(unsigned u16) { return __builtin_bit_cast(float, u16 << 16); }
__device__ __forceinline__ float bflo(unsigned w) { return __builtin_bit_cast(float, w << 16); }
__device__ __forceinline__ float bfhi(unsigned w) { return __builtin_bit_cast(float, w & 0xffff0000u); }
__device__ __forceinline__ int fresh_lane() { int ln; asm volatile("v_mbcnt_lo_u32_b32 %0, -1, 0\n\tv_mbcnt_hi_u32_b32 %0, -1, %0" : "=v"(ln)); return ln; }
template <int PAT> __device__ __forceinline__ float swz_xor(float v) { return __builtin_bit_cast(float, __builtin_amdgcn_ds_swizzle(__builtin_bit_cast(int, v), PAT)); }
__device__ __forceinline__ float half_swap_sum(float v) { auto rr = __builtin_amdgcn_permlane32_swap(__builtin_bit_cast(unsigned, v), __builtin_bit_cast(unsigned, v), false, false); return __builtin_bit_cast(float, rr[0]) + __builtin_bit_cast(float, rr[1]); }
__device__ __forceinline__ float wave_sum(float v) {
    const int ln = fresh_lane();
#pragma unroll
    for (int o = 1; o < 64; o <<= 1) v += __builtin_bit_cast(float, __builtin_amdgcn_ds_bpermute((ln ^ o) << 2, __builtin_bit_cast(int, v)));
    return v;
}
__device__ __forceinline__ float sigmoidf_(float x) { return 1.0f / (1.0f + __expf(-x)); }
__device__ __forceinline__ float siluf_(float x) { return x / (1.0f + __expf(-x)); }
__device__ __forceinline__ float gelu_tanh(float x) { const float z = 0.7978845608028654f * (x + 0.044715f * x * x * x); const float e = __expf(2.0f * z); return 0.5f * x * (2.0f - 2.0f / (e + 1.0f)); }
__device__ __forceinline__ int mod_row(int r) { const int b = r / SEGB; return (r - b * SEGB) < NCTX ? 2 : b; }

namespace pg8 {
#define PG8_LAS __attribute__((address_space(3)))
typedef unsigned short bf16_t;
typedef short bf16x8 __attribute__((ext_vector_type(8)));
typedef float f32x4 __attribute__((ext_vector_type(4)));
typedef unsigned u32x4 __attribute__((ext_vector_type(4)));
constexpr int BM = 256, BK = 64, HALF = 128, HTB = HALF * BK * 2  , STAGE_BYTES = 8 * HTB, NXCD = 8, WGM = 8;

__host__ __device__ __forceinline__ int lds_byte(int r, int c) { const int st = (r >> 4) * 2 + (c >> 5), rr = r & 15, cc = c & 31, ob = rr * 64 + cc * 2; return st * 1024 + (ob ^ (((ob >> 9) & 1) << 5)); }
__host__ __device__ __forceinline__ void stage_rc(int b, int& R, int& C) { const int st = b / 1024, sb = b % 1024, swz = sb ^ (((sb >> 9) & 1) << 5); R = (st >> 1) * 16 + swz / 64; C = (st & 1) * 32 + (swz % 64) / 2; }
__host__ __device__ __forceinline__ int perm32(int rho) { const int n = rho >> 4, i = rho & 15; return 8 * (i >> 2) + 4 * n + (i & 3); }

struct Unit { int pm, pn, aux; };
struct Gemm { const bf16_t* A; const bf16_t* Bt; int M, N, K; };

struct StaticOrder {
    int nM, nN, nwg, G, c;
    __host__ __device__ void init(int M, int N, int G_, int c_) { nM = M / BM; nN = N / BM; nwg = nM * nN; G = G_; c = c_; }
    __host__ __device__ bool next(int i, Unit& u) const {
        const long L = (long)i * G + c; if (L >= nwg) return false;
        int wgid = (int)L; { const int q = nwg / NXCD, r = nwg % NXCD, xcd = wgid % NXCD, off = wgid / NXCD; wgid = (xcd < r ? xcd * (q + 1) : r * (q + 1) + (xcd - r) * q) + off; }
        const int nig = WGM * nN, gid = wgid / nig, fm = gid * WGM, gsz = (nM - fm) < WGM ? (nM - fm) : WGM;
        u.pm = fm + ((wgid % nig) % gsz); u.pn = (wgid % nig) / gsz; return true;
    }
    __device__ __forceinline__ void a_ready(const Unit&) const {}
    __device__ __forceinline__ void done(const Unit&) const {}
};
__device__ __forceinline__ unsigned cvt_pk_bf16(float lo, float hi) { unsigned r; asm volatile("v_cvt_pk_bf16_f32 %0, %1, %2" : "=v"(r) : "v"(lo), "v"(hi)); return r; }
typedef float f32x2 __attribute__((ext_vector_type(2)));
template <class Epi, class Sched, bool ALIGN_EPI = false, bool SP2 = false, bool GATHER = false>
__device__ __forceinline__ void gemm_phase(PG8_LAS unsigned char* lds, const Gemm g, const Sched& S, const Epi& E, const int tid_in) {
    int tid_ = tid_in;
    const int tid = tid_, wid = __builtin_amdgcn_readfirstlane(tid >> 6), lane = tid & 63, wr = wid >> 2, wc = wid & 3, fr = lane & 15, fq = lane >> 4;
    const int K = g.K, nt = K / BK;
    unsigned voffA[2], voffB[2];
#pragma unroll
    for (int i = 0; i < 2; ++i) { int R, C; stage_rc(tid * 16 + i * 8192, R, C); const int Rb = Epi::PERM ? ((R & ~31) + perm32(R & 31)) : R;
        voffA[i] = (unsigned)(R * K + C) * 2u; voffB[i] = (unsigned)(Rb * K + C) * 2u; }
    static_assert(!GATHER || SP2, "GATHER is written for the SP2 loop");
    unsigned vC[2][2] = {}, vN[2][2] = {};
    int gR0 = 0, gC0 = 0; if constexpr (GATHER) stage_rc(tid * 16, gR0, gC0);
#define PG8_GOFF(v, ui_) do { _Pragma("unroll") for (int h_ = 0; h_ < 2; ++h_) _Pragma("unroll") for (int i_ = 0; i_ < 2; ++i_) v[h_][i_] = (unsigned)(S.row((ui_), h_ * 128 + gR0 + 64 * i_) * K + gC0) * 2u; } while (0)
    const size_t kstep = (size_t)(BK * 2);
    const size_t hstep = (size_t)HALF * K * 2;
    const size_t tstep = 2 * hstep;
    const unsigned ldsw = (unsigned)wid * 1024u;
    const int aoff = lds_byte(wr * 64 + fr, fq * 8), boff = lds_byte(wc * 32 + fr, fq * 8);
#define PG8_SA(b, h) (((b) * 2 + (h)) * HTB)
#define PG8_SB(b, h) ((4 + (b) * 2 + (h)) * HTB)
#define PG8_STAGE(bufoff, gbase, voff) do { _Pragma("unroll") for (int _i = 0; _i < 2; ++_i) \
        __builtin_amdgcn_global_load_lds((const unsigned*)((const char*)(gbase) + (voff)[_i]), (PG8_LAS unsigned*)(lds + (bufoff) + ldsw + _i * 8192), 16, 0, 0); } while (0)
#define PG8_LDA(dst, b, h) do { _Pragma("unroll") for (int m = 0; m < 4; ++m) _Pragma("unroll") for (int k = 0; k < 2; ++k) dst[m][k] = *(const PG8_LAS bf16x8*)(lds + PG8_SA(b, h) + aoff + m * 2048 + k * 1024); } while (0)
#define PG8_LDB(dst, b, h) do { _Pragma("unroll") for (int n = 0; n < 2; ++n) _Pragma("unroll") for (int k = 0; k < 2; ++k) dst[n][k] = *(const PG8_LAS bf16x8*)(lds + PG8_SB(b, h) + boff + n * 2048 + k * 1024); } while (0)
#define PG8_MMA(ai, bj, At, Bt) do { __builtin_amdgcn_s_setprio(1); _Pragma("unroll") for (int m = 0; m < 4; ++m) _Pragma("unroll") for (int n = 0; n < 2; ++n) _Pragma("unroll") for (int k = 0; k < 2; ++k) \
        acc[ai][bj][m][n] = __builtin_amdgcn_mfma_f32_16x16x32_bf16(Bt[n][k], At[m][k], acc[ai][bj][m][n], 0, 0, 0); __builtin_amdgcn_s_setprio(0); } while (0)
#define PG8_WAIT_V(n) asm volatile("s_waitcnt vmcnt(" #n ")" ::: "memory")
#define PG8_WAIT_L(n) asm volatile("s_waitcnt lgkmcnt(" #n ")" ::: "memory")
#define PG8_BAR __builtin_amdgcn_s_barrier()
#define PG8_SCHED __builtin_amdgcn_sched_barrier(0)
    Unit cur, nxt; int ui = 0;
    if (!S.next(0, cur)) return;
    f32x4 acc[2][2][4][2];
#pragma unroll
    for (int a = 0; a < 2; ++a)
#pragma unroll
        for (int b = 0; b < 2; ++b)
#pragma unroll
            for (int m = 0; m < 4; ++m)
#pragma unroll
                for (int n = 0; n < 2; ++n) acc[a][b][m][n] = (f32x4){0.f, 0.f, 0.f, 0.f};
    bf16x8 At[4][2], B0[2][2], B1[2][2];
    const char* cA = GATHER ? (const char*)g.A : (const char*)g.A + (size_t)cur.pm * tstep; const char* cB = (const char*)g.Bt + (size_t)cur.pn * tstep;
    const size_t ahstep = GATHER ? 0 : hstep;
    if constexpr (GATHER) PG8_GOFF(vC, 0);
#define PG8_VA(sel_next, h) (GATHER ? vC[h] : voffA)
    S.a_ready(cur);
    if constexpr (SP2) {
        PG8_STAGE(PG8_SB(0, 0), cB, voffB); PG8_STAGE(PG8_SB(0, 1), cB + hstep, voffB); PG8_STAGE(PG8_SA(0, 0), cA, PG8_VA(false, 0)); PG8_STAGE(PG8_SA(0, 1), cA + ahstep, PG8_VA(false, 1));
        if (wr == 1) PG8_BAR;
        PG8_WAIT_V(2); PG8_BAR;
        PG8_STAGE(PG8_SB(1, 0), cB + kstep, voffB); PG8_STAGE(PG8_SA(1, 0), cA + kstep, PG8_VA(false, 0)); PG8_STAGE(PG8_SB(1, 1), cB + hstep + kstep, voffB);
        PG8_WAIT_V(6); PG8_BAR;
    } else {
        PG8_STAGE(PG8_SB(0, 0), cB, voffB); PG8_STAGE(PG8_SA(0, 0), cA, voffA); PG8_STAGE(PG8_SB(0, 1), cB + hstep, voffB); PG8_STAGE(PG8_SA(0, 1), cA + hstep, voffA);
        if (wr == 1) PG8_BAR;
        PG8_WAIT_V(4); PG8_BAR;
        PG8_STAGE(PG8_SB(1, 0), cB + kstep, voffB); PG8_STAGE(PG8_SA(1, 0), cA + kstep, voffA); PG8_STAGE(PG8_SB(1, 1), cB + hstep + kstep, voffB);
        PG8_WAIT_V(6); PG8_BAR;
    }
    for (;;) {
        const bool has_next = S.next(ui + 1, nxt);
        const char* nA = (has_next && !GATHER) ? (const char*)g.A + (size_t)nxt.pm * tstep : cA; const char* nB = has_next ? (const char*)g.Bt + (size_t)nxt.pn * tstep : cB;
        if constexpr (GATHER) { if (has_next) PG8_GOFF(vN, ui + 1); else { _Pragma("unroll") for (int h_ = 0; h_ < 2; ++h_) _Pragma("unroll") for (int i_ = 0; i_ < 2; ++i_) vN[h_][i_] = vC[h_][i_]; } }
        for (int t = 0; t < nt; t += 2) {
            const bool last = (t == nt - 2);
            const char* a1 = cA + (size_t)(t + 1) * kstep;
            const char* a2 = last ? nA : cA + (size_t)(t + 2) * kstep; const char* b2 = last ? nB : cB + (size_t)(t + 2) * kstep;
            const char* a3 = a2 + kstep; const char* b3 = b2 + kstep;
            if (last && has_next) S.a_ready(nxt);
            unsigned vs0[2], vs1[2];
            _Pragma("unroll") for (int i_ = 0; i_ < 2; ++i_) { vs0[i_] = GATHER ? (last ? vN[0][i_] : vC[0][i_]) : voffA[i_]; vs1[i_] = GATHER ? (last ? vN[1][i_] : vC[1][i_]) : voffA[i_]; }
            if constexpr (SP2) {
            PG8_LDB(B0, 0, 0); PG8_LDB(B1, 0, 1); PG8_SCHED; PG8_LDA(At, 0, 0); PG8_STAGE(PG8_SA(1, 1), a1 + ahstep, PG8_VA(false, 1));
            PG8_WAIT_V(8); PG8_WAIT_L(0); PG8_BAR; PG8_MMA(0, 0, At, B0); PG8_MMA(0, 1, At, B1); PG8_BAR; PG8_SCHED;
            PG8_LDA(At, 0, 1); PG8_STAGE(PG8_SB(0, 0), b2, voffB); PG8_STAGE(PG8_SB(0, 1), b2 + hstep, voffB); PG8_STAGE(PG8_SA(0, 0), a2, vs0);
            PG8_WAIT_V(8); PG8_WAIT_L(0); PG8_BAR; PG8_MMA(1, 0, At, B0); PG8_MMA(1, 1, At, B1); PG8_BAR; PG8_SCHED;
            PG8_LDB(B0, 1, 0); PG8_LDB(B1, 1, 1); PG8_SCHED; PG8_LDA(At, 1, 0); PG8_STAGE(PG8_SA(0, 1), a2 + ahstep, vs1);
            PG8_WAIT_V(8); PG8_WAIT_L(0); PG8_BAR; PG8_MMA(0, 0, At, B0); PG8_MMA(0, 1, At, B1); PG8_BAR; PG8_SCHED;
            PG8_LDA(At, 1, 1); PG8_STAGE(PG8_SB(1, 0), b3, voffB); PG8_STAGE(PG8_SB(1, 1), b3 + hstep, voffB); PG8_STAGE(PG8_SA(1, 0), a3, vs0);
            PG8_WAIT_V(8); PG8_WAIT_L(0); PG8_BAR; PG8_MMA(1, 0, At, B0); PG8_MMA(1, 1, At, B1); PG8_BAR; PG8_SCHED;
            } else {
            PG8_LDB(B0, 0, 0); PG8_SCHED; PG8_LDA(At, 0, 0); PG8_STAGE(PG8_SA(1, 1), a1 + hstep, voffA);
            PG8_WAIT_L(8); PG8_BAR; PG8_WAIT_L(0); PG8_MMA(0, 0, At, B0); PG8_BAR; PG8_SCHED;
            PG8_LDB(B1, 0, 1); PG8_STAGE(PG8_SB(0, 0), b2, voffB);
            PG8_BAR; PG8_WAIT_L(0); PG8_MMA(0, 1, At, B1); PG8_BAR;
            PG8_LDA(At, 0, 1); PG8_STAGE(PG8_SA(0, 0), a2, voffA);
            PG8_BAR; PG8_WAIT_L(0); PG8_MMA(1, 0, At, B0); PG8_BAR; PG8_SCHED;
            PG8_STAGE(PG8_SB(0, 1), b2 + hstep, voffB);
            PG8_WAIT_V(6); PG8_BAR; PG8_MMA(1, 1, At, B1); PG8_BAR;
            PG8_LDB(B0, 1, 0); PG8_SCHED; PG8_LDA(At, 1, 0); PG8_STAGE(PG8_SA(0, 1), a2 + hstep, voffA);
            PG8_WAIT_L(8); PG8_BAR; PG8_WAIT_L(0); PG8_MMA(0, 0, At, B0); PG8_BAR; PG8_SCHED;
            PG8_LDB(B1, 1, 1); PG8_STAGE(PG8_SB(1, 0), b3, voffB);
            PG8_BAR; PG8_WAIT_L(0); PG8_MMA(0, 1, At, B1); PG8_BAR;
            PG8_LDA(At, 1, 1); PG8_STAGE(PG8_SA(1, 0), a3, voffA);
            PG8_BAR; PG8_WAIT_L(0); PG8_MMA(1, 0, At, B0); PG8_BAR; PG8_SCHED;
            PG8_STAGE(PG8_SB(1, 1), b3 + hstep, voffB);
            PG8_WAIT_V(6); PG8_BAR; PG8_MMA(1, 1, At, B1); PG8_BAR;
            }
        }
        if constexpr (ALIGN_EPI) { if (wr == 0) PG8_BAR; }
        if constexpr (!Epi::AFTER_DRAIN) { E(acc, cur, wr, wc, fr, fq); S.done(cur); }
        if (!has_next) break;
#pragma unroll
        for (int a = 0; a < 2; ++a)
#pragma unroll
            for (int b = 0; b < 2; ++b)
#pragma unroll
                for (int m = 0; m < 4; ++m)
#pragma unroll
                    for (int n = 0; n < 2; ++n) acc[a][b][m][n] = (f32x4){0.f, 0.f, 0.f, 0.f};
        cur = nxt; cA = nA; cB = nB; ++ui;
        if constexpr (GATHER) { _Pragma("unroll") for (int h_ = 0; h_ < 2; ++h_) _Pragma("unroll") for (int i_ = 0; i_ < 2; ++i_) vC[h_][i_] = vN[h_][i_]; }
        if constexpr (ALIGN_EPI) { if (wr == 1) PG8_BAR; }
    }
    PG8_WAIT_V(0);
    if constexpr (!ALIGN_EPI) { if (wr == 0) PG8_BAR; }
    PG8_BAR;
    if constexpr (Epi::AFTER_DRAIN) { E.fused(acc, cur, wr, wc, fr, fq, lds, wid, lane); S.done(cur); }
#undef PG8_SA
#undef PG8_GOFF
#undef PG8_VA
#undef PG8_SB
#undef PG8_STAGE
#undef PG8_LDA
#undef PG8_LDB
#undef PG8_MMA
#undef PG8_WAIT_V
#undef PG8_WAIT_L
#undef PG8_BAR
#undef PG8_SCHED
}
}
#define XB_TMO      128
#define XB_XCNT(j)  (256  + 64 * (j))
#define XB_XSUB(j)  (1280 + 64 * (j))
#define XB_XGEN(j)  (2304 + 64 * (j))
#define XB_TOP      3328
#define XB_TOPGEN   3392
#define XCD_BAR_WORDS 3456
#define XB_SPIN_CAP (1u << 18)

__device__ __forceinline__ unsigned xb_ld(unsigned* p)              { return __hip_atomic_load(p, __ATOMIC_RELAXED, __HIP_MEMORY_SCOPE_AGENT); }
__device__ __forceinline__ unsigned xb_add(unsigned* p, unsigned v) { return __hip_atomic_fetch_add(p, v, __ATOMIC_RELAXED, __HIP_MEMORY_SCOPE_AGENT); }
__device__ __forceinline__ unsigned xb_xcc_id() { return (unsigned)__builtin_amdgcn_s_getreg((3 << 11) | 20) & 0xFu; }
#define XB_SPIN(cond, bar) do { unsigned _sp = 0; while (cond) { __builtin_amdgcn_s_sleep(1); \
    if ((++_sp & 255u) == 0u) { if (xb_ld(&(bar)[XB_TMO])) break; if (_sp > XB_SPIN_CAP) { atomicAdd(&(bar)[XB_TMO], 1u); break; } } } } while (0)

struct XcdBarrier {
    unsigned* bar; unsigned x;
    volatile LAS unsigned* st;
};

__device__ __forceinline__ XcdBarrier xcd_barrier_post(unsigned* bar, volatile LAS unsigned* st) {
    XcdBarrier b; b.bar = bar; b.x = xb_xcc_id(); b.st = st;
    if (threadIdx.x == 0) (void)xb_add(&bar[XB_XCNT(b.x)], 1u);
    return b;
}
__device__ __forceinline__ void xcd_barrier_complete(unsigned* bar, unsigned x, unsigned& nloc, unsigned& nx) {
    const unsigned G = gridDim.x * gridDim.y * gridDim.z;
    unsigned sum, cnt, mine, sp = 0u;
    for (;;) {
        sum = 0u; cnt = 0u; mine = 0u;
#pragma unroll
        for (unsigned j = 0; j < 16; ++j) { const unsigned c = xb_ld(&bar[XB_XCNT(j)]); sum += c; cnt += (c > 0u) ? 1u : 0u; mine = (j == x) ? c : mine; }
        if (sum == G) break;
        __builtin_amdgcn_s_sleep(1);
        if ((++sp & 255u) == 0u) { if (xb_ld(&bar[XB_TMO])) break; if (sp > XB_SPIN_CAP) { atomicAdd(&bar[XB_TMO], 1u); break; } }
    }
    nloc = mine > 0u ? mine : 1u; nx = cnt > 0u ? cnt : 1u;
}

__device__ __forceinline__ void xcd_barrier(const XcdBarrier& b) {
    asm volatile("s_waitcnt vmcnt(0)" ::: "memory");
    __syncthreads();
    if (threadIdx.x == 0) {
        unsigned* bar = b.bar;
        __builtin_amdgcn_s_waitcnt(0);
        unsigned nloc = b.st[0], nx = b.st[1];
        if (nloc == 0u) { xcd_barrier_complete(bar, b.x, nloc, nx); b.st[0] = nloc; b.st[1] = nx; }
        const unsigned old = xb_add(&bar[XB_XSUB(b.x)], 1u);
        const unsigned gen = old / nloc;
        if (old + 1u == (gen + 1u) * nloc) {
            __builtin_amdgcn_fence(__ATOMIC_RELEASE, "agent");
            asm volatile("s_waitcnt vmcnt(0)" ::: "memory");
            const unsigned og = xb_add(&bar[XB_TOP], 1u);
            const unsigned tg = og / nx;
            if (og + 1u == (tg + 1u) * nx) xb_add(&bar[XB_TOPGEN], 1u);
            else XB_SPIN(xb_ld(&bar[XB_TOPGEN]) == tg, bar);
            __builtin_amdgcn_fence(__ATOMIC_ACQUIRE, "agent");
            xb_add(&bar[XB_XGEN(b.x)], 1u);
            asm volatile("s_waitcnt vmcnt(0)" ::: "memory");
        } else {
            XB_SPIN(xb_ld(&bar[XB_XGEN(b.x)]) == gen, bar);
            __builtin_amdgcn_fence(__ATOMIC_ACQUIRE, "agent");
            asm volatile("s_waitcnt vmcnt(0)" ::: "memory");
        }
    }
    __syncthreads();
}

using pg8::Unit;
struct EpiStoreBf16 {
    static constexpr bool PERM = true, AFTER_DRAIN = false;
    bf16* O; int ldc;
    __device__ __forceinline__ void operator()(const pg8::f32x4 (&acc)[2][2][4][2], const Unit& u, int wr, int wc, int fr, int fq) const {
        const int row0 = u.pm * 256 + wr * 64 + fr, col0 = u.pn * 256 + wc * 32 + 8 * fq;
#pragma unroll
        for (int ai = 0; ai < 2; ++ai)
#pragma unroll
            for (int m = 0; m < 4; ++m) { bf16* rowp = O + (size_t)(row0 + ai * 128 + m * 16) * ldc + col0;
#pragma unroll
                for (int bj = 0; bj < 2; ++bj) { const pg8::f32x4 v0 = acc[ai][bj][m][0], v1 = acc[ai][bj][m][1];
                    v4u w; w.x = pg8::cvt_pk_bf16(v0[0], v0[1]); w.y = pg8::cvt_pk_bf16(v0[2], v0[3]); w.z = pg8::cvt_pk_bf16(v1[0], v1[1]); w.w = pg8::cvt_pk_bf16(v1[2], v1[3]);
                    *(v4u*)(rowp + bj * 128) = w; } }
    }
};
__device__ __forceinline__ float fast_sigmoid(float x) { return __builtin_amdgcn_rcpf(1.0f + __builtin_amdgcn_exp2f(-1.4426950408889634f * x)); }
struct EpiAux {
    static constexpr bool PERM = true, AFTER_DRAIN = false;
    bf16* G; bf16* YB; const bf16* AUXA; const float* gate_b  ; const float* sp8l2  ; const float* pool_b  ; const float* pool_scale  ;
    __device__ __forceinline__ void operator()(const pg8::f32x4 (&acc)[2][2][4][2], const Unit& u, int wr, int wc, int fr, int fq) const {
        const int q = u.pn, pmrow = u.pm % NTM; const int row0 = pmrow * 256 + wr * 64 + fr; const int c0 = wc * 32 + 8 * fq;
        if (q < 8) {
            const int blk = q >> 1, dir = q & 1;
            float br[8], bi[8], sp[8];
            { const float* p0 = gate_b + ((dir * 2 + 0) * 4 + blk) * 128 + c0, *p1 = gate_b + ((dir * 2 + 1) * 4 + blk) * 128 + c0, *p2 = sp8l2 + dir * 512 + blk * 128 + c0;
#pragma unroll
              for (int i = 0; i < 8; ++i) { br[i] = p0[i]; bi[i] = p1[i]; sp[i] = p2[i]; } }
            bf16* obase = G + (size_t)row0 * DM + q * 256 + c0; const bf16* ubase = AUXA + ((size_t)blk * T + row0) * 128 + c0;
#pragma unroll
            for (int ai = 0; ai < 2; ++ai) { v4u uq[4];
#pragma unroll
                for (int m = 0; m < 4; ++m) uq[m] = *(const v4u*)(ubase + (size_t)(ai * 128 + m * 16) * 128);
#pragma unroll
                for (int m = 0; m < 4; ++m) { const int ro = ai * 128 + m * 16;
                    const v4u uw = uq[m]; const float uu[8] = {bflo(uw.x), bfhi(uw.x), bflo(uw.y), bfhi(uw.y), bflo(uw.z), bfhi(uw.z), bflo(uw.w), bfhi(uw.w)};
                    float la[8], bx[8];
#pragma unroll
                    for (int i = 0; i < 8; ++i) { const float gr = acc[ai][0][m][i >> 2][i & 3] + br[i], gi = acc[ai][1][m][i >> 2][i & 3] + bi[i];
                        const float r = fast_sigmoid(gr), ig = fast_sigmoid(gi); const float l2 = -sp[i] * r;
                        const float x = -1.3862943611198906f * l2;
                        const float em = 1.0f - __builtin_amdgcn_exp2f(2.0f * l2);
                        const float sr = x * (1.0f + x * (-0.5f + x * (0.16666667f - 0.041666668f * x)));
                        const float om = x < 0.125f ? sr : em;
                        la[i] = l2; bx[i] = __builtin_amdgcn_sqrtf(om) * (ig * uu[i]); }
                    v4u w; w.x = pg8::cvt_pk_bf16(la[0], la[1]); w.y = pg8::cvt_pk_bf16(la[2], la[3]); w.z = pg8::cvt_pk_bf16(la[4], la[5]); w.w = pg8::cvt_pk_bf16(la[6], la[7]);
                    *(v4u*)(obase + (size_t)ro * DM) = w;
                    w.x = pg8::cvt_pk_bf16(bx[0], bx[1]); w.y = pg8::cvt_pk_bf16(bx[2], bx[3]); w.z = pg8::cvt_pk_bf16(bx[4], bx[5]); w.w = pg8::cvt_pk_bf16(bx[6], bx[7]);
                    *(v4u*)(obase + (size_t)ro * DM + 128) = w; } }
        } else {
            const int g = q - 8;
            const pg8::f32x4 b0 = *(const pg8::f32x4*)(pool_b + g * 128 + c0) * *(const pg8::f32x4*)(pool_scale + g * 128 + c0), b1 = *(const pg8::f32x4*)(pool_b + g * 128 + c0 + 4) * *(const pg8::f32x4*)(pool_scale + g * 128 + c0 + 4);
            bf16* obase = YB + (size_t)row0 * DM + 1024 + g * 128 + c0;
#pragma unroll
            for (int ai = 0; ai < 2; ++ai)
#pragma unroll
                for (int m = 0; m < 4; ++m) { const pg8::f32x4 v0 = acc[ai][0][m][0] + b0, v1 = acc[ai][0][m][1] + b1;
                    v4u w; w.x = pg8::cvt_pk_bf16(v0[0], v0[1]); w.y = pg8::cvt_pk_bf16(v0[2], v0[3]); w.z = pg8::cvt_pk_bf16(v1[0], v1[1]); w.w = pg8::cvt_pk_bf16(v1[2], v1[3]);
                    *(v4u*)(obase + (size_t)(ai * 128 + m * 16) * DM) = w; }
        }
    }
};
struct AuxSched {
    int G, c;
    __device__ __forceinline__ bool next(int i, Unit& u) const { const int L = i * G + c; if (L >= NTM * 12) return false; const int pmrow = L / 12, q = L % 12; u.pn = q; u.pm = (q < 8 ? (q >> 1) : (q - 4)) * NTM + pmrow; return true; }
    __device__ __forceinline__ void a_ready(const Unit&) const {}
    __device__ __forceinline__ void done(const Unit&) const {}
};
struct EpiResid {
    static constexpr bool PERM = true, AFTER_DRAIN = false;
    bf16* X; const float* mod  ; const float* in_x; const float* in_ctx;
    __device__ __forceinline__ void operator()(const pg8::f32x4 (&acc)[2][2][4][2], const Unit& u, int wr, int wc, int fr, int fq) const {
        const int b = u.pm / TPB, tb = u.pm - b * TPB; const int mrow = (tb == 0) ? 2 : b;
        const float* rin = !in_x ? nullptr : (tb == 0 ? in_ctx + (size_t)b * NCTX * DM : in_x + ((size_t)b * LSEQ + (size_t)(tb - 1) * 256) * DM);
        bf16* xb = X + (size_t)u.pm * 256 * DM;
        const int col0 = u.pn * 256 + wc * 32 + 8 * fq; const float* m2 = mod + (size_t)mrow * NMODC + 2 * DM + col0;
#pragma unroll
        for (int bj = 0; bj < 2; ++bj) { const pg8::f32x4 g0 = *(const pg8::f32x4*)(m2 + bj * 128), g1 = *(const pg8::f32x4*)(m2 + bj * 128 + 4);
#pragma unroll
            for (int ai = 0; ai < 2; ++ai) { pg8::f32x4 r0[4], r1[4];
                if (rin) {
#pragma unroll
                    for (int m = 0; m < 4; ++m) { const size_t ro = (size_t)(ai * 128 + wr * 64 + m * 16 + fr) * DM + col0 + bj * 128; r0[m] = *(const pg8::f32x4*)(rin + ro); r1[m] = *(const pg8::f32x4*)(rin + ro + 4); }
                } else { v4u w4[4];
#pragma unroll
                    for (int m = 0; m < 4; ++m) { const size_t ro = (size_t)(ai * 128 + wr * 64 + m * 16 + fr) * DM + col0 + bj * 128; w4[m] = *(const v4u*)(xb + ro); }
#pragma unroll
                    for (int m = 0; m < 4; ++m) { const v4u w = w4[m]; r0[m][0] = bflo(w.x); r0[m][1] = bfhi(w.x); r0[m][2] = bflo(w.y); r0[m][3] = bfhi(w.y); r1[m][0] = bflo(w.z); r1[m][1] = bfhi(w.z); r1[m][2] = bflo(w.w); r1[m][3] = bfhi(w.w); }
                }
#pragma unroll
                for (int m = 0; m < 4; ++m) { const size_t ro = (size_t)(ai * 128 + wr * 64 + m * 16 + fr) * DM + col0 + bj * 128;
                    const pg8::f32x4 o0 = r0[m] + g0 * acc[ai][bj][m][0], o1 = r1[m] + g1 * acc[ai][bj][m][1];
                    v4u w; w.x = pg8::cvt_pk_bf16(o0[0], o0[1]); w.y = pg8::cvt_pk_bf16(o0[2], o0[3]); w.z = pg8::cvt_pk_bf16(o1[0], o1[1]); w.w = pg8::cvt_pk_bf16(o1[2], o1[3]);
                    *(v4u*)(xb + ro) = w; } } }
    }
};
struct MoeSched {
    const LAS int* perm; int ncol, G, c, lim;
    const LAS int* gt;
    __device__ __forceinline__ int row(int ui, int r) const { return gt[ui * 256 + r]; }
    __device__ __forceinline__ bool next(int i, Unit& u) const {
        const int L = i * G + c; const int nt = perm[0]; if (L >= nt * ncol || L >= lim) return false;
        const int q = L / ncol, j = L - q * ncol; const int pe = perm[1 + q];
        u.pm = pe & 0xffff; u.pn = (pe >> 16) * ncol + j; u.aux = q; return true;
    }
    __device__ __forceinline__ void a_ready(const Unit&) const {}
    __device__ __forceinline__ void done(const Unit&) const {}
};
struct MoeOneUp {
    const LAS int* perm; int L; const LAS int* gt;
    __device__ __forceinline__ int row(int, int r) const { return gt[r]; }
    __device__ __forceinline__ bool next(int i, Unit& u) const { if (i > 0) return false; const int q = L >> 2, j = L & 3; const int pe = perm[1 + q]; u.pm = pe & 0xffff; u.pn = (pe >> 16) * 4 + j; u.aux = q; return true; }
    __device__ __forceinline__ void a_ready(const Unit&) const {}
    __device__ __forceinline__ void done(const Unit&) const {}
};
struct MoeDownSched {
    const LAS int* perm; int G, c, R, qov; const unsigned* cnt;
    __device__ __forceinline__ bool next(int i, Unit& u) const {
        int L;
        if (R == 0) L = i * G + c;
        else { const int vi = c < R ? i + 2 : i; L = vi < 2 ? vi * (G - R) + (c - R) : 2 * (G - R) + (vi - 2) * G + c; }
        const int nt = perm[0]; if (L >= nt * 8) return false;
        const int q = L >> 3, j = L & 7; const int pe = perm[1 + q];
        u.pm = pe & 0xffff; u.pn = (pe >> 16) * 8 + j; u.aux = q; return true;
    }
    __device__ __forceinline__ void a_ready(const Unit& u) const {
        if (R == 0 || u.aux < qov) return;
        const unsigned* w = cnt + u.aux;
        for (unsigned sp = 0; sp < (1u << 24); ++sp) { if ((unsigned)__builtin_amdgcn_readfirstlane((int)__hip_atomic_load(w, __ATOMIC_RELAXED, __HIP_MEMORY_SCOPE_AGENT)) >= 4u) break; __builtin_amdgcn_s_sleep(2); }
        __builtin_amdgcn_fence(__ATOMIC_ACQUIRE, "agent");
    }
    __device__ __forceinline__ void done(const Unit&) const {}
};
struct EpiSwiGLU {
    static constexpr bool PERM = true, AFTER_DRAIN = false;
    bf16* HM; const float* wslot;
    __device__ __forceinline__ void operator()(const pg8::f32x4 (&acc)[2][2][4][2], const Unit& u, int wr, int wc, int fr, int fq) const {
        const int j = u.pn & 3; const int row0 = u.pm * 256 + wr * 64 + fr, col0 = j * 128 + wc * 32 + 8 * fq;
        float ws[8];
#pragma unroll
        for (int i = 0; i < 8; ++i) ws[i] = wslot[row0 + (i >> 2) * 128 + (i & 3) * 16];
#pragma unroll
        for (int ai = 0; ai < 2; ++ai)
#pragma unroll
            for (int m = 0; m < 4; ++m) { float h[8];
#pragma unroll
                for (int n = 0; n < 2; ++n)
#pragma unroll
                    for (int x = 0; x < 4; ++x) h[n * 4 + x] = ws[ai * 4 + m] * siluf_(acc[ai][0][m][n][x]) * acc[ai][1][m][n][x];
                v4u w; w.x = pg8::cvt_pk_bf16(h[0], h[1]); w.y = pg8::cvt_pk_bf16(h[2], h[3]); w.z = pg8::cvt_pk_bf16(h[4], h[5]); w.w = pg8::cvt_pk_bf16(h[6], h[7]);
                *(v4u*)(HM + (size_t)(row0 + ai * 128 + m * 16) * DEXP + col0) = w; }
    }
};
struct EpiDown {
    static constexpr bool PERM = true, AFTER_DRAIN = false;
    bf16* YS;
    __device__ __forceinline__ void operator()(const pg8::f32x4 (&acc)[2][2][4][2], const Unit& u, int wr, int wc, int fr, int fq) const {
        const int j = u.pn & 7; const int row0 = u.pm * 256 + wr * 64 + fr, col0 = j * 256 + wc * 32 + 8 * fq;
#pragma unroll
        for (int ai = 0; ai < 2; ++ai)
#pragma unroll
            for (int m = 0; m < 4; ++m) { const int row = row0 + ai * 128 + m * 16;
#pragma unroll
                for (int bj = 0; bj < 2; ++bj) { const pg8::f32x4 v0 = acc[ai][bj][m][0], v1 = acc[ai][bj][m][1];
                    v4u w; w.x = pg8::cvt_pk_bf16(v0[0], v0[1]); w.y = pg8::cvt_pk_bf16(v0[2], v0[3]); w.z = pg8::cvt_pk_bf16(v1[0], v1[1]); w.w = pg8::cvt_pk_bf16(v1[2], v1[3]);
                    *(v4u*)(YS + (size_t)row * DM + col0 + bj * 128) = w; } }
    }
};
struct RowOrder {
    pg8::StaticOrder S; bool latent_only;
    __device__ __forceinline__ bool next(int i, Unit& u) const { if (!S.next(i, u)) return false; if (latent_only) u.pm = u.pm + 1 + (u.pm >= TPB - 1 ? 1 : 0); return true; }
    __device__ __forceinline__ void a_ready(const Unit&) const {}
    __device__ __forceinline__ void done(const Unit&) const {}
};
struct OneUnit {
    int pm, pn;
    __device__ __forceinline__ bool next(int i, Unit& u) const { if (i > 0) return false; u.pm = pm; u.pn = pn; return true; }
    __device__ __forceinline__ void a_ready(const Unit&) const {}
    __device__ __forceinline__ void done(const Unit&) const {}
};

struct Frame {
    LAS unsigned char* lds; unsigned char* ws; const float* const* in;
    int tid, lane, wave, vcu, G;
};
enum { I_X = 0, I_C, I_CTX, I_CCTX, I_MODW, I_MODB, I_NMIX, I_NFFN, I_WIN, I_WOUT, I_RGCW, I_RGCB, I_RGGW, I_RGGB, I_RGLAM, I_SCW, I_POOLW, I_POOLB, I_POOLS, I_DALAM, I_DANORM,
       I_GRPW, I_GRPB, I_EXPW, I_EXPB, I_UP, I_DOWN, I_NFINAL };

__device__ __forceinline__ void transpose_item(const float* W, int K, int N, bf16* WT, int k0, int n0, int n0_out, LAS float* scr, int lane) {
    float v[32];
#pragma unroll
    for (int i = 0; i < 32; ++i) { const int kk = 2 * i + (lane >> 5); v[i] = W[(size_t)(k0 + kk) * N + n0 + (lane & 31)]; }
#pragma unroll
    for (int i = 0; i < 32; ++i) { const int kk = 2 * i + (lane >> 5); scr[kk * 33 + (lane & 31)] = v[i]; }
    LDS_WAIT(); asm volatile("" ::: "memory");
    const int c = lane & 7;
#pragma unroll
    for (int j = 0; j < 4; ++j) { const int n = (lane >> 3) + 8 * j; const LAS float* s = scr + (8 * c) * 33 + n;
        v4u o; o.x = pk2_hw(s[0 * 33], s[1 * 33]); o.y = pk2_hw(s[2 * 33], s[3 * 33]); o.z = pk2_hw(s[4 * 33], s[5 * 33]); o.w = pk2_hw(s[6 * 33], s[7 * 33]);
        *(GAS v4u*)(WT + (size_t)(n0_out + n) * K + k0 + 8 * c) = o; }
    LDS_WAIT(); asm volatile("" ::: "memory");
}
__device__ __forceinline__ void p0_prologue(Frame& F) {
    const int gw = F.vcu * NWAVES + F.wave, NGW = F.G * NWAVES;
    LAS float* S = (LAS float*)(F.lds);
    for (int i = F.tid; i < 3 * DM; i += NWAVES * 64) { const int r = i / DM, k = i % DM; const float c = r < 2 ? F.in[I_C][r * DM + k] : F.in[I_CCTX][k]; S[i] = siluf_(c); }
    __syncthreads();
    {
        float* MODP = (float*)(F.ws + WS_MODP);
        for (int it = gw; it < DEPTH * 48 * KSPLIT; it += NGW) {
            const int kc = it % KSPLIT, nch = (it / KSPLIT) % 48, l = it / (KSPLIT * 48);
            const float* W = F.in[I_MODW] + ((size_t)l * DM + kc * 128) * NMODC + 4 * (nch * 64 + F.lane);
            f32x4 a0 = {0.f, 0.f, 0.f, 0.f}, a1 = a0, a2 = a0;
            for (int k0 = 0; k0 < 128; k0 += 32) {
                f32x4 wv[32];
#pragma unroll
                for (int k = 0; k < 32; ++k) wv[k] = __builtin_nontemporal_load((const GAS f32x4*)(W + (size_t)(k0 + k) * NMODC));
                __builtin_amdgcn_sched_barrier(0);
#pragma unroll
                for (int k = 0; k < 32; ++k) { const int kk = kc * 128 + k0 + k; a0 += wv[k] * S[kk]; a1 += wv[k] * S[DM + kk]; a2 += wv[k] * S[2 * DM + kk]; }
            }
            float* o = MODP + ((size_t)(l * KSPLIT + kc) * 3) * NMODC + 4 * (nch * 64 + F.lane);
            *(f32x4*)o = a0; *(f32x4*)(o + NMODC) = a1; *(f32x4*)(o + 2 * NMODC) = a2;
        }
    }
    __syncthreads();
    {
        LAS float* scr = (LAS float*)(F.lds + F.wave * 16384);
        constexpr int I_IN = 32 * 144, I_OUT = 32 * 64;
        constexpr int PER_L = I_IN + I_OUT;
        for (int it = gw; it < DEPTH * PER_L; it += NGW) {
            const int l = it / PER_L; int r = it % PER_L;
            if (r < I_IN) { const int kb = r / 144, nb = r % 144; transpose_item(F.in[I_WIN] + (size_t)l * DM * PIN, DM, PIN, (bf16*)(F.ws + WS_WIN) + (size_t)l * PIN * DM, 64 * kb, 32 * nb, 32 * nb, scr, F.lane); continue; } r -= I_IN;
            { const int kb = r / 64, nb = r % 64; transpose_item(F.in[I_WOUT] + (size_t)l * DM * DM, DM, DM, (bf16*)(F.ws + WS_WOUT) + (size_t)l * DM * DM, 64 * kb, 32 * nb, 32 * nb, scr, F.lane); }
        }
    }
    {
        const int gt = F.vcu * NWAVES * 64 + F.tid, NGT = F.G * NWAVES * 64;
        bf16* AUXB = (bf16*)(F.ws + WS_AUXB);
        for (int idx0 = gt; idx0 < DEPTH * 12 * 256 * 128; idx0 += 6 * NGT) {
            float vv[6];
#pragma unroll
            for (int u = 0; u < 6; ++u) { const int idx = idx0 + u * NGT; vv[u] = 0.f;
                if (idx < DEPTH * 12 * 256 * 128) { const int k = idx & 127, rr = (idx >> 7) & 255, q = (idx >> 15) % 12, l = idx / (12 * 256 * 128);
                    if (q < 8) { const int blk = q >> 1, dir = q & 1, gate = rr >> 7, e = rr & 127; vv[u] = F.in[I_RGGW][((((size_t)(l * 2 + dir) * 2 + gate) * 4 + blk) * 128 + k) * 128 + e]; }
                    else { const int g = q - 8; vv[u] = rr < 128 ? F.in[I_POOLW][(((size_t)l * 4 + g) * 128 + k) * 128 + rr] * F.in[I_POOLS][l * 512 + g * 128 + rr] : 0.f; } } }
#pragma unroll
            for (int u = 0; u < 6; ++u) { const int idx = idx0 + u * NGT; if (idx < DEPTH * 12 * 256 * 128) AUXB[idx] = (bf16)f2bf(vv[u]); }
        }
        float* SP8 = (float*)(F.ws + WS_WRT) + DEPTH * NROUTE * DM;
        for (int idx = gt; idx < DEPTH * 2 * 512; idx += NGT) SP8[idx] = 8.0f * 1.4426950408889634f * log1pf(__expf(-F.in[I_RGLAM][idx]));
        float* WRT = (float*)(F.ws + WS_WRT);
        for (int idx = gt; idx < DEPTH * NROUTE * DM; idx += NGT) {
            const int k = idx % DM, n = (idx / DM) % NROUTE, l = idx / (DM * NROUTE);
            WRT[idx] = n < 4 ? F.in[I_GRPW][((size_t)l * DM + k) * 4 + n] : F.in[I_EXPW][((size_t)l * DM + k) * 32 + (n - 4)];
        }
    }
}
struct CvtItem { const float* W; bf16* WT; int K, N, k0, n0, n0_out; };
constexpr int CVT_UPE = 32 * 8, CVT_DNE = 8 * 16;
constexpr int CVT_L = NEXP * (CVT_UPE + CVT_DNE);
__device__ __forceinline__ CvtItem moe_item(Frame& F, int it) {
    const int l = it / CVT_L; int r = it % CVT_L; CvtItem c;
    if (r < NEXP * CVT_UPE) { const int e = r / CVT_UPE, q = r % CVT_UPE, kb = q / 8, nb = q % 8; const int n0 = 128 * nb, half = n0 >> 9, jj = (n0 & 511) >> 7;
        c.W = F.in[I_UP] + ((size_t)l * NEXP + e) * DM * 1024; c.WT = (bf16*)(F.ws + WS_UP) + ((size_t)l * NEXP + e) * 1024 * DM; c.K = DM; c.N = 1024; c.k0 = 64 * kb; c.n0 = n0; c.n0_out = jj * 256 + half * 128; }
    else { r -= NEXP * CVT_UPE; const int e = r / CVT_DNE, q = r % CVT_DNE, kb = q / 16, nb = q % 16;
        c.W = F.in[I_DOWN] + ((size_t)l * NEXP + e) * DEXP * DM; c.WT = (bf16*)(F.ws + WS_DOWN) + ((size_t)l * NEXP + e) * DM * DEXP; c.K = DEXP; c.N = DM; c.k0 = 64 * kb; c.n0 = 128 * nb; c.n0_out = 128 * nb; }
    return c;
}
__device__ __forceinline__ void cvt_load(const CvtItem& c, v2u (&v)[32], int lane) {
    const float* p = c.W + (size_t)(c.k0 + (lane >> 5)) * c.N + c.n0 + 4 * (lane & 31); const size_t step = (size_t)2 * c.N;
    f32x4 t[32];
#pragma unroll
    for (int i = 0; i < 32; ++i) { t[i] = __builtin_nontemporal_load((const GAS f32x4*)p); p += step; asm volatile("" : "+v"(p)); }
#pragma unroll
    for (int i = 0; i < 32; ++i) { v[i].x = pk2_hw(t[i].x, t[i].y); v[i].y = pk2_hw(t[i].z, t[i].w); }
}
__device__ __forceinline__ void cvt_finish(const CvtItem& c, const v2u (&v)[32], LAS unsigned char* scr, int lane) {
    constexpr int PT = 264;
#pragma unroll
    for (int i = 0; i < 32; ++i) *(LAS v2u*)(scr + (2 * i + (lane >> 5)) * PT + 8 * (lane & 31)) = v[i];
    LDS_WAIT(); asm volatile("" ::: "memory");
#pragma unroll 4
    for (int q = 0; q < 16; ++q) { const int ci = lane + 64 * q, n = ci >> 3, cq = ci & 7; const LAS unsigned char* s = scr + (8 * cq) * PT + 2 * n;
        v4u o; o.x = (unsigned)*(const LAS unsigned short*)(s) | ((unsigned)*(const LAS unsigned short*)(s + PT) << 16); o.y = (unsigned)*(const LAS unsigned short*)(s + 2 * PT) | ((unsigned)*(const LAS unsigned short*)(s + 3 * PT) << 16);
        o.z = (unsigned)*(const LAS unsigned short*)(s + 4 * PT) | ((unsigned)*(const LAS unsigned short*)(s + 5 * PT) << 16); o.w = (unsigned)*(const LAS unsigned short*)(s + 6 * PT) | ((unsigned)*(const LAS unsigned short*)(s + 7 * PT) << 16);
        __builtin_nontemporal_store(o, (GAS v4u*)(c.WT + (size_t)(c.n0_out + n) * c.K + c.k0 + 8 * cq)); }
    LDS_WAIT(); asm volatile("" ::: "memory");
}
__device__ __forceinline__ void moe_convert_range(Frame& F, int lo, int hi, int rank, int nrank) {
    const int step = nrank * NWAVES;
    LAS unsigned char* scr = F.lds + F.wave * 16896;
    for (int it = lo + rank * NWAVES + F.wave; it < hi; it += step) {
        v2u va[32]; const CvtItem ca = moe_item(F, it); cvt_load(ca, va, F.lane); cvt_finish(ca, va, scr, F.lane);
    }
}
__device__ __forceinline__ void p0b_modreduce(Frame& F) {
    const int gt = F.vcu * NWAVES * 64 + F.tid, NGT = F.G * NWAVES * 64;
    const float* MODP = (const float*)(F.ws + WS_MODP); float* MOD = (float*)(F.ws + WS_MOD);
    for (int idx = gt; idx < DEPTH * 3 * NMODC; idx += NGT) {
        const int n = idx % NMODC, r = (idx / NMODC) % 3, l = idx / (3 * NMODC);
        float s = F.in[I_MODB][l * NMODC + n];
#pragma unroll
        for (int kc = 0; kc < KSPLIT; ++kc) s += MODP[((size_t)(l * KSPLIT + kc) * 3 + r) * NMODC + n];
        MOD[idx] = s;
    }
}
template <int MODE> __device__ __forceinline__ void phase_norm1(Frame& F, int l, float* out) {
    const int gw = F.vcu * NWAVES + F.wave, NGW = F.G * NWAVES;
    bf16* X = (bf16*)(F.ws + WS_X); bf16* H = (bf16*)(F.ws + WS_H); const bf16* YS = (const bf16*)(F.ws + WS_YS);
    const float* MOD = (const float*)(F.ws + WS_MOD); const int* slot = (const int*)(F.ws + WS_ROUTE) + RT_SLOT;
    for (int r = gw; r < T; r += NGW) {
        const int b = r / SEGB, i = r - b * SEGB; const bool isctx = i < NCTX; const int mrow = isctx ? 2 : b;
        if (MODE == 2 && isctx) continue;
        f32x4 v[8];
        if (MODE == 0) {
            const float* src = isctx ? F.in[I_CTX] + ((size_t)b * NCTX + i) * DM : F.in[I_X] + ((size_t)b * LSEQ + (i - NCTX)) * DM;
#pragma unroll
            for (int j = 0; j < 4; ++j) { const int c = 8 * (F.lane + 64 * j); v[2 * j] = *(const GAS f32x4*)(src + c); v[2 * j + 1] = *(const GAS f32x4*)(src + c + 4); }
        } else {
            const int lp = (MODE == 2) ? DEPTH - 1 : l - 1;
            const float* m5 = MOD + ((size_t)lp * 3 + mrow) * NMODC + 5 * DM;
            const int s1 = slot[2 * r], s2 = slot[2 * r + 1];
            const bf16* y1 = YS + (size_t)s1 * DM, *y2 = YS + (size_t)s2 * DM;
#pragma unroll
            for (int j = 0; j < 4; ++j) { const int c = 8 * (F.lane + 64 * j);
                const v4u xw = *(const GAS v4u*)(X + (size_t)r * DM + c), a = *(const GAS v4u*)(y1 + c), bb = *(const GAS v4u*)(y2 + c);
                const f32x4 g0 = *(const GAS f32x4*)(m5 + c), g1 = *(const GAS f32x4*)(m5 + c + 4);
                f32x4 x0, x1, ys0, ys1;
                x0.x = bflo(xw.x); x0.y = bfhi(xw.x); x0.z = bflo(xw.y); x0.w = bfhi(xw.y); x1.x = bflo(xw.z); x1.y = bfhi(xw.z); x1.z = bflo(xw.w); x1.w = bfhi(xw.w);
                ys0.x = bflo(a.x) + bflo(bb.x); ys0.y = bfhi(a.x) + bfhi(bb.x); ys0.z = bflo(a.y) + bflo(bb.y); ys0.w = bfhi(a.y) + bfhi(bb.y);
                ys1.x = bflo(a.z) + bflo(bb.z); ys1.y = bfhi(a.z) + bfhi(bb.z); ys1.z = bflo(a.w) + bflo(bb.w); ys1.w = bfhi(a.w) + bfhi(bb.w);
                v[2 * j] = x0 + g0 * ys0; v[2 * j + 1] = x1 + g1 * ys1; }
        }
        float ss = 0.f;
#pragma unroll
        for (int j = 0; j < 8; ++j) ss += (v[j].x * v[j].x + v[j].y * v[j].y) + (v[j].z * v[j].z + v[j].w * v[j].w);
        const float rstd = 1.0f / sqrtf(wave_sum(ss) * (1.0f / DM) + EPS);
        if (MODE == 2) {
            float* o = out + ((size_t)b * LSEQ + (i - NCTX)) * DM; const float* g = F.in[I_NFINAL];
#pragma unroll
            for (int j = 0; j < 4; ++j) { const int c = 8 * (F.lane + 64 * j); v[2 * j] = v[2 * j] * rstd * *(const GAS f32x4*)(g + c); v[2 * j + 1] = v[2 * j + 1] * rstd * *(const GAS f32x4*)(g + c + 4); }
#pragma unroll
            for (int j = 0; j < 4; ++j) { const int c = 8 * (F.lane + 64 * j); *(GAS f32x4*)(o + c) = v[2 * j]; *(GAS f32x4*)(o + c + 4) = v[2 * j + 1]; }
        } else {
            const float* g = F.in[I_NMIX] + (size_t)l * DM; const float* sh = MOD + ((size_t)l * 3 + mrow) * NMODC, *sc = sh + DM;
            v4u hw[4];
            f32x4 gg[8], cc[8], ss[8];
#pragma unroll
            for (int j = 0; j < 4; ++j) { const int c = 8 * (F.lane + 64 * j);
                gg[2 * j] = *(const GAS f32x4*)(g + c); gg[2 * j + 1] = *(const GAS f32x4*)(g + c + 4); cc[2 * j] = *(const GAS f32x4*)(sc + c); cc[2 * j + 1] = *(const GAS f32x4*)(sc + c + 4);
                ss[2 * j] = *(const GAS f32x4*)(sh + c); ss[2 * j + 1] = *(const GAS f32x4*)(sh + c + 4); }
            asm volatile("" : "+v"(gg[0]), "+v"(gg[7]), "+v"(cc[0]), "+v"(cc[7]), "+v"(ss[0]), "+v"(ss[7]));
#pragma unroll
            for (int j = 0; j < 4; ++j) {
                const f32x4 h0 = v[2 * j] * rstd * gg[2 * j] * (cc[2 * j] + 1.0f) + ss[2 * j];
                const f32x4 h1 = v[2 * j + 1] * rstd * gg[2 * j + 1] * (cc[2 * j + 1] + 1.0f) + ss[2 * j + 1];
                hw[j].x = pk2(h0.x, h0.y); hw[j].y = pk2(h0.z, h0.w); hw[j].z = pk2(h1.x, h1.y); hw[j].w = pk2(h1.z, h1.w); }
#pragma unroll
            for (int j = 0; j < 4; ++j) { const int c = 8 * (F.lane + 64 * j);
                if (MODE != 0) { v4u xw; xw.x = pk2(v[2 * j].x, v[2 * j].y); xw.y = pk2(v[2 * j].z, v[2 * j].w); xw.z = pk2(v[2 * j + 1].x, v[2 * j + 1].y); xw.w = pk2(v[2 * j + 1].z, v[2 * j + 1].w);
                    *(GAS v4u*)(X + (size_t)r * DM + c) = xw; }
                *(GAS v4u*)(H + (size_t)r * DM + c) = hw[j]; }
        }
    }
}
__device__ __forceinline__ void unpack8(const v4u w, float (&f)[8]) { f[0] = bflo(w.x); f[1] = bfhi(w.x); f[2] = bflo(w.y); f[3] = bfhi(w.y); f[4] = bflo(w.z); f[5] = bfhi(w.z); f[6] = bflo(w.w); f[7] = bfhi(w.w); }
__device__ __forceinline__ v4u pack8f(const float (&f)[8]) { v4u w; w.x = pk2(f[0], f[1]); w.y = pk2(f[2], f[3]); w.z = pk2(f[4], f[5]); w.w = pk2(f[6], f[7]); return w; }
__device__ __forceinline__ void phase_prep(Frame& F, int l) {
    const bf16* P = (const bf16*)(F.ws + WS_P); bf16* AUXA = (bf16*)(F.ws + WS_AUXA); bf16* YB = (bf16*)(F.ws + WS_YB);
    bf16* QP = (bf16*)(F.ws + WS_QP); bf16* KP = (bf16*)(F.ws + WS_KP); bf16* VT = (bf16*)(F.ws + WS_VT);
    const int tid = F.tid, lane = F.lane, cg = tid & 63, tw = tid >> 6;
    LAS unsigned char* vl = F.lds;
    constexpr int VP = 1040;
    for (int it = F.vcu; it < NBATCH * CH64 * 5; it += F.G) {
        const int u = it / 5, st = it - 5 * u;
        const int b = u / CH64, cj = u % CH64; const bool isctx = cj < 4;
        const int seg0 = b * SEGB + (isctx ? 0 : NCTX), seglen = isctx ? NCTX : LSEQ, s0 = (isctx ? cj : cj - 4) * 64;
        const int r0 = seg0 + s0;
        const v4u zero4 = {0u, 0u, 0u, 0u};
#define LDV(s, col) (((s) >= 0 && (s) < seglen) ? *(const GAS v4u*)(P + (size_t)(seg0 + (s)) * PIN + (col)) : zero4)
        if (st == 0) {
            const int c0 = 8 * cg, t0 = s0 + 8 * tw; float w0[8], w1[8], w2[8], w3[8], bs[8];
            const float* cw = F.in[I_RGCW] + (size_t)l * 4 * 512 + c0;
#pragma unroll
            for (int i = 0; i < 8; ++i) { w0[i] = cw[i]; w1[i] = cw[512 + i]; w2[i] = cw[1024 + i]; w3[i] = cw[1536 + i]; bs[i] = F.in[I_RGCB][l * 512 + c0 + i]; }
            float xa[8], xb[8], xc[8], xd[8]; v4u raw[11];
#pragma unroll
            for (int t = 0; t < 11; ++t) raw[t] = LDV(t0 - 2 + t, c0);
            unpack8(raw[0], xa); unpack8(raw[1], xb); unpack8(raw[2], xc);
            bf16* o = AUXA + ((size_t)(cg >> 4) * T + (r0 + 8 * tw)) * 128 + (cg & 15) * 8;
#pragma unroll
            for (int t = 0; t < 8; ++t) { unpack8(raw[t + 3], xd); float y[8];
#pragma unroll
                for (int i = 0; i < 8; ++i) { y[i] = bs[i] + w0[i] * xa[i] + w1[i] * xb[i] + w2[i] * xc[i] + w3[i] * xd[i]; xa[i] = xb[i]; xb[i] = xc[i]; xc[i] = xd[i]; }
                *(GAS v4u*)(o + (size_t)t * 128) = pack8f(y); }
        }
        if (st == 1) {
            const int c0 = 8 * cg; float w0[8], w1[8], w2[8];
            const float* sw = F.in[I_SCW] + (size_t)l * 3 * 512 + c0;
#pragma unroll
            for (int i = 0; i < 8; ++i) { w0[i] = sw[i]; w1[i] = sw[512 + i]; w2[i] = sw[1024 + i]; }
#pragma unroll 1
            for (int hf = 0; hf < 2; ++hf) {
                const int t0 = s0 + 8 * tw + 4 * hf; float za[8], zb[8], zc[8], p1[8], p2[8]; v4u rc[6], rx[6], rb[4];
#pragma unroll
                for (int t = 0; t < 6; ++t) { rc[t] = LDV(t0 - 1 + t, 1536 + c0); rx[t] = LDV(t0 - 1 + t, 2048 + c0); }
#pragma unroll
                for (int t = 0; t < 4; ++t) rb[t] = LDV(t0 + t, 1024 + c0);
                unpack8(rc[0], p1); unpack8(rx[0], p2);
#pragma unroll
                for (int i = 0; i < 8; ++i) za[i] = p1[i] * p2[i];
                unpack8(rc[1], p1); unpack8(rx[1], p2);
#pragma unroll
                for (int i = 0; i < 8; ++i) zb[i] = p1[i] * p2[i];
#pragma unroll
                for (int t = 0; t < 4; ++t) { unpack8(rc[t + 2], p1); unpack8(rx[t + 2], p2); float bb[8], y[8]; unpack8(rb[t], bb);
#pragma unroll
                    for (int i = 0; i < 8; ++i) { zc[i] = p1[i] * p2[i]; y[i] = bb[i] * (w0[i] * za[i] + w1[i] * zb[i] + w2[i] * zc[i]); za[i] = zb[i]; zb[i] = zc[i]; }
                    *(GAS v4u*)(YB + (size_t)(r0 + 8 * tw + 4 * hf + t) * DM + 512 + c0) = pack8f(y); }
            }
        }
        if (st == 2) {
            const int g = tw & 3, th = tw >> 2, hw = 1 << g, c0 = 2560 + g * 128 + 8 * (lane & 15), tl0 = 32 * th + 8 * (lane >> 4), t0 = s0 + tl0;
            float sum[8], xv[8];
#pragma unroll
            for (int i = 0; i < 8; ++i) sum[i] = 0.f;
            { v4u wv[16];
#pragma unroll
              for (int k = 0; k < 16; ++k) wv[k] = (k < 2 * hw) ? LDV(t0 - hw + k, c0) : zero4;
#pragma unroll
              for (int k = 0; k < 16; ++k) { unpack8(wv[k], xv);
#pragma unroll
                for (int i = 0; i < 8; ++i) sum[i] += xv[i]; } }
            bf16* o = AUXA + ((size_t)(4 + g) * T + (r0 + tl0)) * 128 + 8 * (lane & 15);
#pragma unroll 1
            for (int hf = 0; hf < 2; ++hf) {
            v4u rv[4], re[4], rl[4];
#pragma unroll
            for (int t = 0; t < 4; ++t) { rv[t] = LDV(t0 + 4 * hf + t, c0); re[t] = LDV(t0 + 4 * hf + t + hw, c0); rl[t] = LDV(t0 + 4 * hf + t - hw, c0); }
#pragma unroll
            for (int t = 0; t < 4; ++t) { const int s = t0 + 4 * hf + t; const int lo = s - hw < 0 ? 0 : s - hw, hi = s + hw > seglen ? seglen : s + hw; const float rc = 1.0f / (float)(hi - lo);
                float y[8], xe[8], xl[8]; unpack8(rv[t], xv); unpack8(re[t], xe); unpack8(rl[t], xl);
#pragma unroll
                for (int i = 0; i < 8; ++i) { y[i] = sum[i] * rc - xv[i]; sum[i] += xe[i] - xl[i]; }
                *(GAS v4u*)(o + (size_t)(4 * hf + t) * 128) = pack8f(y); }
            }
        }
        if (st == 3) {
            const int vec = tid & 127, tq = tid >> 7, which = vec >> 6, hc = (vec >> 3) & 7, dg = vec & 7, axis = dg >> 2, part = (dg >> 1) & 1, jj0 = (dg & 1) * 8;
            const int col = 3072 + 8 * vec, pcol = 3072 + 8 * (vec ^ 2);
            bf16* dst = (which ? KP : QP) + ((size_t)(b * 8 + hc) * SEGB + cj * 64 + 16 * tq) * 64 + 8 * dg;
            const float scl = which ? 1.0f : QSCALE; const float sgn = part ? 1.0f : -1.0f;
            float inv[8];
#pragma unroll
            for (int i = 0; i < 8; ++i) inv[i] = __builtin_amdgcn_exp2f(-(float)(jj0 + i) * (13.287712379549449f / 16.0f)) * 0.15915494309189535f;
            for (int tg = 0; tg < 16; tg += 8) {
            v4u ro[8], rp[8];
#pragma unroll
            for (int t = 0; t < 8; ++t) { ro[t] = *(const GAS v4u*)(P + (size_t)(r0 + 16 * tq + tg + t) * PIN + col); rp[t] = *(const GAS v4u*)(P + (size_t)(r0 + 16 * tq + tg + t) * PIN + pcol); }
#pragma unroll
            for (int t8 = 0; t8 < 8; ++t8) { const int t = tg + t8; const int tl = 16 * tq + t; float xo[8], xp[8], y[8];
                unpack8(ro[t8], xo); unpack8(rp[t8], xp);
                if (!isctx) { const float pos = (float)(axis ? ((s0 + tl) & 63) : ((s0 + tl) >> 6));
#pragma unroll
                    for (int i = 0; i < 8; ++i) { const float rev = pos * inv[i]; const float sn = __builtin_amdgcn_sinf(rev), cs = __builtin_amdgcn_cosf(rev); y[i] = (xo[i] * cs + sgn * xp[i] * sn) * scl; }
                } else {
#pragma unroll
                    for (int i = 0; i < 8; ++i) y[i] = xo[i] * scl;
                }
                *(GAS v4u*)(dst + (size_t)t * 64) = pack8f(y); }
            }
        }
        if (st == 4) {
            __syncthreads();
            v4u vr[8];
#pragma unroll
            for (int t = 0; t < 8; ++t) vr[t] = *(const GAS v4u*)(P + (size_t)(r0 + 8 * tw + t) * PIN + 4096 + 8 * cg);
#pragma unroll
            for (int t = 0; t < 8; ++t) *(LAS v4u*)(vl + (8 * tw + t) * VP + 16 * cg) = vr[t];
            __syncthreads();
            const int h = tid >> 7, e = tid & 127; unsigned w[32];
#pragma unroll
            for (int i = 0; i < 32; ++i) w[i] = 0u;
#pragma unroll
            for (int t = 0; t < 64; ++t) { const int q = t & 15, pq = (q & 3) | ((q & 4) << 1) | ((q & 8) >> 1); const int kvp = (t & 48) + pq;
                const unsigned v = *(const LAS unsigned short*)(vl + t * VP + 2 * tid); w[kvp >> 1] |= v << (16 * (kvp & 1)); }
            v4u* o = (v4u*)(VT + (((size_t)(b * 4 + h) * CH64 + cj) * 128 + e) * 64);
#pragma unroll
            for (int i = 0; i < 8; ++i) { v4u x; x.x = w[4 * i]; x.y = w[4 * i + 1]; x.z = w[4 * i + 2]; x.w = w[4 * i + 3]; o[i] = x; }
        }
#undef LDV
    }
    __syncthreads();
}
__device__ __forceinline__ void phase_scan1(Frame& F, int l) {
    const bf16* G = (const bf16*)(F.ws + WS_G); float* SUM = (float*)(F.ws + WS_SUM);
    const int ch = F.tid, blk = ch >> 7, e = ch & 127;
    for (int u = F.vcu; u < NBATCH * 2 * CH64; u += F.G) {
        const int cj = u % CH64, dir = (u / CH64) & 1, b = u / (2 * CH64); const int r0 = b * SEGB + cj * 64;
        const bf16* g = G + (size_t)r0 * DM + blk * 512 + dir * 256 + e;
        float h = 0.f, ls = 0.f;
        for (int tb = 0; tb < 64; tb += 32) {
            unsigned short ql[32], qx[32];
#pragma unroll
            for (int i = 0; i < 32; ++i) { const int tt = dir ? 63 - (tb + i) : tb + i; ql[i] = g[(size_t)tt * DM]; qx[i] = g[(size_t)tt * DM + 128]; }
#pragma unroll
            for (int i = 0; i < 32; ++i) { const float l2 = bf2f(ql[i]); h = __builtin_amdgcn_exp2f(l2) * h + bf2f(qx[i]); ls += l2; }
        }
        float* o = SUM + ((size_t)((b * 2 + dir) * CH64 + cj) * 2) * 512 + ch; o[0] = __builtin_amdgcn_exp2f(ls); o[512] = h;
    }
}
__device__ __forceinline__ void phase_scan2(Frame& F, int l) {
    { int* s2t = (int*)(F.ws + WS_ROUTE) + RT_S2T; for (int i = F.vcu * NWAVES * 64 + F.tid; i < SLOT_CAP; i += F.G * NWAVES * 64) s2t[i] = 0; }
    const bf16* G = (const bf16*)(F.ws + WS_G); const float* SUM = (const float*)(F.ws + WS_SUM);
    const bf16* P = (const bf16*)(F.ws + WS_P); bf16* YB = (bf16*)(F.ws + WS_YB);
    LAS float* HF = (LAS float*)F.lds;
    const int ch = F.tid, blk = ch >> 7, e = ch & 127;
    const bool skipctx = (l == DEPTH - 1);
    const int nun = skipctx ? NBATCH * (CH64 - 4) : NBATCH * CH64;
    for (int u = F.vcu; u < nun; u += F.G) {
        const int NL = NBATCH * (CH64 - 4);
        const int b = u < NL ? u / (CH64 - 4) : (u - NL) / 4, cj = u < NL ? 4 + u % (CH64 - 4) : (u - NL) % 4; const int r0 = b * SEGB + cj * 64;
        float hf = 0.f, hb = 0.f;
        { const float* S0 = SUM + ((size_t)((b * 2 + 0) * CH64) * 2) * 512 + ch; const float* S1 = SUM + ((size_t)((b * 2 + 1) * CH64) * 2) * 512 + ch;
          const int nf = cj, nb = cj < 4 ? 3 - cj : 135 - cj; const int nmax = nf > nb ? nf : nb;
          for (int p0 = 0; p0 < nmax; p0 += 32) {
              float fa[32], fb[32], ba[32], bb[32];
#pragma unroll
              for (int i = 0; i < 32; ++i) { const int pp = p0 + i; const bool vf = pp < nf, vb = pp < nb; const int p = pp < CH64 ? pp : CH64 - 1; const int cb = p < 4 ? 3 - p : 135 - p;
                  fa[i] = vf ? S0[(size_t)p * 1024] : 1.f; fb[i] = vf ? S0[(size_t)p * 1024 + 512] : 0.f;
                  ba[i] = vb ? S1[(size_t)cb * 1024] : 1.f; bb[i] = vb ? S1[(size_t)cb * 1024 + 512] : 0.f; }
#pragma unroll
              for (int i = 0; i < 32; ++i) { hf = fa[i] * hf + fb[i]; hb = ba[i] * hb + bb[i]; }
          } }
        __syncthreads();
        const bf16* gf = G + (size_t)r0 * DM + blk * 512 + e; const bf16* gb = gf + 256;
        for (int tb = 0; tb < 64; tb += 32) {
            unsigned short fl[32], fx[32];
#pragma unroll
            for (int i = 0; i < 32; ++i) { fl[i] = gf[(size_t)(tb + i) * DM]; fx[i] = gf[(size_t)(tb + i) * DM + 128]; }
#pragma unroll
            for (int i = 0; i < 32; ++i) { hf = __builtin_amdgcn_exp2f(bf2f(fl[i])) * hf + bf2f(fx[i]); HF[(tb + i) * 512 + ch] = hf; }
        }
        for (int tb = 32; tb >= 0; tb -= 32) {
            unsigned short ql[32], qb[32], qa[32];
#pragma unroll
            for (int i = 0; i < 32; ++i) { ql[i] = gb[(size_t)(tb + i) * DM]; qb[i] = gb[(size_t)(tb + i) * DM + 128]; qa[i] = P[(size_t)(r0 + tb + i) * PIN + 512 + ch]; }
#pragma unroll
            for (int i = 31; i >= 0; --i) { hb = __builtin_amdgcn_exp2f(bf2f(ql[i])) * hb + bf2f(qb[i]);
                YB[(size_t)(r0 + tb + i) * DM + ch] = (bf16)f2bf(gelu_tanh(bf2f(qa[i])) * (HF[(tb + i) * 512 + ch] + hb)); }
        }
    }
    __syncthreads();
}

namespace att {
#ifndef ATT_BIG
#define ATT_BIG 16777216.0f
#endif
constexpr int SLOT = 65536, K1_OFF = 16384, V_OFF = 32768;
static_assert(2 * SLOT <= RING_BYTES, "attention LDS");
__device__ __forceinline__ bf16x8 pack8(const f32x16& p, int o) {
    v4u w; w.x = pg8::cvt_pk_bf16(p[o], p[o + 1]); w.y = pg8::cvt_pk_bf16(p[o + 2], p[o + 3]); w.z = pg8::cvt_pk_bf16(p[o + 4], p[o + 5]); w.w = pg8::cvt_pk_bf16(p[o + 6], p[o + 7]);
    return __builtin_bit_cast(bf16x8, w);
}
__device__ __forceinline__ void glds16(const void* sbase, unsigned voff, unsigned lds_dst) { unsigned keep;
    asm volatile("s_mov_b32 %0, m0\n\ts_mov_b32 m0, %3\n\ts_nop 0\n\tglobal_load_lds_dwordx4 %1, %2\n\ts_mov_b32 m0, %0" : "=&s"(keep) : "v"(voff), "s"(sbase), "s"(lds_dst) : "memory"); }
__device__ __forceinline__ float fadd_s(float a, float b) { float r; asm("v_add_f32_e32 %0, %1, %2" : "=v"(r) : "v"(a), "v"(b)); return r; }
__device__ __forceinline__ float max3f(float a, float b, float c) { float r; asm("v_max3_f32 %0, %1, %2, %3" : "=v"(r) : "v"(a), "v"(b), "v"(c)); return r; }
__device__ __forceinline__ float xhalf_max(float m) { auto rr = __builtin_amdgcn_permlane32_swap(__float_as_uint(m), __float_as_uint(m), false, false); return fmaxf(__uint_as_float(rr[0]), __uint_as_float(rr[1])); }
__device__ __forceinline__ float xhalf_sum(float m) { auto rr = __builtin_amdgcn_permlane32_swap(__float_as_uint(m), __float_as_uint(m), false, false); return __uint_as_float(rr[0]) + __uint_as_float(rr[1]); }
__device__ __forceinline__ float max16(const f32x16& p) {
    float a = max3f(p[0], p[1], p[2]), b = max3f(p[3], p[4], p[5]), c = max3f(p[6], p[7], p[8]), d = max3f(p[9], p[10], p[11]);
    a = max3f(a, p[12], p[13]); b = max3f(b, p[14], p[15]); c = fmaxf(c, d); return max3f(a, b, c);
}
}
template <int AB> __device__ __forceinline__ void phase_attn(Frame& F, int l) {
    using namespace att;
    const bf16* QP = (const bf16*)(F.ws + WS_QP); const bf16* KP = (const bf16*)(F.ws + WS_KP); const bf16* VT = (const bf16*)(F.ws + WS_VT); bf16* YB = (bf16*)(F.ws + WS_YB);
    const int lane = F.lane, r32 = lane & 31, hi = lane >> 5, wave = F.wave, c = wave >> 2, g = wave & 3;
    const float lam_init = 0.8f - 0.6f * __expf(-0.3f * (float)l);
    float lam;
    { const float* lp = F.in[I_DALAM] + (size_t)l * 256; const float s01 = wave_sum(lp[lane] * lp[64 + lane]), s23 = wave_sum(lp[128 + lane] * lp[192 + lane]); lam = __expf(s01) - __expf(s23) + lam_init; }
    const float* dan = F.in[I_DANORM] + (size_t)l * 128;
    LAS unsigned char* lds = F.lds; const unsigned lds0 = (unsigned)(size_t)lds;
    int foff[4];
#pragma unroll
    for (int s = 0; s < 4; ++s) foff[s] = r32 * 128 + (((2 * s + hi) ^ ((r32 >> 1) & 7)) << 4);
    constexpr int NLAT = NBATCH * 4 * (LSEQ / 128);
    constexpr int NU = NLAT + NBATCH * 4 * 2;
    const int conv_slot = F.vcu % 3; bool conv_done = false;
    const int gsz = F.G;
    const int cv_lo0 = l * CVT_L;
    for (int it = 0;; ++it) {
        if (it == conv_slot) { __syncthreads(); moe_convert_range(F, cv_lo0, cv_lo0 + CVT_L, F.vcu, F.G); __syncthreads(); conv_done = true; }
        int bh, qb, i0, nt;
        if (gsz == 256) {
            if (it < 2) { bh = F.vcu >> 5; qb = (F.vcu & 31) + 32 * it; i0 = NCTX + qb * 128; nt = SEGB / 128; }
            else if (it == 2 && F.vcu < 16 && l < DEPTH - 1) { bh = F.vcu >> 1; qb = F.vcu & 1; i0 = qb * 128; nt = NCTX / 128; }
            else break;
        } else {
            const int u = it * gsz + F.vcu; if (u >= NU) break;
            if (u < NLAT) { bh = u >> 6; qb = u & 63; i0 = NCTX + qb * 128; nt = SEGB / 128; } else { const int v = u - NLAT; bh = v >> 1; qb = v & 1; i0 = qb * 128; nt = NCTX / 128; }
        }
        const int b = bh >> 2, h = bh & 3;
        bf16x8 qf[4];
        { const bf16* qrow = QP + ((size_t)(bh * 2 + c) * SEGB + i0 + g * 32 + r32) * 64 + 8 * hi;
#pragma unroll
          for (int s = 0; s < 4; ++s) qf[s] = *(const GAS bf16x8*)(qrow + 16 * s); }
        unsigned voff[8];
#pragma unroll
        for (int q = 0; q < 8; ++q) { const int pp = (wave * 8 + q) & 15; const int row = 8 * pp + (lane >> 3), ch = (lane & 7) ^ ((row >> 1) & 7); voff[q] = (unsigned)(row * 128 + ch * 16); }
        const char* kbase0 = (const char*)(KP + (size_t)(bh * 2) * SEGB * 64); const char* vbase0 = (const char*)(VT + (size_t)bh * CH64 * 8192);
        const int reg = wave >> 1;
        const char* rbase = reg >= 2 ? vbase0 + (reg - 2) * 16384 : kbase0 + (size_t)reg * SEGB * 128;
        const unsigned dst0 = lds0 + reg * 16384 + ((wave * 8) & 15) * 1024;
        const int rstride = reg >= 2 ? 32768 : 16384;
#define ATT_DMA(jt) do { const char* sb_ = rbase + (size_t)(jt) * rstride; const unsigned d_ = dst0 + ((jt) & 1) * SLOT; _Pragma("unroll") for (int q_ = 0; q_ < 8; ++q_) \
            glds16(sb_, voff[q_], (unsigned)__builtin_amdgcn_readfirstlane((int)(d_ + q_ * 1024))); } while (0)
        f32x16 o0 = {}, o1 = {}, o2 = {}, o3 = {}, negm = {};
        float mref = 0.f, lsum = 0.f;
        VM_WAIT();
        asm volatile("" : "+v"(qf[0]), "+v"(qf[1]), "+v"(qf[2]), "+v"(qf[3]));
        ATT_DMA(0);
#define ATT_PVH(oa, ob, base_, pa, pb, pc, pd) do { bf16x8 vf_[8]; __builtin_amdgcn_sched_barrier(0); \
            _Pragma("unroll") for (int i_ = 0; i_ < 8; ++i_) vf_[i_] = *(const LAS bf16x8*)((base_) + (i_ >> 2) * 4096 + foff[i_ & 3]);         \
            __builtin_amdgcn_sched_barrier(0); \
            oa = __builtin_amdgcn_mfma_f32_32x32x16_bf16(vf_[0], pa, oa, 0, 0, 0); ob = __builtin_amdgcn_mfma_f32_32x32x16_bf16(vf_[4], pa, ob, 0, 0, 0); \
            oa = __builtin_amdgcn_mfma_f32_32x32x16_bf16(vf_[1], pb, oa, 0, 0, 0); ob = __builtin_amdgcn_mfma_f32_32x32x16_bf16(vf_[5], pb, ob, 0, 0, 0); \
            oa = __builtin_amdgcn_mfma_f32_32x32x16_bf16(vf_[2], pc, oa, 0, 0, 0); ob = __builtin_amdgcn_mfma_f32_32x32x16_bf16(vf_[6], pc, ob, 0, 0, 0); \
            oa = __builtin_amdgcn_mfma_f32_32x32x16_bf16(vf_[3], pd, oa, 0, 0, 0); ob = __builtin_amdgcn_mfma_f32_32x32x16_bf16(vf_[7], pd, ob, 0, 0, 0); \
            __builtin_amdgcn_sched_barrier(0); } while (0)
        for (int j = 0; j < nt; ++j) {
            asm volatile("s_waitcnt vmcnt(0)" ::: "memory");
            __builtin_amdgcn_s_barrier(); asm volatile("" ::: "memory");
            if (j + 1 < nt) ATT_DMA(j + 1);
            if ((AB & 64) && c == 1) continue;
            const LAS unsigned char* st = lds + (j & 1) * SLOT;
            const LAS unsigned char* kb = st + c * K1_OFF;
            f32x16 p0, p1, p2, p3;
#define ATT_QK(pa, kbase_) do { bf16x8 ka[4]; __builtin_amdgcn_sched_barrier(0); \
              _Pragma("unroll") for (int s_ = 0; s_ < 4; ++s_) ka[s_] = *(const LAS bf16x8*)((kbase_) + foff[s_]); \
              __builtin_amdgcn_sched_barrier(0); \
              pa = negm; \
              _Pragma("unroll") for (int s_ = 0; s_ < 4; ++s_) pa = __builtin_amdgcn_mfma_f32_32x32x16_bf16(ka[s_], qf[s_], pa, 0, 0, 0); \
              __builtin_amdgcn_sched_barrier(0); } while (0)
#define ATT_QK4() do { ATT_QK(p0, kb); ATT_QK(p1, kb + 4096); ATT_QK(p2, kb + 8192); ATT_QK(p3, kb + 12288); } while (0)
#define ATT_RAISE(first) do { asm volatile("s_nop 15\n\ts_nop 7" : "+v"(p0), "+v"(p1), "+v"(p2), "+v"(p3));     \
              const float mx_ = xhalf_max(fmaxf(fmaxf(max16(p0), max16(p1)), fmaxf(max16(p2), max16(p3)))); \
              const float dl_ = (first) ? mx_ : fmaxf(mx_, 0.f); mref += dl_; const float f_ = (first) ? 0.f : __builtin_amdgcn_exp2f(-dl_); lsum *= f_; \
              _Pragma("unroll") for (int r_ = 0; r_ < 16; ++r_) { p0[r_] -= dl_; p1[r_] -= dl_; p2[r_] -= dl_; p3[r_] -= dl_; o0[r_] *= f_; o1[r_] *= f_; o2[r_] *= f_; o3[r_] *= f_; negm[r_] = -mref; } } while (0)
#define ATT_EXPSUM() do {   \
              _Pragma("unroll") for (int r_ = 0; r_ < 16; ++r_) p0[r_] = __builtin_amdgcn_exp2f(p0[r_]); __builtin_amdgcn_sched_barrier(0); \
              _Pragma("unroll") for (int r_ = 0; r_ < 16; ++r_) p1[r_] = __builtin_amdgcn_exp2f(p1[r_]); __builtin_amdgcn_sched_barrier(0); \
              _Pragma("unroll") for (int r_ = 0; r_ < 16; ++r_) p2[r_] = __builtin_amdgcn_exp2f(p2[r_]); __builtin_amdgcn_sched_barrier(0); \
              _Pragma("unroll") for (int r_ = 0; r_ < 16; ++r_) p3[r_] = __builtin_amdgcn_exp2f(p3[r_]); \
              __builtin_amdgcn_sched_barrier(0); asm volatile("s_nop 0"); __builtin_amdgcn_sched_barrier(0);       \
              float sa_ = p0[0], sb_ = p1[0], sc_ = p2[0], sd_ = p3[0];         \
              _Pragma("unroll") for (int r_ = 1; r_ < 16; ++r_) { sa_ = fadd_s(sa_, p0[r_]); sb_ = fadd_s(sb_, p1[r_]); sc_ = fadd_s(sc_, p2[r_]); sd_ = fadd_s(sd_, p3[r_]); } \
              ts = fadd_s(fadd_s(sa_, sb_), fadd_s(sc_, sd_)); } while (0)
            ATT_QK4();
            float ts;
            if (j == 0) ATT_RAISE(true);
            ATT_EXPSUM();
            if (__any(!(ts < ATT_BIG))) { ATT_QK4(); ATT_RAISE(false); ATT_EXPSUM(); }
            lsum += ts;
#undef ATT_QK4
#undef ATT_RAISE
#undef ATT_EXPSUM
#undef ATT_QK
            const bf16x8 pa0 = pack8(p0, 0), pa1 = pack8(p0, 8), pa2 = pack8(p1, 0), pa3 = pack8(p1, 8), pb0 = pack8(p2, 0), pb1 = pack8(p2, 8), pb2 = pack8(p3, 0), pb3 = pack8(p3, 8);
            const LAS unsigned char* vb = st + V_OFF;
            ATT_PVH(o0, o1, vb, pa0, pa1, pa2, pa3); ATT_PVH(o2, o3, vb + 8192, pa0, pa1, pa2, pa3);
            ATT_PVH(o0, o1, vb + 16384, pb0, pb1, pb2, pb3); ATT_PVH(o2, o3, vb + 16384 + 8192, pb0, pb1, pb2, pb3);
        }
#undef ATT_PVH
#undef ATT_DMA
        LDS_WAIT(); __builtin_amdgcn_s_barrier(); asm volatile("" ::: "memory");
        lsum = xhalf_sum(lsum);
        const float inv = 1.0f / lsum;
        LAS float* xch = (LAS float*)lds + g * 4096 + lane;
        if (c == 1) {
            const float f = inv * lam;
#pragma unroll
            for (int r = 0; r < 16; ++r) { xch[(0 * 16 + r) * 64] = o0[r] * f; xch[(1 * 16 + r) * 64] = o1[r] * f; xch[(2 * 16 + r) * 64] = o2[r] * f; xch[(3 * 16 + r) * 64] = o3[r] * f; }
        }
        __syncthreads();
        if (c == 0) {
            float ss = 0.f;
#pragma unroll
            for (int r = 0; r < 16; ++r) { o0[r] = o0[r] * inv - xch[(0 * 16 + r) * 64]; o1[r] = o1[r] * inv - xch[(1 * 16 + r) * 64]; o2[r] = o2[r] * inv - xch[(2 * 16 + r) * 64]; o3[r] = o3[r] * inv - xch[(3 * 16 + r) * 64];
                ss += (o0[r] * o0[r] + o1[r] * o1[r]) + (o2[r] * o2[r] + o3[r] * o3[r]); }
            ss = xhalf_sum(ss);
            const float rs = (1.0f / sqrtf(ss * (1.0f / 128.0f) + EPS)) * (1.0f - lam_init);
            bf16* orow = YB + (size_t)(b * SEGB + i0 + g * 32 + r32) * DM + 1536 + h * 128 + 4 * hi;
            v2u ow[16];
#define ATT_ST(oacc, db) do { _Pragma("unroll") for (int rq = 0; rq < 4; ++rq) { const int d0 = (db) * 32 + 8 * rq + 4 * hi; const f32x4 nv = *(const GAS f32x4*)(dan + d0); \
                ow[(db) * 4 + rq].x = pk2(oacc[4 * rq] * rs * nv.x, oacc[4 * rq + 1] * rs * nv.y); ow[(db) * 4 + rq].y = pk2(oacc[4 * rq + 2] * rs * nv.z, oacc[4 * rq + 3] * rs * nv.w); } } while (0)
            ATT_ST(o0, 0); ATT_ST(o1, 1); ATT_ST(o2, 2); ATT_ST(o3, 3);
#undef ATT_ST
#pragma unroll
            for (int k = 0; k < 16; ++k) *(GAS v2u*)(orow + (k >> 2) * 32 + 8 * (k & 3)) = ow[k];
        }
        __syncthreads();
    }
    if (conv_slot >= 0 && !conv_done) { __syncthreads(); moe_convert_range(F, cv_lo0, cv_lo0 + CVT_L, F.vcu, F.G); __syncthreads(); }
}
constexpr size_t WQ_ELEMS = (size_t)DEPTH * 3 * 48 * DM;
__device__ __forceinline__ void router_tables(Frame& F) {
    bf16* WQH = (bf16*)(F.ws + WS_MODP); bf16* WQL = WQH + WQ_ELEMS; float* CC = (float*)(WQL + WQ_ELEMS);
    const float* MOD = (const float*)(F.ws + WS_MOD); const float* WRT = (const float*)(F.ws + WS_WRT);
    const int gt = F.vcu * NWAVES * 64 + F.tid, NGT = F.G * NWAVES * 64;
    for (int idx0 = gt; idx0 < (int)WQ_ELEMS; idx0 += 5 * NGT) {
        float wv[5];
#pragma unroll
        for (int q = 0; q < 5; ++q) { const int idx = idx0 + q * NGT; wv[q] = 0.f;
            if (idx < (int)WQ_ELEMS) { const int k = idx % DM, n = (idx / DM) % 48, mr = (idx / (DM * 48)) % 3, l = idx / (DM * 48 * 3);
                if (n < NROUTE) { const float a = F.in[I_NFFN][l * DM + k] * (1.0f + MOD[((size_t)l * 3 + mr) * NMODC + 4 * DM + k]); wv[q] = a * WRT[((size_t)l * NROUTE + n) * DM + k]; } } }
#pragma unroll
        for (int q = 0; q < 5; ++q) { const int idx = idx0 + q * NGT;
            if (idx < (int)WQ_ELEMS) { const float w = wv[q]; const unsigned h = f2bf(w); const float rem = w - bf2f(h); WQH[idx] = (bf16)h; WQL[idx] = (bf16)f2bf(rem); } }
    }
    const int gw = F.vcu * NWAVES + F.wave, NGW = F.G * NWAVES;
    for (int it = gw; it < DEPTH * 3 * NROUTE; it += NGW) {
        const int n = it % NROUTE, mr = (it / NROUTE) % 3, l = it / (NROUTE * 3); float sacc = 0.f;
        { float ma[32], wa[32];
#pragma unroll
          for (int q = 0; q < 32; ++q) { const int k = F.lane + 64 * q; ma[q] = MOD[((size_t)l * 3 + mr) * NMODC + 3 * DM + k]; wa[q] = WRT[((size_t)l * NROUTE + n) * DM + k]; }
#pragma unroll
          for (int q = 0; q < 32; ++q) sacc += ma[q] * wa[q]; }
        sacc = wave_sum(sacc);
        if (F.lane == 0) CC[it] = sacc + (n < 4 ? F.in[I_GRPB][l * 4 + n] : F.in[I_EXPB][l * 32 + n - 4]);
    }
}
__device__ __forceinline__ void phase_norm2_router(Frame& F, int l, int part, int dummy = 0) {
    typedef float f32x4_ __attribute__((ext_vector_type(4)));
    const bf16* X = (const bf16*)(F.ws + WS_X); const float* MOD = (const float*)(F.ws + WS_MOD);
    const bf16* WQH = (const bf16*)(F.ws + WS_MODP); const bf16* WQL = WQH + WQ_ELEMS; const float* CC = (const float*)(WQL + WQ_ELEMS);
    int* RT = (int*)(F.ws + WS_ROUTE) + (dummy ? RT_WSLOT + SLOT_CAP : 0); unsigned* cnt = (unsigned*)(F.ws + WS_CTL) + CW_CNT + l * 64 + (dummy ? 4096 : 0);
    LAS float* PART = (LAS float*)F.lds;
    LAS float* SSQ = PART + 8 * 12 * 64;
    LAS float* LGT = SSQ + 8 * 16;
    LAS float* RSTD = LGT + 16 * 40;
    LAS int* SLT = (LAS int*)(RSTD + 16);
    bf16* HS = (bf16*)(F.ws + WS_HS); unsigned* moe = (unsigned*)(F.ws + WS_CTL) + CW_MOE + l * CW_MOE_L + (dummy ? 2048 : 0);
    const float* gn = F.in[I_NFFN] + (size_t)l * DM;
    const int lane = F.lane, wave = F.wave, m16 = lane & 15, kg = lane >> 4;
    const int ntile = part == 0 ? T / 16 : part == 2 ? NBATCH * NCTX / 16 : NBATCH * LSEQ / 16;
    const int cu = (part == 1 || part == 2) ? F.vcu - 16 : F.vcu, ncu = part == 1 ? F.G - 16 : part == 2 ? 32 : F.G;
    int t0 = (int)(((long)ntile * cu) / ncu), t1 = (int)(((long)ntile * (cu + 1)) / ncu);
    if (part == 1 && ncu > 32 && ntile > 128) {
        if (cu < 32) { t0 = 4 * cu; t1 = t0 + 4; } else { const int rest = ntile - 128, nc = ncu - 32; t0 = 128 + (int)(((long)rest * (cu - 32)) / nc); t1 = 128 + (int)(((long)rest * (cu - 31)) / nc); } }
#define RT_SYNC() do { LDS_WAIT(); __builtin_amdgcn_s_barrier(); asm volatile("" ::: "memory"); } while (0)
#define RT_ROW0(tl_) (part == 0 ? (tl_) * 16 : part == 2 ? ((tl_) / (NCTX / 16)) * SEGB + ((tl_) % (NCTX / 16)) * 16 : ((tl_) / (LSEQ / 16)) * SEGB + NCTX + ((tl_) % (LSEQ / 16)) * 16)
#define RT_LOAD(xx, hh, ll, kb, xr_, wh_, wl_) do { _Pragma("unroll") for (int s_ = 0; s_ < 2; ++s_) { xx[s_] = *(const GAS bf16x8*)((xr_) + 32 * ((kb) * 2 + s_)); \
            _Pragma("unroll") for (int nt_ = 0; nt_ < 3; ++nt_) { hh[3 * s_ + nt_] = *(const GAS bf16x8*)((wh_) + (size_t)nt_ * 16 * DM + 32 * ((kb) * 2 + s_)); ll[3 * s_ + nt_] = *(const GAS bf16x8*)((wl_) + (size_t)nt_ * 16 * DM + 32 * ((kb) * 2 + s_)); } } } while (0)
#define RT_MMA(xx, hh, ll) do { _Pragma("unroll") for (int s_ = 0; s_ < 2; ++s_) { const bf16x8 xh_ = xx[s_]; const v4u xw_ = __builtin_bit_cast(v4u, xh_); \
            ssq += (bflo(xw_.x) * bflo(xw_.x) + bfhi(xw_.x) * bfhi(xw_.x)) + (bflo(xw_.y) * bflo(xw_.y) + bfhi(xw_.y) * bfhi(xw_.y)) + (bflo(xw_.z) * bflo(xw_.z) + bfhi(xw_.z) * bfhi(xw_.z)) + (bflo(xw_.w) * bflo(xw_.w) + bfhi(xw_.w) * bfhi(xw_.w)); \
            acc0 = __builtin_amdgcn_mfma_f32_16x16x32_bf16(xh_, hh[3 * s_], acc0, 0, 0, 0); acc1 = __builtin_amdgcn_mfma_f32_16x16x32_bf16(xh_, hh[3 * s_ + 1], acc1, 0, 0, 0); acc2 = __builtin_amdgcn_mfma_f32_16x16x32_bf16(xh_, hh[3 * s_ + 2], acc2, 0, 0, 0); \
            acc0 = __builtin_amdgcn_mfma_f32_16x16x32_bf16(xh_, ll[3 * s_], acc0, 0, 0, 0); acc1 = __builtin_amdgcn_mfma_f32_16x16x32_bf16(xh_, ll[3 * s_ + 1], acc1, 0, 0, 0); acc2 = __builtin_amdgcn_mfma_f32_16x16x32_bf16(xh_, ll[3 * s_ + 2], acc2, 0, 0, 0); } } while (0)
    bf16x8 xa[2], xb[2]; bf16x8 ha[6], la[6], hb[6], lb[6];
    const bf16* xr = X, *wh = WQH, *wl = WQL;
    if (t0 < t1) { const int r0_ = RT_ROW0(t0), mr_ = mod_row(r0_);
        xr = X + (size_t)(r0_ + m16) * DM + 256 * wave + 8 * kg; wh = WQH + ((size_t)(l * 3 + mr_) * 48 + m16) * DM + 256 * wave + 8 * kg; wl = WQL + ((size_t)(l * 3 + mr_) * 48 + m16) * DM + 256 * wave + 8 * kg;
        RT_LOAD(xa, ha, la, 0, xr, wh, wl); RT_LOAD(xb, hb, lb, 1, xr, wh, wl); }
    for (int tl = t0; tl < t1; ++tl) {
        const int r0 = RT_ROW0(tl);
        const int mrow = mod_row(r0);
        f32x4_ acc0 = {0.f, 0.f, 0.f, 0.f}, acc1 = acc0, acc2 = acc0; float ssq = 0.f;
        __builtin_amdgcn_sched_barrier(0);
        RT_MMA(xa, ha, la); __builtin_amdgcn_sched_barrier(0); RT_LOAD(xa, ha, la, 2, xr, wh, wl); __builtin_amdgcn_sched_barrier(0);
        RT_MMA(xb, hb, lb); __builtin_amdgcn_sched_barrier(0); RT_LOAD(xb, hb, lb, 3, xr, wh, wl); __builtin_amdgcn_sched_barrier(0);
        RT_MMA(xa, ha, la); __builtin_amdgcn_sched_barrier(0);
        RT_MMA(xb, hb, lb); __builtin_amdgcn_sched_barrier(0);
        if (tl + 1 < t1) { const int r0_ = RT_ROW0(tl + 1), mr_ = mod_row(r0_);
            xr = X + (size_t)(r0_ + m16) * DM + 256 * wave + 8 * kg; wh = WQH + ((size_t)(l * 3 + mr_) * 48 + m16) * DM + 256 * wave + 8 * kg; wl = WQL + ((size_t)(l * 3 + mr_) * 48 + m16) * DM + 256 * wave + 8 * kg;
            RT_LOAD(xa, ha, la, 0, xr, wh, wl); RT_LOAD(xb, hb, lb, 1, xr, wh, wl); }
        __builtin_amdgcn_sched_barrier(0);
        { const int ln_ = fresh_lane(); ssq += __builtin_bit_cast(float, __builtin_amdgcn_ds_bpermute((ln_ ^ 16) << 2, __builtin_bit_cast(int, ssq))); ssq += __builtin_bit_cast(float, __builtin_amdgcn_ds_bpermute((ln_ ^ 32) << 2, __builtin_bit_cast(int, ssq))); }
        RT_SYNC();
#pragma unroll
        for (int r = 0; r < 4; ++r) { PART[(wave * 12 + 0 + r) * 64 + lane] = acc0[r]; PART[(wave * 12 + 4 + r) * 64 + lane] = acc1[r]; PART[(wave * 12 + 8 + r) * 64 + lane] = acc2[r]; }
        if (kg == 0) SSQ[wave * 16 + m16] = ssq;
        RT_SYNC();
        if (F.tid < 16) { float s = 0.f;
#pragma unroll
            for (int w = 0; w < 8; ++w) s += SSQ[w * 16 + F.tid];
            RSTD[F.tid] = 1.0f / sqrtf(s * (1.0f / DM) + EPS); }
        RT_SYNC();
        for (int e = F.tid; e < 16 * NROUTE; e += NWAVES * 64) { const int row = e / NROUTE, n = e % NROUTE; const int nt = n >> 4, col = n & 15, ln = col + 16 * (row >> 2), rg = row & 3; float s = 0.f;
#pragma unroll
            for (int w = 0; w < 8; ++w) s += PART[(w * 12 + nt * 4 + rg) * 64 + ln];
            LGT[row * 40 + n] = s * RSTD[row] + CC[(l * 3 + mrow) * NROUTE + n]; }
        RT_SYNC();
        if (F.tid < 16) { const int r = r0 + F.tid; const LAS float* lgp = LGT + F.tid * 40;
            float lg[4];
#pragma unroll
            for (int n = 0; n < 4; ++n) lg[n] = lgp[n];
            int gi = 0; float gm = lg[0];
#pragma unroll
            for (int n = 1; n < 4; ++n) if (lg[n] > gm) { gm = lg[n]; gi = n; }
            float den = 0.f;
#pragma unroll
            for (int n = 0; n < 4; ++n) den += __expf(lg[n] - gm);
            const float gw = 1.0f / den;
            float el[8];
#pragma unroll
            for (int j = 0; j < 8; ++j) el[j] = lgp[4 + gi * 8 + j];
            int i1 = 0; float v1 = el[0];
#pragma unroll
            for (int j = 1; j < 8; ++j) if (el[j] > v1) { v1 = el[j]; i1 = j; }
            int i2 = -1; float v2 = -3.0e38f;
#pragma unroll
            for (int j = 0; j < 8; ++j) if (j != i1 && el[j] > v2) { v2 = el[j]; i2 = j; }
            if (i2 < 0) i2 = (i1 + 1) & 7;
            const float ex = __expf(v2 - v1), w1 = gw / (1.0f + ex), w2 = gw * ex / (1.0f + ex);
            const int e1 = gi * 8 + i1, e2 = gi * 8 + i2;
            const unsigned p1 = __hip_atomic_fetch_add(cnt + e1, 1u, RLX_AGENT), p2 = __hip_atomic_fetch_add(cnt + e2, 1u, RLX_AGENT);
            if ((p1 & 255u) == 0u) { const unsigned t = __hip_atomic_fetch_add(moe + MOE_NT, 1u, RLX_AGENT); __hip_atomic_store(moe + MOE_TILE_E + t, (unsigned)e1, RLX_AGENT); __hip_atomic_store(moe + MOE_TMAP + e1 * TMAP_STRIDE + (p1 >> 8), t + 1u, RLX_AGENT); }
            if ((p2 & 255u) == 0u) { const unsigned t = __hip_atomic_fetch_add(moe + MOE_NT, 1u, RLX_AGENT); __hip_atomic_store(moe + MOE_TILE_E + t, (unsigned)e2, RLX_AGENT); __hip_atomic_store(moe + MOE_TMAP + e2 * TMAP_STRIDE + (p2 >> 8), t + 1u, RLX_AGENT); }
            unsigned t1 = 0u, t2 = 0u;
            for (unsigned sp = 0; sp < (1u << 22); ++sp) { if (!t1) t1 = __hip_atomic_load(moe + MOE_TMAP + e1 * TMAP_STRIDE + (p1 >> 8), RLX_AGENT); if (!t2) t2 = __hip_atomic_load(moe + MOE_TMAP + e2 * TMAP_STRIDE + (p2 >> 8), RLX_AGENT); if (t1 && t2) break; __builtin_amdgcn_s_sleep(1); }
            if (!t1) t1 = 1u; if (!t2) t2 = 1u;
            const int s1 = (int)((t1 - 1u) * 256u + (p1 & 255u)), s2 = (int)((t2 - 1u) * 256u + (p2 & 255u));
            RT[RT_SLOT + 2 * r] = s1; RT[RT_SLOT + 2 * r + 1] = s2; ((float*)RT)[RT_WSLOT + s1] = w1; ((float*)RT)[RT_WSLOT + s2] = w2; RT[RT_S2T + s1] = r; RT[RT_S2T + s2] = r;
            SLT[2 * F.tid] = s1; SLT[2 * F.tid + 1] = s2; }
        RT_SYNC();
        { const float* sh = MOD + ((size_t)l * 3 + mrow) * NMODC + 3 * DM, *sc = sh + DM;
          const int c = (F.tid & 255) * 8, rw0 = F.tid >> 8;
          v4u xw[8];
#pragma unroll
          for (int q = 0; q < 8; ++q) xw[q] = *(const GAS v4u*)(X + (size_t)(r0 + rw0 + 2 * q) * DM + c);
          const f32x4 a0 = *(const GAS f32x4*)(gn + c) * (*(const GAS f32x4*)(sc + c) + 1.0f), a1 = *(const GAS f32x4*)(gn + c + 4) * (*(const GAS f32x4*)(sc + c + 4) + 1.0f);
          const f32x4 b0 = *(const GAS f32x4*)(sh + c), b1 = *(const GAS f32x4*)(sh + c + 4);
#pragma unroll
          for (int q = 0; q < 8; ++q) { const int row = rw0 + 2 * q; const float rs = RSTD[row]; f32x4 x0, x1;
              x0.x = bflo(xw[q].x); x0.y = bfhi(xw[q].x); x0.z = bflo(xw[q].y); x0.w = bfhi(xw[q].y); x1.x = bflo(xw[q].z); x1.y = bfhi(xw[q].z); x1.z = bflo(xw[q].w); x1.w = bfhi(xw[q].w);
              const f32x4 h0 = x0 * rs * a0 + b0, h1 = x1 * rs * a1 + b1;
              v4u w; w.x = pk2(h0.x, h0.y); w.y = pk2(h0.z, h0.w); w.z = pk2(h1.x, h1.y); w.w = pk2(h1.z, h1.w);
              *(GAS v4u*)(HS + (size_t)(r0 + row) * DM + c) = w; } }
    }
    __syncthreads();
#undef RT_SYNC
#undef RT_LOAD
#undef RT_MMA
#undef RT_ROW0
}
__device__ __forceinline__ void moe_fill_rows(Frame& F, const LAS int* perm, int first, int stride, int lim) {
    const int* s2t = (const int*)(F.ws + WS_ROUTE) + RT_S2T; LAS int* gt = (LAS int*)(F.lds + GT_OFF);
    const int nu = perm[0] * 4;
    for (int e = F.tid; e < 4 * 256; e += NWAVES * 64) { const int ui = e >> 8, r = e & 255; const int L = first + ui * stride;
        if (L < nu && L < lim) { const int pm = perm[1 + (L >> 2)] & 0xffff; gt[e] = s2t[pm * 256 + r]; } }
    __syncthreads();
}
constexpr int PERM_OFF = MISC_OFF + 1024;
static_assert(PERM_OFF + 4 * (176 + 176) <= LDS_BYTES, "perm");
__device__ __forceinline__ void moe_sort_tiles(Frame& F, int l) {
    const unsigned* moe = (const unsigned*)(F.ws + WS_CTL) + CW_MOE + l * CW_MOE_L;
    LAS int* perm = (LAS int*)(F.lds + PERM_OFF); LAS int* etab = perm + 176;
    int nt = (int)moe[MOE_NT]; if (nt > SLOT_CAP / 256) nt = SLOT_CAP / 256;
    if (F.tid < 176) etab[F.tid] = F.tid < nt ? (int)(moe[MOE_TILE_E + F.tid] & 31) : 255;
    __syncthreads();
    if (F.tid < nt) { const int e = etab[F.tid]; int pos = 0;
        for (int t = 0; t < nt; ++t) { const int e2 = etab[t]; pos += (e2 < e || (e2 == e && t < F.tid)) ? 1 : 0; }
        perm[1 + pos] = F.tid | (e << 16); }
    if (F.tid == 0) perm[0] = nt;
    __syncthreads();
}

constexpr int PH_PER_LAYER = 11, N_PHASES = 2 + DEPTH * PH_PER_LAYER + 1;
struct Args { const float* in[28]; float* out; unsigned char* ws; int ph_lo, ph_hi; };
static_assert(sizeof(Args) == 28 * 8 + 8 + 8 + 8, "Args has no padding");

__global__ void __launch_bounds__(NWAVES * 64, 2) hymba_fwd(Args args) {
    extern __shared__ __attribute__((aligned(16))) unsigned char lds_raw[];
    Frame F;
    F.lds = (LAS unsigned char*)lds_raw; F.ws = args.ws; F.in = args.in;
    F.tid = threadIdx.x; F.lane = F.tid & 63; F.wave = __builtin_amdgcn_readfirstlane(F.tid >> 6);
    F.G = gridDim.x; { const int bx = blockIdx.x; F.vcu = (F.G % 8 == 0) ? (bx % 8) * (F.G / 8) + bx / 8 : bx; }
    volatile LAS unsigned* MISC = (volatile LAS unsigned*)(F.lds + MISC_OFF);
    if (F.tid < 32) MISC[F.tid] = 0u;
    const int wave0 = F.wave, vcu0 = F.vcu, g0 = F.G;
    __syncthreads();
    unsigned* ctl = (unsigned*)(F.ws + WS_CTL);
#if MK_SPLIT
#define GRID_BAR() do { } while (0)
#else
    XcdBarrier bar = xcd_barrier_post(ctl + CW_BAR, MISC + 8);
#define GRID_BAR() xcd_barrier(bar)
#endif
    const int lo = args.ph_lo, hi = args.ph_hi;
#ifndef PH_MASK
#define PH_MASK 0x3fff
#endif
#define PHON(x) (((PH_MASK) >> (x)) & 1)
#ifndef REP_MASK
#define REP_MASK 0
#endif
#define NREP(x) ((((REP_MASK) >> (x)) & 1) ? 2 : 1)
#define REFRESH() do { const int ln_ = fresh_lane(); F.tid = (wave0 << 6) | ln_; F.lane = ln_; F.wave = wave0; int v_ = vcu0, g_ = g0; asm volatile("" : "+s"(v_), "+s"(g_)); F.vcu = v_; F.G = g_; } while (0)
#define IN(k) (lo <= (k) && (k) < hi)
#define SEAM(k) do { if (IN(k) && IN((k) + 1)) GRID_BAR(); } while (0)
    LAS unsigned char* ring = F.lds;
    const bool CTX_IN_E = (F.G == 256);

    if (PHON(0) && IN(0)) { for (int rep = 0; rep < NREP(0); ++rep) { REFRESH(); p0_prologue(F); __syncthreads(); } } SEAM(0);
    if (PHON(1) && IN(1)) { REFRESH(); p0b_modreduce(F); } SEAM(1);

    for (int l = 0; l < DEPTH; ++l) {
        const int pb = 2 + l * PH_PER_LAYER;
        if (PHON(2) && IN(pb + 0)) { for (int rep = 0; rep < (l == 0 ? NREP(2) : 1); ++rep) { REFRESH(); if (l == 0) { router_tables(F); phase_norm1<0>(F, l, nullptr); } else phase_norm1<1>(F, l, nullptr); } } SEAM(pb + 0);
        if (PHON(3) && IN(pb + 1)) { REFRESH();
            pg8::Gemm g{(const bf16*)(F.ws + WS_H), (const bf16*)(F.ws + WS_WIN) + (size_t)l * PIN * DM, T, PIN, DM}; pg8::StaticOrder S; S.init(T, PIN, F.G, (int)blockIdx.x);
            EpiStoreBf16 E{(bf16*)(F.ws + WS_P), PIN};
            for (int rep = 0; rep < NREP(3); ++rep) pg8::gemm_phase<EpiStoreBf16, pg8::StaticOrder, true, true>(ring, g, S, E, F.tid);
        } SEAM(pb + 1);
        if (PHON(4) && IN(pb + 2)) { for (int rep = 0; rep < NREP(4); ++rep) { REFRESH(); phase_prep(F, l); } } SEAM(pb + 2);
        if (PHON(5) && IN(pb + 3)) { REFRESH();
            int kaux = 128; asm volatile("" : "+s"(kaux));
            pg8::Gemm g{(const bf16*)(F.ws + WS_AUXA), (const bf16*)(F.ws + WS_AUXB) + (size_t)l * 12 * 256 * 128, 8 * T, 12 * 256, kaux}; AuxSched S{F.G, F.vcu};
            EpiAux E{(bf16*)(F.ws + WS_G), (bf16*)(F.ws + WS_YB), (const bf16*)(F.ws + WS_AUXA), F.in[I_RGGB] + (size_t)l * 2 * 2 * 4 * 128, (const float*)(F.ws + WS_WRT) + DEPTH * NROUTE * DM + (size_t)l * 1024, F.in[I_POOLB] + (size_t)l * 512, F.in[I_POOLS] + (size_t)l * 512};
            for (int rep = 0; rep < NREP(5); ++rep) pg8::gemm_phase<EpiAux, AuxSched, true, true>(ring, g, S, E, F.tid);
            __syncthreads();
            if (F.tid == 0) __hip_atomic_fetch_add(ctl + CW_AUXD + l, 1u, __ATOMIC_RELEASE, __HIP_MEMORY_SCOPE_AGENT);
        }
        if (PHON(6) && IN(pb + 4)) { for (int rep = 0; rep < NREP(6); ++rep) { REFRESH(); phase_attn<0>(F, l);
                if (F.tid == 0) { unsigned* cw = ctl + CW_AUXD + l; for (unsigned sp = 0; sp < (1u << 26) && __hip_atomic_load(cw, __ATOMIC_ACQUIRE, __HIP_MEMORY_SCOPE_AGENT) < (unsigned)F.G; ++sp) __builtin_amdgcn_s_sleep(2); }
                __syncthreads();
                REFRESH(); phase_scan1(F, l); __syncthreads(); } } SEAM(pb + 4);
        if (PHON(7) && IN(pb + 5)) { for (int rep = 0; rep < NREP(7); ++rep) { REFRESH(); phase_scan2(F, l); } } SEAM(pb + 5);
        if (PHON(8) && IN(pb + 6)) { REFRESH();
            pg8::Gemm g{(const bf16*)(F.ws + WS_YB), (const bf16*)(F.ws + WS_WOUT) + (size_t)l * DM * DM, T, DM, DM};
            RowOrder S; S.latent_only = (l == DEPTH - 1) || CTX_IN_E; S.S.init(S.latent_only ? NBATCH * LSEQ : T, DM, F.G, (int)blockIdx.x);
            EpiResid E{(bf16*)(F.ws + WS_X), (const float*)(F.ws + WS_MOD) + (size_t)l * 3 * NMODC, l == 0 ? F.in[I_X] : nullptr, F.in[I_CTX]};
            pg8::gemm_phase<EpiResid, RowOrder, true, true>(ring, g, S, E, F.tid);
        } SEAM(pb + 6);
        if (PHON(9) && IN(pb + 7)) {
            if (l == DEPTH - 1) { for (int rep = NREP(9) - 1; rep >= 0; --rep) { REFRESH(); phase_norm2_router(F, l, 3, rep); } }
            else if (!CTX_IN_E) { for (int rep = NREP(9) - 1; rep >= 0; --rep) { REFRESH(); phase_norm2_router(F, l, 0, rep); } }
            else if (F.vcu >= 16) { REFRESH(); phase_norm2_router(F, l, 1);
                if (F.vcu < 48) {
                    if (F.tid == 0) { unsigned* cw = ctl + CW_CTXD + l;
                        for (unsigned sp = 0; sp < (1u << 26) && __hip_atomic_load(cw, __ATOMIC_ACQUIRE, __HIP_MEMORY_SCOPE_AGENT) < 16u; ++sp) __builtin_amdgcn_s_sleep(2); }
                    __syncthreads();
                    REFRESH(); phase_norm2_router(F, l, 2); } }
            else { REFRESH();
                pg8::Gemm g{(const bf16*)(F.ws + WS_YB), (const bf16*)(F.ws + WS_WOUT) + (size_t)l * DM * DM, T, DM, DM};
                OneUnit S{(F.vcu >> 3) * TPB, F.vcu & 7};
                EpiResid E{(bf16*)(F.ws + WS_X), (const float*)(F.ws + WS_MOD) + (size_t)l * 3 * NMODC, l == 0 ? F.in[I_X] : nullptr, F.in[I_CTX]};
                pg8::gemm_phase<EpiResid, OneUnit, true, true>(ring, g, S, E, F.tid);
                __syncthreads();
                if (F.tid == 0) __hip_atomic_fetch_add(ctl + CW_CTXD + l, 1u, __ATOMIC_RELEASE, __HIP_MEMORY_SCOPE_AGENT);
            }
        } SEAM(pb + 7);
        if (PHON(11) && IN(pb + 9)) { REFRESH();
            moe_sort_tiles(F, l);
            const LAS int* perm = (const LAS int*)(F.lds + PERM_OFF); const int nF = perm[0] * 4, rf = nF / F.G, R = nF - rf * F.G;
            pg8::Gemm g{(const bf16*)(F.ws + WS_HS), (const bf16*)(F.ws + WS_UP) + (size_t)l * NEXP * 1024 * DM, SLOT_CAP, NEXP * 1024, DM}; MoeSched S{perm, 4, F.G, F.vcu, (R > 0 && rf > 0) ? rf * F.G : 0x7fffffff, (const LAS int*)(F.lds + GT_OFF)};
            moe_fill_rows(F, perm, F.vcu, F.G, S.lim);
            EpiSwiGLU E{(bf16*)(F.ws + WS_HM), (const float*)(F.ws + WS_ROUTE) + RT_WSLOT};
            for (int rep = 0; rep < NREP(11); ++rep) pg8::gemm_phase<EpiSwiGLU, MoeSched, true, true, true>(ring, g, S, E, F.tid);
        } SEAM(pb + 9);
        if (PHON(12) && IN(pb + 10)) { REFRESH();
            moe_sort_tiles(F, l);
            const LAS int* perm = (const LAS int*)(F.lds + PERM_OFF); const int nF = perm[0] * 4, rf = nF / F.G; int R = nF - rf * F.G; if (rf == 0) R = 0;
            unsigned* fov = ctl + CW_FOV + l * 256;
            if (F.vcu < R) {
                pg8::Gemm g{(const bf16*)(F.ws + WS_HS), (const bf16*)(F.ws + WS_UP) + (size_t)l * NEXP * 1024 * DM, SLOT_CAP, NEXP * 1024, DM}; MoeOneUp S{perm, rf * F.G + F.vcu, (const LAS int*)(F.lds + GT_OFF)};
                moe_fill_rows(F, perm, rf * F.G + F.vcu, 0x10000000, 0x7fffffff);
                EpiSwiGLU E{(bf16*)(F.ws + WS_HM), (const float*)(F.ws + WS_ROUTE) + RT_WSLOT};
                pg8::gemm_phase<EpiSwiGLU, MoeOneUp, true, true, true>(ring, g, S, E, F.tid);
                __syncthreads();
                if (F.tid == 0) __hip_atomic_fetch_add(fov + ((rf * F.G + F.vcu) >> 2), 1u, __ATOMIC_RELEASE, __HIP_MEMORY_SCOPE_AGENT);
                REFRESH();
            }
            pg8::Gemm g{(const bf16*)(F.ws + WS_HM), (const bf16*)(F.ws + WS_DOWN) + (size_t)l * NEXP * DM * DEXP, SLOT_CAP, NEXP * DM, DEXP}; MoeDownSched S{perm, F.G, F.vcu, R, (rf * F.G) >> 2, fov};
            EpiDown E{(bf16*)(F.ws + WS_YS)};
            for (int rep = 0; rep < NREP(12); ++rep) pg8::gemm_phase<EpiDown, MoeDownSched, true, true>(ring, g, S, E, F.tid);
        } SEAM(pb + 10);
    }
    if (PHON(13) && IN(N_PHASES - 1)) { for (int rep = 0; rep < NREP(13); ++rep) { REFRESH(); phase_norm1<2>(F, DEPTH, args.out); } }
#undef IN
#undef SEAM
}

extern "C" void kernel_launch(void* const* d_in, const int* in_sizes, int n_in, void* d_out, int out_size, void* d_ws, size_t ws_size, hipStream_t stream) {
    static int grid = 0;
    if (grid == 0) {
        if (n_in != 28 || in_sizes[0] != NBATCH * LSEQ * DM || out_size != NBATCH * LSEQ * DM || ws_size < WS_END) {
            fprintf(stderr, "kernel_launch: unexpected shapes (n_in %d, in0 %d, out %d, ws %zu need %zu); nothing launched\n", n_in, n_in > 0 ? in_sizes[0] : -1, out_size, ws_size, (size_t)WS_END); grid = -1; return; }
        int dev = 0, cus = 0, per_cu = 0;
        if (hipGetDevice(&dev) != hipSuccess || hipDeviceGetAttribute(&cus, hipDeviceAttributeMultiprocessorCount, dev) != hipSuccess) { fprintf(stderr, "kernel_launch: device query failed\n"); grid = -1; return; }
        if (hipFuncSetAttribute((const void*)hymba_fwd, hipFuncAttributeMaxDynamicSharedMemorySize, LDS_BYTES) != hipSuccess) { fprintf(stderr, "kernel_launch: hipFuncSetAttribute failed\n"); grid = -1; return; }
        if (hipOccupancyMaxActiveBlocksPerMultiprocessor(&per_cu, (const void*)hymba_fwd, NWAVES * 64, LDS_BYTES) != hipSuccess || per_cu < 1)
            fprintf(stderr, "kernel_launch: note: occupancy query reports %d workgroups per CU\n", per_cu);
        (void)hipGetLastError();
        grid = cus;
    }
    if (grid < 0) return;
    if (hipMemsetAsync((char*)d_ws + WS_CTL, 0, CTL_ZERO_BYTES, stream) != hipSuccess) { fprintf(stderr, "kernel_launch: memset failed\n"); return; }
    Args a{};
    for (int i = 0; i < 28; ++i) a.in[i] = (const float*)d_in[i];
    a.out = (float*)d_out; a.ws = (unsigned char*)d_ws;
#if MK_SPLIT
    for (int p = 0; p < N_PHASES; ++p) { a.ph_lo = p; a.ph_hi = p + 1; hipLaunchKernelGGL(hymba_fwd, dim3(grid), dim3(NWAVES * 64), LDS_BYTES, stream, a); }
#else
    a.ph_lo = 0; a.ph_hi = N_PHASES;
    hipLaunchKernelGGL(hymba_fwd, dim3(grid), dim3(NWAVES * 64), LDS_BYTES, stream, a);
#endif
    const hipError_t le = hipPeekAtLastError();
    if (le != hipSuccess) fprintf(stderr, "kernel_launch: launch failed: %s\n", hipGetErrorName(le));
}
```
